# Optimizing an MI355X kernel written in HIP

```python
import jax, jax.numpy as jnp
from jax import lax
import numpy as np

D_MODEL = 2048
BATCH = 4
SEQ = 4096
DEPTH = 2

GRID_W = 64
CTX_LEN = 256
HEAD_DIM = 128
ROPE_THETA = 10000.0
Q_BLOCK = 128
EPS = 1e-6
NEG_INF = -1e30
A_HEADS = 8
A_KV_HEADS = 2
M_HEADS = 4
M_CHUNK = 128
M_CONV_W = 3
C_HEADS = 4
C_KV_HEADS = 2
WINDOW = 128
N_GROUPS = 4
EXPERTS_PER_GROUP = 4
N_EXPERTS = N_GROUPS * EXPERTS_PER_GROUP
TOP_K = 2
D_FF_EXPERT = 512

A_WIDTH = A_HEADS * HEAD_DIM
A_KV_WIDTH = A_KV_HEADS * HEAD_DIM
M_WIDTH = M_HEADS * HEAD_DIM
C_WIDTH = C_HEADS * HEAD_DIM
C_KV_WIDTH = C_KV_HEADS * HEAD_DIM
SPLIT_WIDTHS = (A_WIDTH, A_KV_WIDTH, A_KV_WIDTH,
                M_WIDTH, M_WIDTH, M_WIDTH, M_WIDTH, 4 * M_HEADS,
                C_WIDTH, C_KV_WIDTH, C_KV_WIDTH,
                3 * D_MODEL)
P_IN = sum(SPLIT_WIDTHS)
SPLIT_IDX = tuple(int(v) for v in np.cumsum(SPLIT_WIDTHS)[:-1])

kernel_name = 'hybrid_gqa_mlstm_swa_hmoe_prefix_dit'

f32 = jnp.float32


def rms_norm(x, g):
    xf = x.astype(f32)
    y = xf * lax.rsqrt(jnp.mean(xf * xf, axis=-1, keepdims=True) + EPS)
    return (y * g.astype(f32)).astype(x.dtype)


def _modulate(x, g, shift, scale):
    return rms_norm(x, g) * (1 + scale) + shift


def _heads(a, n_heads):
    B, T, _ = a.shape
    return a.reshape(B, T, n_heads, HEAD_DIM).transpose(0, 2, 1, 3)


def _merge_heads(a):
    B, H, T, d = a.shape
    return a.transpose(0, 2, 1, 3).reshape(B, T, H * d)


def axial_rope_tables(n_tokens):
    n_rows = n_tokens // GRID_W
    rows, cols = jnp.meshgrid(jnp.arange(n_rows), jnp.arange(GRID_W), indexing='ij')
    rows = rows.reshape(-1).astype(f32)
    cols = cols.reshape(-1).astype(f32)
    axis_dim = HEAD_DIM // 2
    inv_freq = ROPE_THETA ** (-jnp.arange(0, axis_dim, 2, dtype=f32) / axis_dim)
    ang = jnp.concatenate([rows[:, None] * inv_freq, cols[:, None] * inv_freq], axis=-1)
    return jnp.cos(ang), jnp.sin(ang)


def apply_axial_rope(x, cos, sin):
    *lead, T, d = x.shape
    xf = x.astype(f32).reshape(*lead, T, 2, 2, d // 4)
    c = cos.reshape(T, 2, d // 4)
    s = sin.reshape(T, 2, d // 4)
    x1, x2 = xf[..., 0, :], xf[..., 1, :]
    out = jnp.stack([x1 * c - x2 * s, x2 * c + x1 * s], axis=-2)
    return out.reshape(*lead, T, d).astype(x.dtype)


def centred_dwconv(x, w):
    K, C = w.shape
    return lax.conv_general_dilated(x, w.astype(x.dtype)[:, None, :], window_strides=(1,),
                                    padding=[(K // 2, K // 2)],
                                    dimension_numbers=('NWC', 'WIO', 'NWC'),
                                    feature_group_count=C)


def _attend_dense(q, k, v):
    s = jnp.einsum('bkgqd,bksd->bkgqs', q, k, preferred_element_type=f32) * (HEAD_DIM ** -0.5)
    p = jax.nn.softmax(s, axis=-1).astype(v.dtype)
    return jnp.einsum('bkgqs,bksd->bkgqd', p, v)


def global_gqa_latent(q, k_all, v_all):
    B, Hq, T, d = q.shape
    G = Hq // A_KV_HEADS
    nb = T // Q_BLOCK
    qb = q.reshape(B, A_KV_HEADS, G, nb, Q_BLOCK, d).transpose(3, 0, 1, 2, 4, 5)
    ob = lax.map(lambda qq: _attend_dense(qq, k_all, v_all), qb)
    return ob.transpose(1, 2, 3, 0, 4, 5).reshape(B, Hq, T, d)


def global_gqa_context(q, k, v):
    B, Hq, Tc, d = q.shape
    G = Hq // A_KV_HEADS
    o = _attend_dense(q.reshape(B, A_KV_HEADS, G, Tc, d), k, v)
    return o.reshape(B, Hq, Tc, d)


def _sink_probs(s, sink):
    m = jnp.maximum(jnp.max(s, axis=-1, keepdims=True), sink)
    p = jnp.exp(s - m)
    return p / (jnp.sum(p, axis=-1, keepdims=True) + jnp.exp(sink - m))


def window_gqa_latent(q, k, v, k_ctx, v_ctx, sink):
    B, Hq, T, d = q.shape
    Hkv = C_KV_HEADS
    G = Hq // Hkv
    nb = T // Q_BLOCK
    ns = -(-WINDOW // Q_BLOCK)
    nband = 2 * ns + 1
    L = nband * Q_BLOCK

    def band(a):
        ap = jnp.pad(a, ((0, 0), (0, 0), (ns * Q_BLOCK, ns * Q_BLOCK), (0, 0)))
        ap = ap.reshape(B, Hkv, nb + 2 * ns, Q_BLOCK, d)
        return jnp.concatenate([ap[:, :, j:j + nb] for j in range(nband)], axis=3)

    kb, vb = band(k), band(v)
    qb = q.reshape(B, Hkv, G, nb, Q_BLOCK, d)
    scale = HEAD_DIM ** -0.5
    s_loc = jnp.einsum('bkgnqd,bknsd->bkgnqs', qb, kb, preferred_element_type=f32) * scale
    qpos = jnp.arange(nb)[:, None] * Q_BLOCK + jnp.arange(Q_BLOCK)[None, :]
    kpos = jnp.arange(nb)[:, None] * Q_BLOCK + jnp.arange(L)[None, :] - ns * Q_BLOCK
    valid = ((jnp.abs(qpos[:, :, None] - kpos[:, None, :]) <= WINDOW)
             & (kpos[:, None, :] >= 0) & (kpos[:, None, :] < T))
    s_loc = jnp.where(valid, s_loc, NEG_INF)
    s_ctx = jnp.einsum('bkgnqd,bksd->bkgnqs', qb, k_ctx, preferred_element_type=f32) * scale
    s = jnp.concatenate([s_loc, s_ctx], axis=-1)
    p = _sink_probs(s, sink.astype(f32).reshape(1, Hkv, G, 1, 1, 1)).astype(v.dtype)
    o = (jnp.einsum('bkgnqs,bknsd->bkgnqd', p[..., :L], vb)
         + jnp.einsum('bkgnqs,bksd->bkgnqd', p[..., L:], v_ctx))
    return o.reshape(B, Hq, T, d)


def window_gqa_context(q, k, v, sink):
    B, Hq, Tc, d = q.shape
    G = Hq // C_KV_HEADS
    qg = q.reshape(B, C_KV_HEADS, G, Tc, d)
    s = jnp.einsum('bkgqd,bksd->bkgqs', qg, k, preferred_element_type=f32) * (HEAD_DIM ** -0.5)
    p = _sink_probs(s, sink.astype(f32).reshape(1, C_KV_HEADS, G, 1, 1)).astype(v.dtype)
    return jnp.einsum('bkgqs,bksd->bkgqd', p, v).reshape(B, Hq, Tc, d)


def _mlstm_zero_state(B):
    return (jnp.zeros((B, M_HEADS, HEAD_DIM, HEAD_DIM), f32),
            jnp.zeros((B, M_HEADS, HEAD_DIM), f32),
            jnp.full((B, M_HEADS), NEG_INF, f32))


def mlstm_chunk_scan(q, k, v, ig, lf, state):
    B, H, T, d = q.shape
    nc = T // M_CHUNK

    def chunks(a):
        return jnp.moveaxis(a.reshape(B, H, nc, M_CHUNK, *a.shape[3:]), 2, 0)

    tri = jnp.tril(jnp.ones((M_CHUNK, M_CHUNK), bool))

    def step(carry, xs):
        C, n, m = carry
        qc, kc, vc, ic, fc = xs
        b = jnp.cumsum(fc, axis=-1)
        log_d = jnp.where(tri, b[..., :, None] - b[..., None, :] + ic[..., None, :], -jnp.inf)
        log_inter = b + m[..., None]
        m_row = jnp.maximum(log_inter, jnp.max(log_d, axis=-1))
        w_intra = jnp.exp(log_d - m_row[..., None]) * jnp.einsum('bhjd,bhsd->bhjs', qc, kc)
        w_inter = jnp.exp(log_inter - m_row)
        num = (w_inter[..., None] * jnp.einsum('bhjd,bhde->bhje', qc, C)
               + jnp.einsum('bhjs,bhse->bhje', w_intra, vc))
        den = w_inter * jnp.einsum('bhjd,bhd->bhj', qc, n) + jnp.sum(w_intra, axis=-1)
        h = num / jnp.maximum(jnp.abs(den), jnp.exp(-m_row))[..., None]
        b_last = b[..., -1]
        log_w = b_last[..., None] - b + ic
        m_new = jnp.maximum(b_last + m, jnp.max(log_w, axis=-1))
        w_s = jnp.exp(log_w - m_new[..., None])
        decay = jnp.exp(b_last + m - m_new)
        C = decay[..., None, None] * C + jnp.einsum('bhs,bhsd,bhse->bhde', w_s, kc, vc)
        n = decay[..., None] * n + jnp.einsum('bhs,bhsd->bhd', w_s, kc)
        return (C, n, m_new), h

    state, hs = lax.scan(step, state, (chunks(q), chunks(k), chunks(v), chunks(ig), chunks(lf)))
    return jnp.moveaxis(hs, 0, 2).reshape(B, H, T, d), state


def _mlstm_prep(mq, mk, mv, mg, conv_w, ig_b, fg_b):
    qk = jax.nn.silu(centred_dwconv(jnp.concatenate([mq, mk], axis=-1), conv_w))
    q, k = jnp.split(qk, 2, axis=-1)
    q = _heads(q, M_HEADS).astype(f32)
    k = _heads(k, M_HEADS).astype(f32) * (HEAD_DIM ** -0.5)
    v = _heads(mv, M_HEADS).astype(f32)
    B, T, _ = mg.shape
    g = mg.astype(f32).reshape(B, T, 2, 2, M_HEADS).transpose(0, 2, 3, 4, 1)
    ig = g[:, 0] + ig_b.astype(f32)[None, :, :, None]
    lf = jax.nn.log_sigmoid(g[:, 1] + fg_b.astype(f32)[None, :, :, None])
    return q, k, v, ig, lf


def mlstm_bidir(lat, ctx):
    B = lat[0].shape[0]
    h_lat, h_ctx = 0.0, 0.0
    for direction in range(2):
        flip = (lambda a: jnp.flip(a, axis=2)) if direction else (lambda a: a)
        qc, kc, vc, ic, fc = ctx
        hc, st = mlstm_chunk_scan(flip(qc), flip(kc), flip(vc), flip(ic[:, direction]), flip(fc[:, direction]),
                                  _mlstm_zero_state(B))
        ql, kl, vl, il, fl = lat
        hl, _ = mlstm_chunk_scan(flip(ql), flip(kl), flip(vl), flip(il[:, direction]), flip(fl[:, direction]), st)
        h_lat = h_lat + flip(hl)
        h_ctx = h_ctx + flip(hc)
    return h_lat, h_ctx


def _mlstm_out(h, mo, norm_g):
    h = rms_norm(h, norm_g.reshape(M_HEADS, 1, HEAD_DIM))
    return _merge_heads(h).astype(mo.dtype) * jax.nn.sigmoid(mo)


def mixer_sublayer(h_l, h_c, w_in, a_qn_g, a_kn_g, m_conv, m_ig_b, m_fg_b, m_norm_g, c_sink,
                   w_br_a, w_br_m, w_br_c, w_out, need_ctx_out):
    T = h_l.shape[1]
    cos, sin = axial_rope_tables(T)
    (aq_l, ak_l, av_l, mq_l, mk_l, mv_l, mo_l, mg_l, cq_l, ck_l, cv_l, g_l) = jnp.split(h_l @ w_in, SPLIT_IDX, axis=-1)
    (aq_c, ak_c, av_c, mq_c, mk_c, mv_c, mo_c, mg_c, cq_c, ck_c, cv_c, g_c) = jnp.split(h_c @ w_in, SPLIT_IDX, axis=-1)

    aq = apply_axial_rope(rms_norm(_heads(aq_l, A_HEADS), a_qn_g), cos, sin)
    ak = apply_axial_rope(rms_norm(_heads(ak_l, A_KV_HEADS), a_kn_g), cos, sin)
    av = _heads(av_l, A_KV_HEADS)
    akc = rms_norm(_heads(ak_c, A_KV_HEADS), a_kn_g)
    avc = _heads(av_c, A_KV_HEADS)
    oa_l = global_gqa_latent(aq, jnp.concatenate([ak, akc], axis=2), jnp.concatenate([av, avc], axis=2))

    lat_in = _mlstm_prep(mq_l, mk_l, mv_l, mg_l, m_conv, m_ig_b, m_fg_b)
    ctx_in = _mlstm_prep(mq_c, mk_c, mv_c, mg_c, m_conv, m_ig_b, m_fg_b)
    hm_l, hm_c = mlstm_bidir(lat_in, ctx_in)
    om_l = _mlstm_out(hm_l, mo_l, m_norm_g)

    cq = apply_axial_rope(_heads(cq_l, C_HEADS), cos, sin)
    ck = apply_axial_rope(_heads(ck_l, C_KV_HEADS), cos, sin)
    cv = _heads(cv_l, C_KV_HEADS)
    ckc = _heads(ck_c, C_KV_HEADS)
    cvc = _heads(cv_c, C_KV_HEADS)
    oc_l = window_gqa_latent(cq, ck, cv, ckc, cvc, c_sink)

    def merge(oa, om, oc, g):
        ga, gm, gc = jnp.split(jax.nn.sigmoid(g), 3, axis=-1)
        y = ga * (_merge_heads(oa) @ w_br_a) + gm * (om @ w_br_m) + gc * (_merge_heads(oc) @ w_br_c)
        return y @ w_out

    y_l = merge(oa_l, om_l, oc_l, g_l)
    if not need_ctx_out:
        return y_l, None
    oa_c = global_gqa_context(rms_norm(_heads(aq_c, A_HEADS), a_qn_g), akc, avc)
    om_c = _mlstm_out(hm_c, mo_c, m_norm_g)
    oc_c = window_gqa_context(_heads(cq_c, C_HEADS), ckc, cvc, c_sink)
    return y_l, merge(oa_c, om_c, oc_c, g_c)


def hier_moe(h, w_rg, b_rg, w_re, b_re, w_gate, w_up, w_down):
    shape = h.shape
    hf = h.reshape(-1, shape[-1])
    N = hf.shape[0]
    g_logits = (hf @ w_rg).astype(f32) + b_rg.astype(f32)
    g_prob = jax.nn.softmax(g_logits, axis=-1)
    g_sel = jnp.argmax(g_logits, axis=-1)
    p_g = jnp.take_along_axis(g_prob, g_sel[:, None], axis=-1)[:, 0]
    e_logits = ((hf @ w_re).astype(f32) + b_re.astype(f32)).reshape(N, N_GROUPS, EXPERTS_PER_GROUP)
    e_in = jnp.take_along_axis(e_logits, g_sel[:, None, None], axis=1)[:, 0]
    top_p, top_i = lax.top_k(jax.nn.softmax(e_in, axis=-1), TOP_K)
    top_p = top_p / jnp.sum(top_p, axis=-1, keepdims=True)
    expert_ids = g_sel[:, None] * EXPERTS_PER_GROUP + top_i
    weights = p_g[:, None] * top_p
    combine = jnp.sum(jax.nn.one_hot(expert_ids, N_EXPERTS, dtype=f32) * weights[..., None], axis=1)
    a = jnp.einsum('nd,edf->nef', hf, w_gate)
    u = jnp.einsum('nd,edf->nef', hf, w_up)
    mid = jax.nn.silu(a) * u * combine.astype(hf.dtype)[..., None]
    return jnp.einsum('nef,efd->nd', mid, w_down).reshape(shape)


def setup_inputs(seed: int = 0) -> dict:
    key = jax.random.key(seed)
    ks = jax.random.split(key, 32)
    D = D_MODEL

    def nrm(k, shape, scale):
        return jax.random.normal(k, shape, f32) * scale

    return {
        'x': nrm(ks[0], (BATCH, SEQ, D), 1.0),
        'c': nrm(ks[1], (BATCH, D), 1.0),
        'ctx': nrm(ks[2], (BATCH, CTX_LEN, D), 1.0),
        'c_ctx': nrm(ks[3], (D,), 1.0),
        'norm1_g': 1.0 + nrm(ks[4], (DEPTH, D), 0.05),
        'norm2_g': 1.0 + nrm(ks[5], (DEPTH, D), 0.05),
        'w_mod': nrm(ks[6], (DEPTH, D, 6 * D), 0.5 * D ** -0.5),
        'b_mod': nrm(ks[7], (DEPTH, 6 * D), 0.02),
        'w_in': nrm(ks[8], (DEPTH, D, P_IN), D ** -0.5),
        'a_qn_g': 1.0 + nrm(ks[9], (DEPTH, HEAD_DIM), 0.05),
        'a_kn_g': 1.0 + nrm(ks[10], (DEPTH, HEAD_DIM), 0.05),
        'm_conv': nrm(ks[11], (DEPTH, M_CONV_W, 2 * M_WIDTH), M_CONV_W ** -0.5),
        'm_ig_b': nrm(ks[12], (DEPTH, 2, M_HEADS), 0.1),
        'm_fg_b': 3.0 + nrm(ks[13], (DEPTH, 2, M_HEADS), 0.5),
        'm_norm_g': 1.0 + nrm(ks[14], (DEPTH, M_WIDTH), 0.05),
        'c_sink': nrm(ks[15], (DEPTH, C_HEADS), 0.5),
        'w_br_a': nrm(ks[16], (DEPTH, A_WIDTH, D), A_WIDTH ** -0.5),
        'w_br_m': nrm(ks[17], (DEPTH, M_WIDTH, D), M_WIDTH ** -0.5),
        'w_br_c': nrm(ks[18], (DEPTH, C_WIDTH, D), C_WIDTH ** -0.5),
        'w_out': nrm(ks[19], (DEPTH, D, D), D ** -0.5),
        'w_rg': nrm(ks[20], (DEPTH, D, N_GROUPS), D ** -0.5),
        'b_rg': nrm(ks[21], (DEPTH, N_GROUPS), 0.01),
        'w_re': nrm(ks[22], (DEPTH, D, N_EXPERTS), D ** -0.5),
        'b_re': nrm(ks[23], (DEPTH, N_EXPERTS), 0.01),
        'w_gate': nrm(ks[24], (DEPTH, N_EXPERTS, D, D_FF_EXPERT), D ** -0.5),
        'w_up': nrm(ks[25], (DEPTH, N_EXPERTS, D, D_FF_EXPERT), D ** -0.5),
        'w_down': nrm(ks[26], (DEPTH, N_EXPERTS, D_FF_EXPERT, D), D_FF_EXPERT ** -0.5),
        'final_g': 1.0 + nrm(ks[27], (D,), 0.05),
    }


def reference(x, c, ctx, c_ctx, norm1_g, norm2_g, w_mod, b_mod, w_in, a_qn_g, a_kn_g, m_conv, m_ig_b, m_fg_b,
              m_norm_g, c_sink, w_br_a, w_br_m, w_br_c, w_out, w_rg, b_rg, w_re, b_re, w_gate, w_up, w_down,
              final_g):
    s_lat = jax.nn.silu(c)
    s_ctx = jax.nn.silu(c_ctx)
    xl, xc = x, ctx
    for l in range(DEPTH):
        need_ctx_out = l < DEPTH - 1
        mod_l = (s_lat @ w_mod[l] + b_mod[l])[:, None, :]
        mod_c = (s_ctx @ w_mod[l] + b_mod[l])[None, None, :]
        sh1, sc1, g1, sh2, sc2, g2 = jnp.split(mod_l, 6, axis=-1)
        sh1c, sc1c, g1c, sh2c, sc2c, g2c = jnp.split(mod_c, 6, axis=-1)
        hl = _modulate(xl, norm1_g[l], sh1, sc1)
        hc = _modulate(xc, norm1_g[l], sh1c, sc1c)
        y_l, y_c = mixer_sublayer(hl, hc, w_in[l], a_qn_g[l], a_kn_g[l], m_conv[l], m_ig_b[l], m_fg_b[l],
                                  m_norm_g[l], c_sink[l], w_br_a[l], w_br_m[l], w_br_c[l], w_out[l], need_ctx_out)
        xl = xl + g1 * y_l
        xl = xl + g2 * hier_moe(_modulate(xl, norm2_g[l], sh2, sc2), w_rg[l], b_rg[l], w_re[l], b_re[l],
                                w_gate[l], w_up[l], w_down[l])
        if need_ctx_out:
            xc = xc + g1c * y_c
            xc = xc + g2c * hier_moe(_modulate(xc, norm2_g[l], sh2c, sc2c), w_rg[l], b_rg[l], w_re[l], b_re[l],
                                     w_gate[l], w_up[l], w_down[l])
    return rms_norm(xl, final_g)
```

```cpp
#include <hip/hip_runtime.h>
#include <cstdio>
#include <cstdint>

#ifndef MK_PER_PHASE
#define MK_PER_PHASE 1
#endif

#define GAS __attribute__((address_space(1)))
#define LAS __attribute__((address_space(3)))
typedef unsigned short bf16_t;
typedef short bf16x8 __attribute__((ext_vector_type(8)));
typedef short s16x4 __attribute__((ext_vector_type(4)));
typedef float f32x2 __attribute__((ext_vector_type(2)));
typedef float f32x4 __attribute__((ext_vector_type(4)));
typedef float f32x8 __attribute__((ext_vector_type(8)));
typedef float f32x16 __attribute__((ext_vector_type(16)));
typedef unsigned u32x2 __attribute__((ext_vector_type(2)));
typedef unsigned u32x4 __attribute__((ext_vector_type(4)));

constexpr int DM = 2048, NB = 4, SEQ = 4096, CTXL = 256, HD = 128;
constexpr int NLAT = NB * SEQ, NCTX = NB * CTXL, NROW = NLAT + NCTX;
constexpr int KVL = SEQ + CTXL;
constexpr int PIN = 10768, NPIN = 11008;
constexpr int NEXP = 16, DFF = 512;
constexpr int MOE_TILES_MAX = 152, MOE_ROWS_MAX = MOE_TILES_MAX * 256;
constexpr float EPS = 1e-6f;
constexpr int NWAVES = 8, NTHR = 512;

constexpr size_t MiB = 1u << 20;
constexpr size_t WS_CTL = 0, CTL_ZERO_BYTES = 1 * MiB;
constexpr size_t WS_MOD = 1 * MiB;
constexpr size_t WS_ROPE = 2 * MiB;
constexpr size_t WS_MODP = 4 * MiB;
constexpr size_t WS_ROUTE = 12 * MiB;
constexpr size_t WS_GRAW = 14 * MiB;
constexpr size_t WS_GATE = 16 * MiB;
constexpr size_t WS_WIN = 20 * MiB;
constexpr size_t WS_WBR = 63 * MiB;
constexpr size_t WS_WOUT = 71 * MiB;
constexpr size_t WS_WGU = 79 * MiB;
constexpr size_t WS_WD = 143 * MiB;
constexpr size_t WS_XL = 175 * MiB;
constexpr size_t WS_XC = 303 * MiB;
constexpr size_t WS_H = 311 * MiB;
constexpr size_t WS_MO = 379 * MiB;
constexpr size_t WS_P1 = 396 * MiB;
constexpr size_t WS_G = 532 * MiB;
constexpr size_t WS_OALL = 396 * MiB;
constexpr size_t WS_HM = 464 * MiB;
constexpr size_t WS_XS = 396 * MiB;
constexpr size_t WS_MID = 548 * MiB;
constexpr size_t WS_MOEOUT = 586 * MiB;
constexpr size_t WS_QA = 738 * MiB;
constexpr size_t WS_QAC = 770 * MiB;
constexpr size_t WS_KA = 772 * MiB;
constexpr size_t WS_VA = 781 * MiB;
constexpr size_t WS_QC = 790 * MiB;
constexpr size_t WS_QCC = 806 * MiB;
constexpr size_t WS_KC = 807 * MiB;
constexpr size_t WS_VC = 816 * MiB;
constexpr size_t WS_QM = 825 * MiB;
constexpr size_t WS_KM = 842 * MiB;
constexpr size_t WS_VM = 859 * MiB;
constexpr size_t WS_Y = 738 * MiB;
constexpr size_t WS_END = 876 * MiB;

constexpr int CW_BAR = 4096;
constexpr int CW_QCTR = 8192;
constexpr int CW_ECNT = 12288;
constexpr size_t RT_SLOTE = 0;
constexpr size_t RT_SLOTP = 160 * 1024;
constexpr size_t RT_SLOTW = 320 * 1024;
constexpr size_t RT_SLOTD = 480 * 1024;
constexpr size_t RT_WSORT = 640 * 1024;

constexpr int RING_BYTES = 131072;
constexpr int ML_SM = 131072;
constexpr int LDSCTL_OFF = 143360;
constexpr int LDS_BYTES = 147456;
constexpr int LC_BAR = 8;
constexpr int LC_Q = 16;
constexpr int LC_TILE = 64;

__device__ __forceinline__ float bflo(unsigned w) { return __uint_as_float(w << 16); }
__device__ __forceinline__ float bfhi(unsigned w) { return __uint_as_float(w & 0xffff0000u); }
__device__ __forceinline__ unsigned cvt_pk_bf16(float lo, float hi) { unsigned r; asm volatile("v_cvt_pk_bf16_f32 %0, %1, %2" : "=v"(r) : "v"(lo), "v"(hi)); return r; }
template <int O> __device__ __forceinline__ float xshfl(float v) {
    if constexpr (O < 32) return __int_as_float(__builtin_amdgcn_ds_swizzle(__float_as_int(v), (O << 10) | 0x1f));
    else { auto rr = __builtin_amdgcn_permlane32_swap(__float_as_uint(v), __float_as_uint(v), false, false); return __uint_as_float(rr[0]) == v ? __uint_as_float(rr[1]) : __uint_as_float(rr[0]); }
}
__device__ __forceinline__ float wave_sum(float v) {
    v += xshfl<1>(v); v += xshfl<2>(v); v += xshfl<4>(v); v += xshfl<8>(v); v += xshfl<16>(v);
    { auto rr = __builtin_amdgcn_permlane32_swap(__float_as_uint(v), __float_as_uint(v), false, false); v = __uint_as_float(rr[0]) + __uint_as_float(rr[1]); }
    return v;
}
__device__ __forceinline__ float sigmoidf_(float x) { return __builtin_amdgcn_rcpf(1.0f + __expf(-x)); }
__device__ __forceinline__ float siluf_(float x) { return x * sigmoidf_(x); }
__device__ __forceinline__ int opaque(int x) { asm volatile("" : "+v"(x)); return x; }
__device__ __forceinline__ int tid_of(int wave) { int l; asm volatile("v_mbcnt_lo_u32_b32 %0, -1, 0\n\tv_mbcnt_hi_u32_b32 %0, -1, %0" : "=v"(l)); return wave * 64 + l; }
#define LDS_WAIT() asm volatile("s_waitcnt lgkmcnt(0)" ::: "memory")
#define VM_WAIT() asm volatile("s_waitcnt vmcnt(0)" ::: "memory")

#define XB_TMO      128
#define XB_XCNT(j)  (256  + 64 * (j))
#define XB_XSUB(j)  (1280 + 64 * (j))
#define XB_XGEN(j)  (2304 + 64 * (j))
#define XB_TOP      3328
#define XB_TOPGEN   3392
#define XCD_BAR_WORDS 3456
#define XB_SPIN_CAP (1u << 18)
__device__ __forceinline__ unsigned xb_ld(unsigned* p)              { return __hip_atomic_load(p, __ATOMIC_RELAXED, __HIP_MEMORY_SCOPE_AGENT); }
__device__ __forceinline__ unsigned xb_add(unsigned* p, unsigned v) { return __hip_atomic_fetch_add(p, v, __ATOMIC_RELAXED, __HIP_MEMORY_SCOPE_AGENT); }
__device__ __forceinline__ unsigned xb_xcc_id() { return (unsigned)__builtin_amdgcn_s_getreg((3 << 11) | 20) & 0xFu; }
#define XB_SPIN(cond, bar) do { unsigned _sp = 0; while (cond) { __builtin_amdgcn_s_sleep(1); \
    if ((++_sp & 255u) == 0u) { if (xb_ld(&(bar)[XB_TMO])) break; if (_sp > XB_SPIN_CAP) { atomicAdd(&(bar)[XB_TMO], 1u); break; } } } } while (0)
struct XcdBarrier { unsigned* bar; unsigned x; volatile LAS unsigned* st; };
__device__ __forceinline__ XcdBarrier xcd_barrier_post(unsigned* bar, volatile LAS unsigned* st, int tid) {
    XcdBarrier b; b.bar = bar; b.x = xb_xcc_id(); b.st = st;
    if (tid == 0) (void)xb_add(&bar[XB_XCNT(b.x)], 1u);
    return b;
}
__device__ __forceinline__ void xcd_barrier_complete(unsigned* bar, unsigned x, unsigned& nloc, unsigned& nx) {
    const unsigned G = gridDim.x * gridDim.y * gridDim.z;
    unsigned sum, cnt, mine, sp = 0u;
    for (;;) {
        sum = 0u; cnt = 0u; mine = 0u;
#pragma unroll
        for (unsigned j = 0; j < 16; ++j) { const unsigned c = xb_ld(&bar[XB_XCNT(j)]); sum += c; cnt += (c > 0u) ? 1u : 0u; mine = (j == x) ? c : mine; }
        if (sum == G) break;
        __builtin_amdgcn_s_sleep(1);
        if ((++sp & 255u) == 0u) { if (xb_ld(&bar[XB_TMO])) break; if (sp > XB_SPIN_CAP) { atomicAdd(&bar[XB_TMO], 1u); break; } }
    }
    nloc = mine > 0u ? mine : 1u; nx = cnt > 0u ? cnt : 1u;
}
__device__ __forceinline__ void xcd_barrier(const XcdBarrier& b, int tid) {
    asm volatile("s_waitcnt vmcnt(0)" ::: "memory");
    __syncthreads();
    if (tid == 0) {
        unsigned* bar = b.bar;
        __builtin_amdgcn_s_waitcnt(0);
        unsigned nloc = b.st[0], nx = b.st[1];
        if (nloc == 0u) { xcd_barrier_complete(bar, b.x, nloc, nx); b.st[0] = nloc; b.st[1] = nx; }
        const unsigned old = xb_add(&bar[XB_XSUB(b.x)], 1u);
        const unsigned gen = old / nloc;
        if (old + 1u == (gen + 1u) * nloc) {
            __builtin_amdgcn_fence(__ATOMIC_RELEASE, "agent");
            asm volatile("s_waitcnt vmcnt(0)" ::: "memory");
            const unsigned og = xb_add(&bar[XB_TOP], 1u);
            const unsigned tg = og / nx;
            if (og + 1u == (tg + 1u) * nx) xb_add(&bar[XB_TOPGEN], 1u);
            else XB_SPIN(xb_ld(&bar[XB_TOPGEN]) == tg, bar);
            __builtin_amdgcn_fence(__ATOMIC_ACQUIRE, "agent");
            xb_add(&bar[XB_XGEN(b.x)], 1u);
            asm volatile("s_waitcnt vmcnt(0)" ::: "memory");
        } else {
            XB_SPIN(xb_ld(&bar[XB_XGEN(b.x)]) == gen, bar);
            __builtin_amdgcn_fence(__ATOMIC_ACQUIRE, "agent");
            asm volatile("s_waitcnt vmcnt(0)" ::: "memory");
        }
    }
    __syncthreads();
}
namespace pg8 {
constexpr int BM = 256, BK = 64, HALF = 128, HTB = HALF * BK * 2, STAGE_BYTES = 8 * HTB, NXCD = 8, WGM = 8;
__host__ __device__ __forceinline__ int lds_byte(int r, int c) { const int st = (r >> 4) * 2 + (c >> 5), rr = r & 15, cc = c & 31, ob = rr * 64 + cc * 2; return st * 1024 + (ob ^ (((ob >> 9) & 1) << 5)); }
__host__ __device__ __forceinline__ void stage_rc(int b, int& R, int& C) { const int st = b / 1024, sb = b % 1024, swz = sb ^ (((sb >> 9) & 1) << 5); R = (st >> 1) * 16 + swz / 64; C = (st & 1) * 32 + (swz % 64) / 2; }
__host__ __device__ __forceinline__ int perm32(int rho) { const int n = rho >> 4, i = rho & 15; return 8 * (i >> 2) + 4 * n + (i & 3); }

struct Unit { int pm, pn; };
struct Gemm { const bf16_t* A; const bf16_t* Bt; int M, N, K; };

struct StaticOrder {
    int nM, nN, nwg, G, c;
    __host__ __device__ void init(int M, int N, int G_, int c_) { nM = M / BM; nN = N / BM; nwg = nM * nN; G = G_; c = c_; }
    __host__ __device__ bool next(int i, Unit& u) const {
        const long L = (long)i * G + c; if (L >= nwg) return false;
        int wgid = (int)L; { const int q = nwg / NXCD, r = nwg % NXCD, xcd = wgid % NXCD, off = wgid / NXCD; wgid = (xcd < r ? xcd * (q + 1) : r * (q + 1) + (xcd - r) * q) + off; }
        const int nig = WGM * nN, gid = wgid / nig, fm = gid * WGM, gsz = (nM - fm) < WGM ? (nM - fm) : WGM;
        u.pm = fm + ((wgid % nig) % gsz); u.pn = (wgid % nig) / gsz; return true;
    }
    __device__ __forceinline__ void a_ready(const Unit&) const {}
    __device__ __forceinline__ void done(const Unit&) const {}
};
struct MoeOrder {
    int ntiles, nN, G, c; const LAS int* tile_e;
    __device__ __forceinline__ bool next(int i, Unit& u) const {
        const long L = (long)i * G + c; if (L >= (long)ntiles * nN) return false;
        const int rt = (int)(L / nN), ct = (int)(L % nN); u.pm = rt; u.pn = tile_e[rt] * nN + ct; return true;
    }
    __device__ __forceinline__ void a_ready(const Unit&) const {}
    __device__ __forceinline__ void done(const Unit&) const {}
};

typedef f32x4 Acc[2][2][4][2];

struct EpiInProj {
    static constexpr bool PERM = true, AFTER_DRAIN = false, HAS_MID = false; static constexpr int MID0 = -1, MID1 = -1;
    bf16_t* P1; bf16_t* MO; bf16_t* G; float* GRAW;
    __device__ __forceinline__ void mid(Acc&, const Unit&, int, int, int, int, int) const {}
    __device__ __forceinline__ void operator()(const Acc& acc, const Unit& u, int wr, int wc, int fr, int fq) const {
        const int row0 = u.pm * BM + wr * 64 + fr, pn = u.pn;
        if (pn == 42) {
            if (wc == 0 && fq < 2) {
#pragma unroll
                for (int ai = 0; ai < 2; ++ai)
#pragma unroll
                    for (int m = 0; m < 4; ++m) { float* rowp = GRAW + (size_t)(row0 + ai * HALF + m * 16) * 16 + 8 * fq;
                        *(f32x4*)(rowp) = acc[ai][0][m][0]; *(f32x4*)(rowp + 4) = acc[ai][0][m][1]; }
            }
            return;
        }
        bf16_t* base; int ldc, colt; bool sig;
        if (pn < 12) { base = P1; ldc = 4096; colt = pn * BM; sig = false; }
        else if (pn < 14) { base = MO; ldc = 512; colt = (pn - 12) * BM; sig = true; }
        else if (pn < 18) { base = P1; ldc = 4096; colt = 3072 + (pn - 14) * BM; sig = false; }
        else { base = G; ldc = 6144; colt = (pn - 18) * BM; sig = true; }
        const int col0 = colt + wc * 32 + 8 * fq;
#pragma unroll
        for (int ai = 0; ai < 2; ++ai)
#pragma unroll
            for (int m = 0; m < 4; ++m) { bf16_t* rowp = base + (size_t)(row0 + ai * HALF + m * 16) * ldc + col0;
#pragma unroll
                for (int bj = 0; bj < 2; ++bj) { f32x4 v0 = acc[ai][bj][m][0], v1 = acc[ai][bj][m][1];
                    if (sig) {
#pragma unroll
                        for (int j = 0; j < 4; ++j) { v0[j] = fmaxf(sigmoidf_(v0[j]), 1e-6f); v1[j] = fmaxf(sigmoidf_(v1[j]), 1e-6f); } }
                    u32x4 w; w.x = cvt_pk_bf16(v0[0], v0[1]); w.y = cvt_pk_bf16(v0[2], v0[3]); w.z = cvt_pk_bf16(v1[0], v1[1]); w.w = cvt_pk_bf16(v1[2], v1[3]);
                    *(u32x4*)(rowp + bj * HALF) = w; } }
    }
};
struct EpiBranch {
    static constexpr bool PERM = true, AFTER_DRAIN = false, HAS_MID = true; static constexpr int MID0 = 16, MID1 = 24;
    const bf16_t* G; bf16_t* Y;
    __device__ __forceinline__ void mid(Acc& acc, const Unit& u, int t, int wr, int wc, int fr_, int fq_) const {
        const int fr = opaque(fr_), fq = opaque(fq_);
        const int row0 = u.pm * BM + wr * 64 + fr, col0 = u.pn * BM + wc * 32 + 8 * fq;
        const int cn = (t == 16) ? 0 : 2048;
#pragma unroll
        for (int ai = 0; ai < 2; ++ai)
#pragma unroll
            for (int m = 0; m < 4; ++m) { const bf16_t* rowp = G + (size_t)(row0 + ai * HALF + m * 16) * 6144 + col0 + cn;
#pragma unroll
                for (int bj = 0; bj < 2; ++bj) { const u32x4 a = *(const u32x4*)(rowp + bj * HALF), b = *(const u32x4*)(rowp + bj * HALF + 2048);
                    f32x4 r0, r1;
                    r0[0] = bflo(a.x) * __builtin_amdgcn_rcpf(bflo(b.x)); r0[1] = bfhi(a.x) * __builtin_amdgcn_rcpf(bfhi(b.x));
                    r0[2] = bflo(a.y) * __builtin_amdgcn_rcpf(bflo(b.y)); r0[3] = bfhi(a.y) * __builtin_amdgcn_rcpf(bfhi(b.y));
                    r1[0] = bflo(a.z) * __builtin_amdgcn_rcpf(bflo(b.z)); r1[1] = bfhi(a.z) * __builtin_amdgcn_rcpf(bfhi(b.z));
                    r1[2] = bflo(a.w) * __builtin_amdgcn_rcpf(bflo(b.w)); r1[3] = bfhi(a.w) * __builtin_amdgcn_rcpf(bfhi(b.w));
                    acc[ai][bj][m][0] *= r0; acc[ai][bj][m][1] *= r1; }
                asm volatile("" ::: "memory"); }
    }
    __device__ __forceinline__ void operator()(const Acc& acc, const Unit& u, int wr, int wc, int fr, int fq) const {
        const int row0 = u.pm * BM + wr * 64 + fr, col0 = u.pn * BM + wc * 32 + 8 * fq;
#pragma unroll
        for (int ai = 0; ai < 2; ++ai)
#pragma unroll
            for (int m = 0; m < 4; ++m) { const size_t r = (size_t)(row0 + ai * HALF + m * 16);
#pragma unroll
                for (int bj = 0; bj < 2; ++bj) { const u32x4 g = *(const u32x4*)(G + r * 6144 + 4096 + col0 + bj * HALF);
                    const f32x4 v0 = acc[ai][bj][m][0], v1 = acc[ai][bj][m][1];
                    u32x4 w; w.x = cvt_pk_bf16(v0[0] * bflo(g.x), v0[1] * bfhi(g.x)); w.y = cvt_pk_bf16(v0[2] * bflo(g.y), v0[3] * bfhi(g.y));
                    w.z = cvt_pk_bf16(v1[0] * bflo(g.z), v1[1] * bfhi(g.z)); w.w = cvt_pk_bf16(v1[2] * bflo(g.w), v1[3] * bfhi(g.w));
                    *(u32x4*)(Y + r * 2048 + col0 + bj * HALF) = w; }
                asm volatile("" ::: "memory"); }
    }
};
struct EpiOut {
    static constexpr bool PERM = false, AFTER_DRAIN = false, HAS_MID = false; static constexpr int MID0 = -1, MID1 = -1;
    const float* res_lat; const float* res_ctx; float* out_lat; float* out_ctx; const float* modl;
    __device__ __forceinline__ void mid(Acc&, const Unit&, int, int, int, int, int) const {}
    __device__ __forceinline__ void operator()(const Acc& acc, const Unit& u, int wr, int wc, int fr, int fq) const {
        const bool lat = u.pm < 64; const int rbase = lat ? u.pm * BM : (u.pm - 64) * BM;
        const float* res = lat ? res_lat : res_ctx; float* out = lat ? out_lat : out_ctx;
        const float* gv = modl + (size_t)(lat ? (u.pm >> 4) : 4) * 12288 + 4096;
        const int row0 = rbase + wr * 64 + fr, col0 = u.pn * BM + wc * 32 + 4 * fq;
        f32x4 g[2][2];
#pragma unroll
        for (int bj = 0; bj < 2; ++bj)
#pragma unroll
            for (int n = 0; n < 2; ++n) g[bj][n] = *(const f32x4*)(gv + col0 + bj * HALF + n * 16);
#pragma unroll
        for (int ai = 0; ai < 2; ++ai)
#pragma unroll
            for (int m = 0; m < 4; ++m) { const size_t off = (size_t)(row0 + ai * HALF + m * 16) * DM + col0;
#pragma unroll
                for (int bj = 0; bj < 2; ++bj)
#pragma unroll
                    for (int n = 0; n < 2; ++n) { const f32x4 r = *(const f32x4*)(res + off + bj * HALF + n * 16);
                        *(f32x4*)(out + off + bj * HALF + n * 16) = r + g[bj][n] * acc[ai][bj][m][n]; } }
    }
};
struct EpiMoe1 {
    static constexpr bool PERM = true, AFTER_DRAIN = false, HAS_MID = false; static constexpr int MID0 = -1, MID1 = -1;
    bf16_t* MID; const float* wsort;
    __device__ __forceinline__ void mid(Acc&, const Unit&, int, int, int, int, int) const {}
    __device__ __forceinline__ void operator()(const Acc& acc, const Unit& u, int wr, int wc, int fr, int fq) const {
        const int row0 = u.pm * BM + wr * 64 + fr, ct = u.pn & 3, col0 = ct * 128 + wc * 16 + 4 * fq;
#pragma unroll
        for (int ai = 0; ai < 2; ++ai)
#pragma unroll
            for (int m = 0; m < 4; ++m) { const size_t r = (size_t)(row0 + ai * HALF + m * 16); const float w = wsort[r];
#pragma unroll
                for (int bj = 0; bj < 2; ++bj) { const f32x4 a = acc[ai][bj][m][0], up = acc[ai][bj][m][1];
                    u32x2 o; o.x = cvt_pk_bf16(siluf_(a[0]) * up[0] * w, siluf_(a[1]) * up[1] * w); o.y = cvt_pk_bf16(siluf_(a[2]) * up[2] * w, siluf_(a[3]) * up[3] * w);
                    *(u32x2*)(MID + r * DFF + col0 + bj * 64) = o; } }
    }
};
struct EpiMoe2 {
    static constexpr bool PERM = true, AFTER_DRAIN = false, HAS_MID = false; static constexpr int MID0 = -1, MID1 = -1;
    bf16_t* O;
    __device__ __forceinline__ void mid(Acc&, const Unit&, int, int, int, int, int) const {}
    __device__ __forceinline__ void operator()(const Acc& acc, const Unit& u, int wr, int wc, int fr, int fq) const {
        const int row0 = u.pm * BM + wr * 64 + fr, col0 = (u.pn & 7) * BM + wc * 32 + 8 * fq;
#pragma unroll
        for (int ai = 0; ai < 2; ++ai)
#pragma unroll
            for (int m = 0; m < 4; ++m) { bf16_t* rowp = O + (size_t)(row0 + ai * HALF + m * 16) * DM + col0;
#pragma unroll
                for (int bj = 0; bj < 2; ++bj) { const f32x4 v0 = acc[ai][bj][m][0], v1 = acc[ai][bj][m][1];
                    u32x4 w; w.x = cvt_pk_bf16(v0[0], v0[1]); w.y = cvt_pk_bf16(v0[2], v0[3]); w.z = cvt_pk_bf16(v1[0], v1[1]); w.w = cvt_pk_bf16(v1[2], v1[3]);
                    *(u32x4*)(rowp + bj * HALF) = w; } }
    }
};

template <class Epi, class Sched>
__device__ __forceinline__ void gemm_phase(LAS unsigned char* lds, const Gemm g, const Sched& S, const Epi& E, int wave) {
    const int tid = tid_of(wave), wid = wave, lane = tid & 63, wr = wid >> 2, wc = wid & 3, fr = lane & 15, fq = lane >> 4;
    const int K = g.K, nt = K / BK;
    unsigned voffA[2], voffB[2];
#pragma unroll
    for (int i = 0; i < 2; ++i) { int R, C; stage_rc(tid * 16 + i * 8192, R, C); const int Rb = Epi::PERM ? ((R & ~31) + perm32(R & 31)) : R;
        voffA[i] = (unsigned)(R * K + C) * 2u; voffB[i] = (unsigned)(Rb * K + C) * 2u; }
    const size_t kstep = (size_t)(BK * 2);
    const size_t hstep = (size_t)HALF * K * 2;
    const size_t tstep = 2 * hstep;
    const unsigned ldsw = (unsigned)wid * 1024u;
    const int aoff = lds_byte(wr * 64 + fr, fq * 8), boff = lds_byte(wc * 32 + fr, fq * 8);
#define PG8_SA(b, h) (((b) * 2 + (h)) * HTB)
#define PG8_SB(b, h) ((4 + (b) * 2 + (h)) * HTB)
#define PG8_STAGE(bufoff, gbase, voff) do { _Pragma("unroll") for (int _i = 0; _i < 2; ++_i) \
        __builtin_amdgcn_global_load_lds((const unsigned*)((const char*)(gbase) + (voff)[_i]), (LAS unsigned*)(lds + (bufoff) + ldsw + _i * 8192), 16, 0, 0); } while (0)
#define PG8_LDA(dst, b, h) do { _Pragma("unroll") for (int m = 0; m < 4; ++m) _Pragma("unroll") for (int k = 0; k < 2; ++k) dst[m][k] = *(const LAS bf16x8*)(lds + PG8_SA(b, h) + aoff + m * 2048 + k * 1024); } while (0)
#define PG8_LDB(dst, b, h) do { _Pragma("unroll") for (int n = 0; n < 2; ++n) _Pragma("unroll") for (int k = 0; k < 2; ++k) dst[n][k] = *(const LAS bf16x8*)(lds + PG8_SB(b, h) + boff + n * 2048 + k * 1024); } while (0)
#define PG8_MMA(ai, bj, At, Bt) do { __builtin_amdgcn_s_setprio(1); _Pragma("unroll") for (int m = 0; m < 4; ++m) _Pragma("unroll") for (int n = 0; n < 2; ++n) _Pragma("unroll") for (int k = 0; k < 2; ++k) \
        acc[ai][bj][m][n] = __builtin_amdgcn_mfma_f32_16x16x32_bf16(Bt[n][k], At[m][k], acc[ai][bj][m][n], 0, 0, 0); __builtin_amdgcn_s_setprio(0); } while (0)
#define PG8_WAIT_V(n) asm volatile("s_waitcnt vmcnt(" #n ")" ::: "memory")
#define PG8_WAIT_L(n) asm volatile("s_waitcnt lgkmcnt(" #n ")" ::: "memory")
#define PG8_BAR __builtin_amdgcn_s_barrier()
#define PG8_SCHED __builtin_amdgcn_sched_barrier(0)
    Unit cur, nxt; int ui = 0;
    if (!S.next(0, cur)) return;
    f32x4 acc[2][2][4][2];
#pragma unroll
    for (int a = 0; a < 2; ++a)
#pragma unroll
        for (int b = 0; b < 2; ++b)
#pragma unroll
            for (int m = 0; m < 4; ++m)
#pragma unroll
                for (int n = 0; n < 2; ++n) acc[a][b][m][n] = (f32x4){0.f, 0.f, 0.f, 0.f};
    bf16x8 At[4][2], B0[2][2], B1[2][2];
    const char* cA = (const char*)g.A + (size_t)cur.pm * tstep; const char* cB = (const char*)g.Bt + (size_t)cur.pn * tstep;
    S.a_ready(cur);
    PG8_STAGE(PG8_SB(0, 0), cB, voffB); PG8_STAGE(PG8_SB(0, 1), cB + hstep, voffB); PG8_STAGE(PG8_SA(0, 0), cA, voffA); PG8_STAGE(PG8_SA(0, 1), cA + hstep, voffA);
    if (wr == 1) PG8_BAR;
    PG8_WAIT_V(2); PG8_BAR;
    PG8_STAGE(PG8_SB(1, 0), cB + kstep, voffB); PG8_STAGE(PG8_SA(1, 0), cA + kstep, voffA); PG8_STAGE(PG8_SB(1, 1), cB + hstep + kstep, voffB);
    PG8_WAIT_V(6); PG8_BAR;
    for (;;) {
        const bool has_next = S.next(ui + 1, nxt);
        const char* nA = has_next ? (const char*)g.A + (size_t)nxt.pm * tstep : cA; const char* nB = has_next ? (const char*)g.Bt + (size_t)nxt.pn * tstep : cB;
        for (int t = 0; t < nt; t += 2) {
            const bool last = (t == nt - 2);
            const char* a1 = cA + (size_t)(t + 1) * kstep;
            const char* a2 = last ? nA : cA + (size_t)(t + 2) * kstep; const char* b2 = last ? nB : cB + (size_t)(t + 2) * kstep;
            const char* a3 = a2 + kstep; const char* b3 = b2 + kstep;
            if (last && has_next) S.a_ready(nxt);
            if constexpr (Epi::HAS_MID) { if (t == Epi::MID0 || t == Epi::MID1) { E.mid(acc, cur, t, wr, wc, fr, fq); PG8_SCHED; } }
            PG8_LDB(B0, 0, 0); PG8_LDB(B1, 0, 1); PG8_SCHED; PG8_LDA(At, 0, 0); PG8_STAGE(PG8_SA(1, 1), a1 + hstep, voffA);
            PG8_WAIT_V(8); PG8_WAIT_L(0); PG8_BAR; PG8_MMA(0, 0, At, B0); PG8_MMA(0, 1, At, B1); PG8_BAR; PG8_SCHED;
            PG8_LDA(At, 0, 1); PG8_STAGE(PG8_SB(0, 0), b2, voffB); PG8_STAGE(PG8_SB(0, 1), b2 + hstep, voffB); PG8_STAGE(PG8_SA(0, 0), a2, voffA);
            PG8_WAIT_V(8); PG8_WAIT_L(0); PG8_BAR; PG8_MMA(1, 0, At, B0); PG8_MMA(1, 1, At, B1); PG8_BAR; PG8_SCHED;
            PG8_LDB(B0, 1, 0); PG8_LDB(B1, 1, 1); PG8_SCHED; PG8_LDA(At, 1, 0); PG8_STAGE(PG8_SA(0, 1), a2 + hstep, voffA);
            PG8_WAIT_V(8); PG8_WAIT_L(0); PG8_BAR; PG8_MMA(0, 0, At, B0); PG8_MMA(0, 1, At, B1); PG8_BAR; PG8_SCHED;
            PG8_LDA(At, 1, 1); PG8_STAGE(PG8_SB(1, 0), b3, voffB); PG8_STAGE(PG8_SB(1, 1), b3 + hstep, voffB); PG8_STAGE(PG8_SA(1, 0), a3, voffA);
            PG8_WAIT_V(8); PG8_WAIT_L(0); PG8_BAR; PG8_MMA(1, 0, At, B0); PG8_MMA(1, 1, At, B1); PG8_BAR; PG8_SCHED;
        }
        if (wr == 0) PG8_BAR;
        E(acc, cur, wr, wc, fr, fq); S.done(cur);
        if (!has_next) break;
#pragma unroll
        for (int a = 0; a < 2; ++a)
#pragma unroll
            for (int b = 0; b < 2; ++b)
#pragma unroll
                for (int m = 0; m < 4; ++m)
#pragma unroll
                    for (int n = 0; n < 2; ++n) acc[a][b][m][n] = (f32x4){0.f, 0.f, 0.f, 0.f};
        cur = nxt; cA = nA; cB = nB; ++ui;
        if (wr == 1) PG8_BAR;
    }
    PG8_WAIT_V(0);
    PG8_BAR;
#undef PG8_SA
#undef PG8_SB
#undef PG8_STAGE
#undef PG8_LDA
#undef PG8_LDB
#undef PG8_MMA
#undef PG8_WAIT_V
#undef PG8_WAIT_L
#undef PG8_BAR
#undef PG8_SCHED
}
}
namespace att {
constexpr int D = 128, QBLK = 32, KVBLK = 64;
constexpr float SCALE = 0.088388347648318440f;
constexpr float THR = 8.f;
constexpr size_t SHM_V = KVBLK * D * 2, SHM_K = KVBLK * D * 2;
#define KSWZ(row, colB) ((row) * 256 + ((colB) ^ (((row) & 7) << 4)))
#define SBAR() __builtin_amdgcn_sched_barrier(0)
__device__ __forceinline__ int crow(int r, int hi) { return (r & 3) + 8 * (r >> 2) + 4 * hi; }

template <bool MASK>
__device__ __forceinline__ void partialSM(f32x16& p0, f32x16& p1, float& m_reg, float& mn, float& alpha, int dq, int hi) {
  constexpr float C = SCALE * 1.4426950408889634f;
  if (MASK) { if (dq < 100000) { const int dl = dq - 4 * hi - 128, dh = dq - 4 * hi + 128;
#pragma unroll
      for (int r = 0; r < 16; ++r) { const int k0 = (r & 3) + 8 * (r >> 2), k1 = k0 + 32;
        p0[r] = (k0 >= dl && k0 <= dh) ? p0[r] : -1e30f; p1[r] = (k1 >= dl && k1 <= dh) ? p1[r] : -1e30f; } } }
  float pmax = p0[0];
#pragma unroll
  for (int r = 1; r < 16; ++r) pmax = fmaxf(pmax, p0[r]);
#pragma unroll
  for (int r = 0; r < 16; ++r) pmax = fmaxf(pmax, p1[r]);
  { auto rr = __builtin_amdgcn_permlane32_swap(__float_as_uint(pmax), __float_as_uint(pmax), false, false);
    pmax = fmaxf(__uint_as_float(rr[0]), __uint_as_float(rr[1])); }
  if (__builtin_expect(__all(pmax - m_reg <= THR / SCALE), 1)) { mn = m_reg; alpha = 1.f; }
  else { mn = fmaxf(m_reg, pmax); alpha = __builtin_amdgcn_exp2f((m_reg - mn) * C); m_reg = mn; }
  float mnC = -mn * C;
#pragma unroll
  for (int r = 0; r < 16; ++r) p0[r] = fmaf(p0[r], C, mnC);
#pragma unroll
  for (int r = 0; r < 16; ++r) p1[r] = fmaf(p1[r], C, mnC);
#pragma unroll
  for (int r = 0; r < 16; ++r) p0[r] = __builtin_amdgcn_exp2f(p0[r]);
}
#define PK4(P, BASE, OUT) do { unsigned a0 = cvt_pk_bf16(P[BASE + 0], P[BASE + 1]), a1 = cvt_pk_bf16(P[BASE + 2], P[BASE + 3]);   \
    unsigned b0 = cvt_pk_bf16(P[BASE + 4], P[BASE + 5]), b1 = cvt_pk_bf16(P[BASE + 6], P[BASE + 7]);                              \
    auto r0 = __builtin_amdgcn_permlane32_swap(a0, b0, false, false); auto r1 = __builtin_amdgcn_permlane32_swap(a1, b1, false, false); \
    u32x4 w = {r0[0], r1[0], r0[1], r1[1]}; OUT = *reinterpret_cast<bf16x8*>(&w); } while (0)
__device__ __forceinline__ void finishSM(f32x16& p0, f32x16& p1, float alpha, float& l_reg, bf16x8& pa0, bf16x8& pa1, bf16x8& pa2, bf16x8& pa3) {
#pragma unroll
  for (int r = 0; r < 16; ++r) p1[r] = __builtin_amdgcn_exp2f(p1[r]);
  float ps = 0;
#pragma unroll
  for (int r = 0; r < 16; ++r) ps += p0[r];
#pragma unroll
  for (int r = 0; r < 16; ++r) ps += p1[r];
  { auto rr = __builtin_amdgcn_permlane32_swap(__float_as_uint(ps), __float_as_uint(ps), false, false);
    ps = __uint_as_float(rr[0]) + __uint_as_float(rr[1]); }
  l_reg = l_reg * alpha + ps;
  PK4(p0, 0, pa0); PK4(p0, 8, pa1); PK4(p1, 0, pa2); PK4(p1, 8, pa3);
}
__device__ __forceinline__ void qkt(f32x16& p0, f32x16& p1, const LAS char* Ks, const bf16x8* qr, int r32, int hi) {
  p0 = f32x16{}; p1 = f32x16{};
#pragma unroll
  for (int d0 = 0; d0 < 8; ++d0) { int cb = (d0 * 16 + hi * 8) * 2;
    bf16x8 b0 = *reinterpret_cast<const LAS bf16x8*>(Ks + KSWZ(r32, cb));
    bf16x8 b1 = *reinterpret_cast<const LAS bf16x8*>(Ks + KSWZ(32 + r32, cb));
    p0 = __builtin_amdgcn_mfma_f32_32x32x16_bf16(b0, qr[d0], p0, 0, 0, 0);
    p1 = __builtin_amdgcn_mfma_f32_32x32x16_bf16(b1, qr[d0], p1, 0, 0, 0); }
}
__device__ __forceinline__ int v_st(int k, int c) { const int kk = (k & ~0xC) | ((k & 4) << 1) | ((k & 8) >> 1); return ((kk >> 3) * 4 + (c >> 5)) * 512 + ((kk & 7) * 32 + (c & 31)) * 2; }
__device__ __forceinline__ int v_rd_base(int lane) { return ((lane & 3) << 3) | (((lane >> 2) & 3) << 6) | (((lane >> 4) & 1) << 5) | (((lane >> 5) & 1) << 8); }
constexpr int v_rd_off(int d0, int ks, int half) { return d0 * 512 + ks * 4096 + half * 2048; }
template <int OFF> __device__ __forceinline__ s16x4 tr_read(int vb) {
  s16x4 r; asm volatile("ds_read_b64_tr_b16 %0, %1 offset:%2" : "=&v"(r) : "v"(vb), "i"(OFF) : "memory"); return r;
}
#define PKV(L, H) (bf16x8){L[0], L[1], L[2], L[3], H[0], H[1], H[2], H[3]}
template <int D0> __device__ __forceinline__ void pv_one(f32x16& od, int vb, bf16x8 pa0, bf16x8 pa1, bf16x8 pa2, bf16x8 pa3) {
  const s16x4 l0 = tr_read<v_rd_off(D0, 0, 0)>(vb), h0 = tr_read<v_rd_off(D0, 0, 1)>(vb), l1 = tr_read<v_rd_off(D0, 1, 0)>(vb), h1 = tr_read<v_rd_off(D0, 1, 1)>(vb);
  const s16x4 l2 = tr_read<v_rd_off(D0, 2, 0)>(vb), h2 = tr_read<v_rd_off(D0, 2, 1)>(vb), l3 = tr_read<v_rd_off(D0, 3, 0)>(vb), h3 = tr_read<v_rd_off(D0, 3, 1)>(vb);
  asm volatile("s_waitcnt lgkmcnt(0)" ::: "memory"); SBAR();
  od = __builtin_amdgcn_mfma_f32_32x32x16_bf16(pa0, PKV(l0, h0), od, 0, 0, 0);
  od = __builtin_amdgcn_mfma_f32_32x32x16_bf16(pa1, PKV(l1, h1), od, 0, 0, 0);
  od = __builtin_amdgcn_mfma_f32_32x32x16_bf16(pa2, PKV(l2, h2), od, 0, 0, 0);
  od = __builtin_amdgcn_mfma_f32_32x32x16_bf16(pa3, PKV(l3, h3), od, 0, 0, 0);
}
__device__ __forceinline__ void pv_d0(f32x16* o, int vb, bf16x8 pa0, bf16x8 pa1, bf16x8 pa2, bf16x8 pa3) {
  pv_one<0>(o[0], vb, pa0, pa1, pa2, pa3); pv_one<1>(o[1], vb, pa0, pa1, pa2, pa3); pv_one<2>(o[2], vb, pa0, pa1, pa2, pa3); pv_one<3>(o[3], vb, pa0, pa1, pa2, pa3);
}

struct Args { const bf16_t* Q; const bf16_t* K; const bf16_t* V; bf16_t* O; int ldo, n0, base0, base1, NT, qpos0; float m_init, l_init; };
template <bool MASK>
__device__ __forceinline__ void attn_body(const Args a, LAS char* lds, int wave) {
  const int tid = tid_of(wave), wid = wave, lane = tid & 63, r32 = lane & 31, hi = lane >> 5;
  LAS char* V_lds = lds; LAS char* K_lds = lds + 2 * SHM_V;
  LAS float* ws = (LAS float*)(lds + 2 * SHM_V + 2 * SHM_K) + wid * 64; LAS float* li_l = ws; LAS float* al_l = ws + 32;
  float m_reg = a.m_init, l_reg = a.l_init; f32x16 o[4] = {}; bf16x8 qr[8];
  const bf16_t* Qw = a.Q + (long)(wid * QBLK + r32) * D + hi * 8;
#pragma unroll
  for (int d0 = 0; d0 < 8; ++d0) qr[d0] = *reinterpret_cast<const bf16x8*>(Qw + d0 * 16);
  const int sr = tid >> 4, sc = (tid & 15) * 8, vst0 = v_st(sr, sc), vst1 = v_st(32 + sr, sc);
  const int vb0 = (int)(unsigned)(uintptr_t)V_lds + v_rd_base(lane);
  const int qpos = a.qpos0 + wid * QBLK + r32;
  struct { bf16x8 vs0, vs1, ks0, ks1; } sr_[2];
#define KROW(j) (((j) < a.n0) ? (a.base0 + 64 * (j)) : (a.base1 + 64 * ((j) - a.n0)))
#define DQ(j) (((j) < a.n0) ? (qpos - (a.base0 + 64 * (j))) : 1000000)
#define SLOAD(i, j) do { const long k0_ = KROW(j); sr_[i].vs0 = *reinterpret_cast<const bf16x8*>(&a.V[(k0_ + sr) * D + sc]); sr_[i].vs1 = *reinterpret_cast<const bf16x8*>(&a.V[(k0_ + 32 + sr) * D + sc]); \
    sr_[i].ks0 = *reinterpret_cast<const bf16x8*>(&a.K[(k0_ + sr) * D + sc]); sr_[i].ks1 = *reinterpret_cast<const bf16x8*>(&a.K[(k0_ + 32 + sr) * D + sc]); } while (0)
#define SWRITE(b, i) do { *(LAS bf16x8*)(V_lds + (b) * SHM_V + vst0) = sr_[i].vs0;          \
    *(LAS bf16x8*)(V_lds + (b) * SHM_V + vst1) = sr_[i].vs1; int kc = sc * 2;               \
    *(LAS bf16x8*)(K_lds + (b) * SHM_K + KSWZ(sr, kc)) = sr_[i].ks0;                       \
    *(LAS bf16x8*)(K_lds + (b) * SHM_K + KSWZ(32 + sr, kc)) = sr_[i].ks1; } while (0)
#define SWAIT() asm volatile("s_waitcnt vmcnt(4)" ::: "memory")
#define RESC(al) do { if (__any((al) < 1.f)) { if (hi == 0) al_l[r32] = (al); asm volatile("s_waitcnt lgkmcnt(0)" ::: "memory"); \
    _Pragma("unroll") for (int d = 0; d < 4; ++d) _Pragma("unroll") for (int r = 0; r < 16; ++r) o[d][r] *= al_l[crow(r, hi)]; } } while (0)
  f32x16 pA0, pA1, pB0, pB1; float mnA, mnB, alA, alB; bf16x8 pa0, pa1, pa2, pa3; const int NT = a.NT;
  constexpr int SE = 0, SO = 1;
  SLOAD(SE, 0); asm volatile("s_waitcnt vmcnt(0)" ::: "memory"); SWRITE(0, SE); __syncthreads();
  qkt(pA0, pA1, K_lds, qr, r32, hi); partialSM<MASK>(pA0, pA1, m_reg, mnA, alA, DQ(0), hi);
  SLOAD(SO, 1); if (2 < NT) SLOAD(SE, 2);
  SWAIT(); SWRITE(1, SO); __syncthreads();
  for (int j = 1; j + 1 < NT; j += 2) {
    SBAR(); qkt(pB0, pB1, K_lds + SHM_K, qr, r32, hi);
    finishSM(pA0, pA1, alA, l_reg, pa0, pa1, pa2, pa3); SBAR();
    SLOAD(SO, j + 2); SBAR();
    pv_d0(o, vb0, pa0, pa1, pa2, pa3); partialSM<MASK>(pB0, pB1, m_reg, mnB, alB, DQ(j), hi);
    __syncthreads(); SWAIT(); SWRITE(0, SE);
    RESC(alB); __syncthreads();
    SBAR(); qkt(pA0, pA1, K_lds, qr, r32, hi);
    finishSM(pB0, pB1, alB, l_reg, pa0, pa1, pa2, pa3); SBAR();
    if (j + 3 < NT) SLOAD(SE, j + 3); SBAR();
    pv_d0(o, vb0 + (int)SHM_V, pa0, pa1, pa2, pa3); partialSM<MASK>(pA0, pA1, m_reg, mnA, alA, DQ(j + 1), hi);
    __syncthreads(); SWAIT(); SWRITE(1, SO);
    RESC(alA); __syncthreads();
  }
  SBAR(); qkt(pB0, pB1, K_lds + SHM_K, qr, r32, hi);
  finishSM(pA0, pA1, alA, l_reg, pa0, pa1, pa2, pa3); SBAR();
  pv_d0(o, vb0, pa0, pa1, pa2, pa3); partialSM<MASK>(pB0, pB1, m_reg, mnB, alB, DQ(NT - 1), hi);
  __syncthreads(); RESC(alB);
  finishSM(pB0, pB1, alB, l_reg, pa0, pa1, pa2, pa3); SBAR();
  pv_d0(o, vb0 + (int)SHM_V, pa0, pa1, pa2, pa3);
  if (hi == 0) li_l[r32] = l_reg; asm volatile("s_waitcnt lgkmcnt(0)" ::: "memory");
  float rli[16];
#pragma unroll
  for (int r = 0; r < 16; ++r) rli[r] = __builtin_amdgcn_rcpf(li_l[crow(r, hi)]);
  bf16_t* Ow = a.O + (long)(wid * QBLK) * a.ldo;
#pragma unroll
  for (int r = 0; r < 16; ++r) { int orow = crow(r, hi);
#pragma unroll
    for (int d0 = 0; d0 < 4; ++d0) { const float v = o[d0][r] * rli[r]; Ow[(long)orow * a.ldo + d0 * 32 + r32] = (bf16_t)(cvt_pk_bf16(v, v) & 0xffffu); } }
  __syncthreads();
#undef KROW
#undef DQ
#undef SLOAD
#undef SWRITE
#undef SWAIT
#undef RESC
}
}
namespace ml {
using namespace att;
struct Args { const bf16_t* Q; const bf16_t* K; const bf16_t* V; const float* GI; const float* GF; float* HM; int dir, ctx_out; };
constexpr int G_A = 0, G_M = 512, G_EBM = 1024, G_WINT = 1536, G_WK = 2048, G_STRIDE = 2560;
constexpr int SM_N = 5120, SM_RDEN = 5632, SM_SCAL = 6656, SM_NACC = 6720;

__device__ __forceinline__ void chunk_map(int c, int dir, int& P0, int& sgn) {
  const int cc = c < 2 ? c : c - 2, pbase = c < 2 ? SEQ : 0, nseg = c < 2 ? CTXL : SEQ;
  if (dir == 0) { P0 = pbase + cc * 128; sgn = 1; } else { P0 = pbase + nseg - 1 - cc * 128; sgn = -1; }
}
__device__ __forceinline__ float scan_add(float x, int lane) {
#pragma unroll
  for (int o = 1; o < 64; o <<= 1) { const float t = __int_as_float(__builtin_amdgcn_ds_bpermute((lane - o) << 2, __float_as_int(x))); if (lane >= o) x += t; }
  return x;
}
__device__ __forceinline__ float scan_max(float x, int lane) {
#pragma unroll
  for (int o = 1; o < 64; o <<= 1) { const float t = __int_as_float(__builtin_amdgcn_ds_bpermute((lane - o) << 2, __float_as_int(x))); if (lane >= o) x = fmaxf(x, t); }
  return x;
}
__device__ __forceinline__ void gate_tables(LAS char* gt, LAS float* scal, float ig0, float ig1, float lf0, float lf1, float m_prev, int lane) {
  float b0 = scan_add(lf0, lane); const float t0 = __int_as_float(__builtin_amdgcn_readlane(__float_as_int(b0), 63)); float b1 = scan_add(lf1, lane) + t0;
  const float a0 = ig0 - b0, a1 = ig1 - b1;
  float A0 = scan_max(a0, lane); const float tA = __int_as_float(__builtin_amdgcn_readlane(__float_as_int(A0), 63)); float A1 = fmaxf(scan_max(a1, lane), tA);
  const float M0 = fmaxf(m_prev, A0), M1 = fmaxf(m_prev, A1), Ml = __int_as_float(__builtin_amdgcn_readlane(__float_as_int(M1), 63)), bl = __int_as_float(__builtin_amdgcn_readlane(__float_as_int(b1), 63));
  LAS float* fa = (LAS float*)(gt + G_A); LAS float* fM = (LAS float*)(gt + G_M); LAS float* fe = (LAS float*)(gt + G_EBM); LAS float* fw = (LAS float*)(gt + G_WINT); LAS float* fk = (LAS float*)(gt + G_WK);
  fa[lane] = a0; fa[64 + lane] = a1; fM[lane] = M0; fM[64 + lane] = M1;
  fe[lane] = __expf(-(b0 + M0)); fe[64 + lane] = __expf(-(b1 + M1));
  fw[lane] = __expf(m_prev - M0); fw[64 + lane] = __expf(m_prev - M1);
  fk[lane] = __expf(a0 - Ml); fk[64 + lane] = __expf(a1 - Ml);
  if (lane == 0) { scal[0] = __expf(m_prev - Ml); scal[1] = bl + Ml; }
}

__device__ __forceinline__ void mlstm_seq(const Args a, LAS char* lds, int wave) {
  int tid = tid_of(wave); const int wid = wave, jb = wid & 3, eh = wid >> 2;
  int lane = tid & 63, r32 = lane & 31, hi = lane >> 5;
  LAS char* K_lds = lds; LAS char* V_lds = lds + 32768; LAS char* KW_lds = lds + 65536; LAS char* C_lds = lds + 98304; LAS char* sm = lds + ML_SM;
  LAS float* n_lds = (LAS float*)(sm + SM_N); LAS float* rden = (LAS float*)(sm + SM_RDEN) + wid * 32;
  LAS float* nacc = (LAS float*)(sm + SM_NACC);
  f32x16 cst[2] = {};
  for (int i = tid; i < 2048; i += NTHR) ((LAS u32x4*)C_lds)[i] = (u32x4){0u, 0u, 0u, 0u};
  if (tid < 128) { n_lds[tid] = 0.f; nacc[tid] = 0.f; nacc[128 + tid] = 0.f; }
  __syncthreads();
  int sr = tid >> 4, sc = (tid & 15) * 8;
  int vbV = (int)(unsigned)(uintptr_t)V_lds + v_rd_base(lane) + eh * 1024;
  int vbC = (int)(unsigned)(uintptr_t)C_lds + v_rd_base(lane) + eh * 1024;
  int vbKW = (int)(unsigned)(uintptr_t)KW_lds + v_rd_base(lane) + jb * 512;
  bf16x8 qr[8]; bf16x8 stK[4], stV[4];
  float gi0 = 0.f, gi1 = 0.f, gf0 = 0.f, gf1 = 0.f;
  constexpr int NCH = 34;
#define ML_LOADKV(c) do { int P0_, sg_; chunk_map((c), a.dir, P0_, sg_); _Pragma("unroll") for (int i = 0; i < 4; ++i) { const long pos = P0_ + sg_ * (sr + 32 * i); \
    stK[i] = *reinterpret_cast<const bf16x8*>(a.K + pos * 128 + sc); stV[i] = *reinterpret_cast<const bf16x8*>(a.V + pos * 128 + sc); } } while (0)
#define ML_LOADQ(c) do { int P0_, sg_; chunk_map((c), a.dir, P0_, sg_); const long pos = P0_ + sg_ * (jb * 32 + r32); \
    _Pragma("unroll") for (int d0 = 0; d0 < 8; ++d0) qr[d0] = *reinterpret_cast<const bf16x8*>(a.Q + pos * 128 + d0 * 16 + hi * 8); } while (0)
#define ML_LOADG(c) do { int P0_, sg_; chunk_map((c), a.dir, P0_, sg_); gi0 = a.GI[P0_ + sg_ * lane]; gi1 = a.GI[P0_ + sg_ * (64 + lane)]; gf0 = a.GF[P0_ + sg_ * lane]; gf1 = a.GF[P0_ + sg_ * (64 + lane)]; } while (0)
#define ML_WRITEKV(gt, nac) do { const LAS float* fk_ = (const LAS float*)((gt) + G_WK); float cs_[8] = {0.f, 0.f, 0.f, 0.f, 0.f, 0.f, 0.f, 0.f}; _Pragma("unroll") for (int i = 0; i < 4; ++i) { const int s = sr + 32 * i, tl = s >> 6, rr = s & 63; \
    *(LAS bf16x8*)(K_lds + tl * 16384 + KSWZ(rr, sc * 2)) = stK[i]; *(LAS bf16x8*)(V_lds + tl * 16384 + v_st(rr, sc)) = stV[i]; \
    const float w_ = fk_[s]; const u32x4 kk = *reinterpret_cast<const u32x4*>(&stK[i]); u32x4 o_; \
    o_.x = cvt_pk_bf16(bflo(kk.x) * w_, bfhi(kk.x) * w_); o_.y = cvt_pk_bf16(bflo(kk.y) * w_, bfhi(kk.y) * w_); o_.z = cvt_pk_bf16(bflo(kk.z) * w_, bfhi(kk.z) * w_); o_.w = cvt_pk_bf16(bflo(kk.w) * w_, bfhi(kk.w) * w_); \
    cs_[0] += bflo(o_.x); cs_[1] += bfhi(o_.x); cs_[2] += bflo(o_.y); cs_[3] += bfhi(o_.y); cs_[4] += bflo(o_.z); cs_[5] += bfhi(o_.z); cs_[6] += bflo(o_.w); cs_[7] += bfhi(o_.w); \
    *(LAS u32x4*)(KW_lds + tl * 16384 + v_st(rr, sc)) = o_; } \
    _Pragma("unroll") for (int i = 0; i < 8; ++i) (void)__hip_atomic_fetch_add((nac) + sc + i, cs_[i], __ATOMIC_RELAXED, __HIP_MEMORY_SCOPE_WORKGROUP); } while (0)
  if (wid == 0) { ML_LOADG(0); gate_tables(sm, (LAS float*)(sm + SM_SCAL), gi0, gi1, gf0, gf1, -1e30f, lane); ML_LOADG(1); }
  ML_LOADKV(0); ML_LOADQ(0);
  __syncthreads();
  ML_WRITEKV(sm, nacc);
  __syncthreads();
  for (int c = 0; c < NCH; ++c) {
    asm volatile("" : "+v"(tid)); lane = tid & 63; r32 = lane & 31; hi = lane >> 5; sr = tid >> 4; sc = (tid & 15) * 8;
    vbV = (int)(unsigned)(uintptr_t)V_lds + v_rd_base(lane) + eh * 1024; vbC = (int)(unsigned)(uintptr_t)C_lds + v_rd_base(lane) + eh * 1024; vbKW = (int)(unsigned)(uintptr_t)KW_lds + v_rd_base(lane) + jb * 512;
    const int par = c & 1; LAS char* gt = sm + par * G_STRIDE; LAS char* gtn = sm + (par ^ 1) * G_STRIDE;
    const LAS float* scal = (const LAS float*)(sm + SM_SCAL) + par * 4; LAS float* scaln = (LAS float*)(sm + SM_SCAL) + (par ^ 1) * 4;
    const float decay = scal[0];
    if (c + 1 < NCH) { if (wid == 0) { gate_tables(gtn, scaln, gi0, gi1, gf0, gf1, scal[1], lane); if (c + 2 < NCH) ML_LOADG(c + 2); } }
    const bool want_out = (c >= 2) || (a.ctx_out != 0);
    if (want_out) {
      const LAS float* fa = (const LAS float*)(gt + G_A); const LAS float* fM = (const LAS float*)(gt + G_M); const LAS float* fe = (const LAS float*)(gt + G_EBM); const LAS float* fw = (const LAS float*)(gt + G_WINT);
      const int j = jb * 32 + r32; const float Mj = fM[j], wintj = fw[j];
      f32x16 o[2] = {};
      pv_one<0>(o[0], vbC, qr[0], qr[1], qr[2], qr[3]); pv_one<1>(o[1], vbC, qr[0], qr[1], qr[2], qr[3]);
      pv_one<0>(o[0], vbC + 16384, qr[4], qr[5], qr[6], qr[7]); pv_one<1>(o[1], vbC + 16384, qr[4], qr[5], qr[6], qr[7]);
#pragma unroll
      for (int r = 0; r < 16; ++r) { const float w = fw[jb * 32 + crow(r, hi)]; o[0][r] *= w; o[1][r] *= w; }
      float qn = 0.f;
#pragma unroll
      for (int d0 = 0; d0 < 8; ++d0) { const u32x4 qq = *reinterpret_cast<const u32x4*>(&qr[d0]); const f32x4 n0 = *(const LAS f32x4*)(n_lds + d0 * 16 + hi * 8), n1 = *(const LAS f32x4*)(n_lds + d0 * 16 + hi * 8 + 4);
        qn += bflo(qq.x) * n0[0] + bfhi(qq.x) * n0[1] + bflo(qq.y) * n0[2] + bfhi(qq.y) * n0[3] + bflo(qq.z) * n1[0] + bfhi(qq.z) * n1[1] + bflo(qq.w) * n1[2] + bfhi(qq.w) * n1[3]; }
      { auto rr = __builtin_amdgcn_permlane32_swap(__float_as_uint(qn), __float_as_uint(qn), false, false); qn = __uint_as_float(rr[0]) + __uint_as_float(rr[1]); }
      float den = wintj * qn;
#pragma unroll
      for (int t = 0; t < 2; ++t) {
        if (t * 64 <= jb * 32 + 31) {
          f32x16 p0, p1; qkt(p0, p1, K_lds + t * 16384, qr, r32, hi);
          float ps = 0.f;
#pragma unroll
          for (int r = 0; r < 16; ++r) { const int s0 = t * 64 + crow(r, hi), s1 = s0 + 32;
            const float e0 = __expf(fa[s0] - Mj), e1 = __expf(fa[s1] - Mj);
            p0[r] = (s0 <= j) ? p0[r] * e0 : 0.f; p1[r] = (s1 <= j) ? p1[r] * e1 : 0.f; ps += p0[r] + p1[r]; }
          { auto rr = __builtin_amdgcn_permlane32_swap(__float_as_uint(ps), __float_as_uint(ps), false, false); ps = __uint_as_float(rr[0]) + __uint_as_float(rr[1]); }
          den += ps;
          bf16x8 pa0, pa1, pa2, pa3; PK4(p0, 0, pa0); PK4(p0, 8, pa1); PK4(p1, 0, pa2); PK4(p1, 8, pa3);
          pv_one<0>(o[0], vbV + t * 16384, pa0, pa1, pa2, pa3); pv_one<1>(o[1], vbV + t * 16384, pa0, pa1, pa2, pa3);
        }
      }
      const float rd = __builtin_amdgcn_rcpf(fmaxf(fabsf(den), fe[j]));
      if (hi == 0) rden[r32] = rd;
      asm volatile("s_waitcnt lgkmcnt(0)" ::: "memory");
      float* hp = a.HM + ((size_t)c * 128 + jb * 32 + 4 * hi) * 128 + eh * 64 + r32;
#pragma unroll
      for (int r = 0; r < 16; ++r) { const int jr = (r & 3) + 8 * (r >> 2); const float rv = rden[jr + 4 * hi];
        hp[jr * 128] = o[0][r] * rv; hp[jr * 128 + 32] = o[1][r] * rv; }
    }
    if (c + 1 < NCH) { ML_LOADQ(c + 1); ML_LOADKV(c + 1); }
    if (c + 1 < NCH) {
#pragma unroll
      for (int r = 0; r < 16; ++r) { cst[0][r] *= decay; cst[1][r] *= decay; }
#pragma unroll
      for (int t = 0; t < 2; ++t) {
#define ML_UPD(KS) do { const s16x4 kl = tr_read<v_rd_off(0, KS, 0)>(vbKW + t * 16384), kh = tr_read<v_rd_off(0, KS, 1)>(vbKW + t * 16384); \
        const s16x4 v0l = tr_read<v_rd_off(0, KS, 0)>(vbV + t * 16384), v0h = tr_read<v_rd_off(0, KS, 1)>(vbV + t * 16384); \
        const s16x4 v1l = tr_read<v_rd_off(1, KS, 0)>(vbV + t * 16384), v1h = tr_read<v_rd_off(1, KS, 1)>(vbV + t * 16384); \
        asm volatile("s_waitcnt lgkmcnt(0)" ::: "memory"); SBAR(); \
        const bf16x8 ka = PKV(kl, kh); \
        cst[0] = __builtin_amdgcn_mfma_f32_32x32x16_bf16(ka, PKV(v0l, v0h), cst[0], 0, 0, 0); \
        cst[1] = __builtin_amdgcn_mfma_f32_32x32x16_bf16(ka, PKV(v1l, v1h), cst[1], 0, 0, 0); } while (0)
        ML_UPD(0); ML_UPD(1); ML_UPD(2); ML_UPD(3);
#undef ML_UPD
      }
    }
    __syncthreads();
    if (c + 1 < NCH) {
#pragma unroll
      for (int i = 0; i < 2; ++i)
#pragma unroll
        for (int r = 0; r < 16; ++r) { const int dk = jb * 32 + crow(r, hi), e = (2 * eh + i) * 32 + r32;
          *(LAS bf16_t*)(C_lds + (dk >> 6) * 16384 + v_st(dk & 63, e)) = (bf16_t)(cvt_pk_bf16(cst[i][r], cst[i][r]) & 0xffffu); }
      if (tid < 128) { n_lds[tid] = decay * n_lds[tid] + nacc[par * 128 + tid]; nacc[par * 128 + tid] = 0.f; }
      ML_WRITEKV(gtn, nacc + (par ^ 1) * 128);
    }
    __syncthreads();
  }
#undef ML_LOADKV
#undef ML_LOADQ
#undef ML_LOADG
#undef ML_WRITEKV
}
}
struct Frame {
    char* lds; LAS unsigned char* lds3; volatile LAS unsigned* LC; unsigned* ctl; unsigned char* ws;
    int tid, lane, wave, G, bid;
    const float* const __attribute__((address_space(4)))* karg;
};
__device__ __forceinline__ const float* inp(const Frame& F, int k) { auto p = F.karg; asm volatile("" : "+s"(p)); return p[k]; }
__device__ __forceinline__ float* outp(const Frame& F) { auto p = F.karg; asm volatile("" : "+s"(p)); return (float*)p[28]; }
#define WSP(T, off) ((T*)(F.ws + (off)))

__device__ __forceinline__ void p_mod_partial(Frame& F) {
    float* sv = (float*)F.lds;
    float* MODP = WSP(float, WS_MODP);
    for (int it = F.bid; it < 2 * 16 * 24; it += F.G) {
        const int l = it / 384, ks = (it % 384) / 24, cc = it % 24, k0 = ks * 128, n = cc * 512 + F.tid;
        __syncthreads();
        for (int i = F.tid; i < 640; i += NTHR) { const int r = i >> 7, k = i & 127; const float c = (r < 4) ? inp(F, 1)[r * DM + k0 + k] : inp(F, 3)[k0 + k]; sv[i] = siluf_(c); }
        __syncthreads();
        const float* w = inp(F, 6) + (size_t)l * DM * 12288 + (size_t)k0 * 12288 + n;
        float a0 = 0.f, a1 = 0.f, a2 = 0.f, a3 = 0.f, a4 = 0.f;
#pragma unroll 8
        for (int k = 0; k < 128; ++k) { const float wv = w[(size_t)k * 12288]; a0 += sv[k] * wv; a1 += sv[128 + k] * wv; a2 += sv[256 + k] * wv; a3 += sv[384 + k] * wv; a4 += sv[512 + k] * wv; }
        float* o = MODP + ((size_t)(l * 16 + ks) * 5) * 12288 + n;
        o[0] = a0; o[12288] = a1; o[2 * 12288] = a2; o[3 * 12288] = a3; o[4 * 12288] = a4;
    }
    __syncthreads();
}
__device__ __forceinline__ void p_rope_tables(Frame& F) {
    float* ct = WSP(float, WS_ROPE); float* st = ct + SEQ * 64;
    for (int i = F.bid * NTHR + F.tid; i < SEQ * 64; i += F.G * NTHR) {
        const int t = i >> 6, j = i & 63, ax = j >> 5, f = j & 31;
        const float inv = powf(10000.0f, -(float)(2 * f) / 64.0f);
        const float ang = (float)(ax == 0 ? (t >> 6) : (t & 63)) * inv;
        ct[i] = __cosf(ang); st[i] = __sinf(ang);
    }
}
__device__ __forceinline__ void p_mod_reduce(Frame& F) {
    const float* MODP = WSP(float, WS_MODP); float* MOD = WSP(float, WS_MOD);
    for (int i = F.bid * NTHR + F.tid; i < 2 * 5 * 12288; i += F.G * NTHR) {
        const int l = i / 61440, r = (i % 61440) / 12288, n = i % 12288;
        float s = inp(F, 7)[l * 12288 + n];
#pragma unroll
        for (int ks = 0; ks < 16; ++ks) s += MODP[((size_t)(l * 16 + ks) * 5 + r) * 12288 + n];
        MOD[i] = s;
    }
}
__device__ __forceinline__ void tr_item(const float* src, size_t lds_, int k0, int ns0, int nvalid, bf16_t* dst, size_t ldd, int kd0, int mode, int rowbase, float* scr, int lane) {
    const int cl = lane & 31;
#pragma unroll 8
    for (int i = 0; i < 32; ++i) { const int kk = 2 * i + (lane >> 5); scr[kk * 33 + cl] = (cl < nvalid) ? src[(size_t)(k0 + kk) * lds_ + ns0 + cl] : 0.f; }
    LDS_WAIT(); asm volatile("" ::: "memory");
    const int c = lane & 7;
#pragma unroll
    for (int j = 0; j < 4; ++j) { const int n = (lane >> 3) + 8 * j; const float* s = scr + (8 * c) * 33 + n;
        u32x4 o; o.x = cvt_pk_bf16(s[0 * 33], s[1 * 33]); o.y = cvt_pk_bf16(s[2 * 33], s[3 * 33]); o.z = cvt_pk_bf16(s[4 * 33], s[5 * 33]); o.w = cvt_pk_bf16(s[6 * 33], s[7 * 33]);
        const int drow = mode == 0 ? rowbase + n : rowbase + 8 * (n >> 2) + (n & 3);
        *(u32x4*)(dst + (size_t)drow * ldd + kd0 + 8 * c) = o; }
    LDS_WAIT(); asm volatile("" ::: "memory");
}
__device__ __forceinline__ void p_convert_weights(Frame& F, int l) {
    float* scr = (float*)(F.lds + F.wave * 16384);
    const int gw = F.bid * NWAVES + F.wave, NGW = F.G * NWAVES;
    bf16_t* WIN = WSP(bf16_t, WS_WIN); bf16_t* WBR = WSP(bf16_t, WS_WBR); bf16_t* WOUT = WSP(bf16_t, WS_WOUT); bf16_t* WGU = WSP(bf16_t, WS_WGU); bf16_t* WD = WSP(bf16_t, WS_WD);
    const float* w_in = inp(F, 8) + (size_t)l * DM * PIN;
    const float* w_a = inp(F, 16) + (size_t)l * 1024 * DM; const float* w_m = inp(F, 17) + (size_t)l * 512 * DM; const float* w_c = inp(F, 18) + (size_t)l * 512 * DM;
    const float* w_o = inp(F, 19) + (size_t)l * DM * DM;
    const float* w_g = inp(F, 24) + (size_t)l * NEXP * DM * DFF; const float* w_u = inp(F, 25) + (size_t)l * NEXP * DM * DFF; const float* w_d = inp(F, 26) + (size_t)l * NEXP * DFF * DM;
    constexpr int I_IN = 344 * 32, I_A = 16 * 64, I_M = 8 * 64, I_O = 32 * 64, I_G = NEXP * 32 * 16, I_D = NEXP * 8 * 64;
    constexpr int NIT = I_IN + I_A + 2 * I_M + I_O + 2 * I_G + I_D;
    for (int it = gw; it < NIT; it += NGW) {
        int r = it;
        if (r < I_IN) { const int nb = r >> 5, kb = r & 31;
            int ns0, nv; if (nb < 112) { ns0 = nb * 32; nv = 32; } else if (nb < 336) { ns0 = nb * 32 + 16; nv = 32; } else if (nb == 336) { ns0 = 3584; nv = 16; } else { ns0 = 0; nv = 0; }
            tr_item(w_in, PIN, kb * 64, ns0, nv, WIN, DM, kb * 64, 0, nb * 32, scr, F.lane); continue; } r -= I_IN;
        if (r < I_A) { const int kb = r >> 6, nb = r & 63; tr_item(w_a, DM, kb * 64, nb * 32, 32, WBR, DM, kb * 64, 0, nb * 32, scr, F.lane); continue; } r -= I_A;
        if (r < I_M) { const int kb = r >> 6, nb = r & 63; tr_item(w_m, DM, kb * 64, nb * 32, 32, WBR, DM, 1024 + kb * 64, 0, nb * 32, scr, F.lane); continue; } r -= I_M;
        if (r < I_M) { const int kb = r >> 6, nb = r & 63; tr_item(w_c, DM, kb * 64, nb * 32, 32, WBR, DM, 1536 + kb * 64, 0, nb * 32, scr, F.lane); continue; } r -= I_M;
        if (r < I_O) { const int kb = r >> 6, nb = r & 63; tr_item(w_o, DM, kb * 64, nb * 32, 32, WOUT, DM, kb * 64, 0, nb * 32, scr, F.lane); continue; } r -= I_O;
        if (r < I_G) { const int e = r >> 9, kb = (r >> 4) & 31, fb = r & 15; tr_item(w_g + (size_t)e * DM * DFF, DFF, kb * 64, fb * 32, 32, WGU, DM, kb * 64, 1, e * 1024 + fb * 64, scr, F.lane); continue; } r -= I_G;
        if (r < I_G) { const int e = r >> 9, kb = (r >> 4) & 31, fb = r & 15; tr_item(w_u + (size_t)e * DM * DFF, DFF, kb * 64, fb * 32, 32, WGU, DM, kb * 64, 1, e * 1024 + fb * 64 + 4, scr, F.lane); continue; } r -= I_G;
        { const int e = r >> 9, kb = (r >> 6) & 7, nb = r & 63; tr_item(w_d + (size_t)e * DFF * DM, DM, kb * 64, nb * 32, 32, WD, DFF, kb * 64, 0, e * 2048 + nb * 32, scr, F.lane); }
    }
}

struct RowVec { f32x4 v[8]; };
__device__ __forceinline__ void row_load(RowVec& x, const float* p, int lane) {
#pragma unroll
    for (int j = 0; j < 8; ++j) x.v[j] = *(const f32x4*)(p + (j * 64 + lane) * 4);
}
__device__ __forceinline__ float row_rms(const RowVec& x) {
    float s = 0.f;
#pragma unroll
    for (int j = 0; j < 8; ++j) s += (x.v[j][0] * x.v[j][0] + x.v[j][1] * x.v[j][1]) + (x.v[j][2] * x.v[j][2] + x.v[j][3] * x.v[j][3]);
    return rsqrtf(wave_sum(s) * (1.0f / DM) + EPS);
}
__device__ __forceinline__ void row_add_moe(RowVec& x, const bf16_t* MOEOUT, int d0, int d1, const float* g2, int lane) {
#pragma unroll
    for (int j = 0; j < 8; ++j) { const int c = (j * 64 + lane) * 4;
        const u32x2 a = *(const u32x2*)(MOEOUT + (size_t)d0 * DM + c), b = *(const u32x2*)(MOEOUT + (size_t)d1 * DM + c); const f32x4 g = *(const f32x4*)(g2 + c);
        x.v[j][0] += g[0] * (bflo(a.x) + bflo(b.x)); x.v[j][1] += g[1] * (bfhi(a.x) + bfhi(b.x)); x.v[j][2] += g[2] * (bflo(a.y) + bflo(b.y)); x.v[j][3] += g[3] * (bfhi(a.y) + bfhi(b.y)); }
}
__device__ __forceinline__ void row_modulate(RowVec& x, float rms, const float* ng, const float* sh, const float* sc, int lane) {
#pragma unroll
    for (int j = 0; j < 8; ++j) { const int c = (j * 64 + lane) * 4; const f32x4 g = *(const f32x4*)(ng + c), s = *(const f32x4*)(sc + c), h = *(const f32x4*)(sh + c);
        x.v[j] = (x.v[j] * rms * g) * (s + 1.0f) + h; }
}
__device__ __forceinline__ void row_store_bf16(const RowVec& x, bf16_t* p, int lane) {
#pragma unroll
    for (int j = 0; j < 8; ++j) { u32x2 o; o.x = cvt_pk_bf16(x.v[j][0], x.v[j][1]); o.y = cvt_pk_bf16(x.v[j][2], x.v[j][3]); *(u32x2*)(p + (j * 64 + lane) * 4) = o; }
}
__device__ __forceinline__ void row_store_f32(const RowVec& x, float* p, int lane) {
#pragma unroll
    for (int j = 0; j < 8; ++j) *(f32x4*)(p + (j * 64 + lane) * 4) = x.v[j];
}
__device__ __forceinline__ void p_norm1(Frame& F, int l) {
    const int gw = F.bid * NWAVES + F.wave, NGW = F.G * NWAVES;
    const float* MOD = WSP(float, WS_MOD); bf16_t* H = WSP(bf16_t, WS_H); float* XL = WSP(float, WS_XL); float* XC = WSP(float, WS_XC);
    const bf16_t* MOEOUT = WSP(bf16_t, WS_MOEOUT); const int* SLOTD = (const int*)(F.ws + WS_ROUTE + RT_SLOTD);
    const float* ng = inp(F, 4) + l * DM;
    for (int row = gw; row < NROW; row += NGW) {
        const bool lat = row < NLAT; const int mr = lat ? (row >> 12) : 4;
        RowVec x;
        if (l == 0) row_load(x, lat ? inp(F, 0) + (size_t)row * DM : inp(F, 2) + (size_t)(row - NLAT) * DM, F.lane);
        else { float* xp = lat ? XL + (size_t)row * DM : XC + (size_t)(row - NLAT) * DM; row_load(x, xp, F.lane);
            row_add_moe(x, MOEOUT, SLOTD[row * 2], SLOTD[row * 2 + 1], MOD + (size_t)((l - 1) * 5 + mr) * 12288 + 10240, F.lane); row_store_f32(x, xp, F.lane); }
        const float rms = row_rms(x); const float* m = MOD + (size_t)(l * 5 + mr) * 12288;
        row_modulate(x, rms, ng, m, m + 2048, F.lane);
        row_store_bf16(x, H + (size_t)row * DM, F.lane);
    }
}
__device__ __forceinline__ void p_final(Frame& F) {
    const int gw = F.bid * NWAVES + F.wave, NGW = F.G * NWAVES;
    const float* MOD = WSP(float, WS_MOD); const float* XL = WSP(float, WS_XL);
    const bf16_t* MOEOUT = WSP(bf16_t, WS_MOEOUT); const int* SLOTD = (const int*)(F.ws + WS_ROUTE + RT_SLOTD);
    float* out_ = outp(F); const float* fg_ = inp(F, 27);
    for (int row = gw; row < NLAT; row += NGW) {
        RowVec x; row_load(x, XL + (size_t)row * DM, F.lane);
        row_add_moe(x, MOEOUT, SLOTD[row * 2], SLOTD[row * 2 + 1], MOD + (size_t)(5 + (row >> 12)) * 12288 + 10240, F.lane);
        const float rms = row_rms(x);
#pragma unroll
        for (int j = 0; j < 8; ++j) { const int c = (j * 64 + F.lane) * 4; const f32x4 g = *(const f32x4*)(fg_ + c); *(f32x4*)(out_ + (size_t)row * DM + c) = x.v[j] * rms * g; }
    }
}
__device__ __forceinline__ void p_norm2_route(Frame& F, int l, int nrows) {
    const int gw = F.bid * NWAVES + F.wave, NGW = F.G * NWAVES;
    const float* MOD = WSP(float, WS_MOD); bf16_t* H = WSP(bf16_t, WS_H); const float* XL = WSP(float, WS_XL); const float* XC = WSP(float, WS_XC);
    const float* ng = inp(F, 5) + l * DM; const float* w_rg = inp(F, 20) + (size_t)l * DM * 4; const float* w_re = inp(F, 22) + (size_t)l * DM * 16;
    const float* b_rg = inp(F, 21) + l * 4; const float* b_re = inp(F, 23) + l * 16;
    int* lc = (int*)F.lds;
    if (F.tid < 64) lc[F.tid] = 0;
    __syncthreads();
    for (int row = gw; row < nrows; row += NGW) {
        const bool lat = row < NLAT; const int mr = lat ? (row >> 12) : 4;
        RowVec x; row_load(x, lat ? XL + (size_t)row * DM : XC + (size_t)(row - NLAT) * DM, F.lane);
        const float rms = row_rms(x); const float* m = MOD + (size_t)(l * 5 + mr) * 12288;
        row_modulate(x, rms, ng, m + 6144, m + 8192, F.lane);
        row_store_bf16(x, H + (size_t)row * DM, F.lane);
        float lg[20];
#pragma unroll
        for (int i = 0; i < 20; ++i) lg[i] = 0.f;
        const int lane_o = opaque(F.lane);
#pragma unroll
        for (int j = 0; j < 8; ++j)
#pragma unroll
            for (int i = 0; i < 4; ++i) { const int k = (j * 64 + lane_o) * 4 + i; const float hv = x.v[j][i];
                const f32x4 wg = *(const f32x4*)(w_rg + (size_t)k * 4);
                const f32x4 e0 = *(const f32x4*)(w_re + (size_t)k * 16), e1 = *(const f32x4*)(w_re + (size_t)k * 16 + 4), e2 = *(const f32x4*)(w_re + (size_t)k * 16 + 8), e3 = *(const f32x4*)(w_re + (size_t)k * 16 + 12);
#pragma unroll
                for (int q = 0; q < 4; ++q) { lg[q] += hv * wg[q]; lg[4 + q] += hv * e0[q]; lg[8 + q] += hv * e1[q]; lg[12 + q] += hv * e2[q]; lg[16 + q] += hv * e3[q]; }
                if (i == 3) asm volatile("" ::: "memory"); }
#pragma unroll
        for (int i = 0; i < 20; ++i) lg[i] = wave_sum(lg[i]);
        if (F.lane == 0) {
            const float g0 = lg[0] + b_rg[0], g1 = lg[1] + b_rg[1], g2 = lg[2] + b_rg[2], g3 = lg[3] + b_rg[3];
            int gs = 0; float gm = g0; if (g1 > gm) { gm = g1; gs = 1; } if (g2 > gm) { gm = g2; gs = 2; } if (g3 > gm) { gm = g3; gs = 3; }
            const float pg = 1.0f / (__expf(g0 - gm) + __expf(g1 - gm) + __expf(g2 - gm) + __expf(g3 - gm));
            float el[4];
#pragma unroll
            for (int q = 0; q < 4; ++q) { float v = 0.f;
#pragma unroll
                for (int g = 0; g < 4; ++g) v = (g == gs) ? lg[4 + g * 4 + q] + b_re[g * 4 + q] : v; el[q] = v; }
            int i0 = 0; float m0 = el[0];
#pragma unroll
            for (int q = 1; q < 4; ++q) if (el[q] > m0) { m0 = el[q]; i0 = q; }
            int i1 = -1; float m1 = -3.0e38f;
#pragma unroll
            for (int q = 0; q < 4; ++q) if (q != i0 && el[q] > m1) { m1 = el[q]; i1 = q; }
            const float p1 = __expf(m1 - m0);
            const float w0 = pg / (1.0f + p1), w1 = pg * p1 / (1.0f + p1);
            const int e0 = gs * 4 + i0, e1 = gs * 4 + i1;
            const int n = atomicAdd(&lc[32], 2);
            const int q0 = atomicAdd(&lc[e0], 1), q1 = atomicAdd(&lc[e1], 1);
            int* en = lc + 64 + n * 4;
            en[0] = row * 2; en[1] = e0; en[2] = q0; ((float*)en)[3] = w0;
            en[4] = row * 2 + 1; en[5] = e1; en[6] = q1; ((float*)en)[7] = w1;
        }
    }
    __syncthreads();
    if (F.tid < 16) lc[16 + F.tid] = (int)atomicAdd(F.ctl + CW_ECNT + (l * 16 + F.tid) * 64, (unsigned)lc[F.tid]);
    __syncthreads();
    int* SLOTE = (int*)(F.ws + WS_ROUTE + RT_SLOTE); int* SLOTP = (int*)(F.ws + WS_ROUTE + RT_SLOTP); float* SLOTW = (float*)(F.ws + WS_ROUTE + RT_SLOTW);
    const int ne = lc[32];
    for (int i = F.tid; i < ne; i += NTHR) { const int* en = lc + 64 + i * 4; const int s = en[0], e = en[1]; SLOTE[s] = e; SLOTP[s] = lc[16 + e] + en[2]; SLOTW[s] = ((const float*)en)[3]; }
    __syncthreads();
}
__device__ __forceinline__ int moe_tables(Frame& F, int l) {
    volatile LAS int* T = (volatile LAS int*)(F.LC + LC_TILE);
    __syncthreads();
    if (F.tid == 0) {
        int off = 0, nt = 0;
#pragma unroll 1
        for (int e = 0; e < NEXP; ++e) { const int c = (int)__hip_atomic_load(F.ctl + CW_ECNT + (l * 16 + e) * 64, __ATOMIC_RELAXED, __HIP_MEMORY_SCOPE_AGENT); const int t = (c + 255) >> 8;
            T[160 + e] = off;
#pragma unroll 1
            for (int i = 0; i < t; ++i) T[nt + i] = e;
            nt += t; off += t * 256; }
        T[176] = off; T[180] = nt;
    }
    __syncthreads();
    return T[180];
}
__device__ __forceinline__ void p_gather(Frame& F, int l, int nrows) {
    (void)moe_tables(F, l);
    volatile LAS int* T = (volatile LAS int*)(F.LC + LC_TILE);
    const int gw = F.bid * NWAVES + F.wave, NGW = F.G * NWAVES;
    const int* SLOTE = (const int*)(F.ws + WS_ROUTE + RT_SLOTE); const int* SLOTP = (const int*)(F.ws + WS_ROUTE + RT_SLOTP); const float* SLOTW = (const float*)(F.ws + WS_ROUTE + RT_SLOTW);
    int* SLOTD = (int*)(F.ws + WS_ROUTE + RT_SLOTD); float* WSORT = (float*)(F.ws + WS_ROUTE + RT_WSORT);
    const bf16_t* H = WSP(bf16_t, WS_H); bf16_t* XS = WSP(bf16_t, WS_XS);
    for (int s = gw; s < nrows * 2; s += NGW) {
        const int e = SLOTE[s], d = T[160 + e] + SLOTP[s], row = s >> 1;
        const u32x4* src = (const u32x4*)(H + (size_t)row * DM); u32x4* dst = (u32x4*)(XS + (size_t)d * DM);
        const u32x4 a = src[F.lane], b = src[64 + F.lane], c = src[128 + F.lane], dd = src[192 + F.lane];
        dst[F.lane] = a; dst[64 + F.lane] = b; dst[128 + F.lane] = c; dst[192 + F.lane] = dd;
        if (F.lane == 0) { SLOTD[s] = d; WSORT[d] = SLOTW[s]; }
    }
    for (int i = F.bid * NTHR + F.tid; i < NEXP * 256; i += F.G * NTHR) { const int e = i >> 8, j = i & 255;
        const int c = (int)__hip_atomic_load(F.ctl + CW_ECNT + (l * 16 + e) * 64, __ATOMIC_RELAXED, __HIP_MEMORY_SCOPE_AGENT); const int pad = ((c + 255) & ~255) - c;
        if (j < pad) WSORT[T[160 + e] + c + j] = 0.f; }
}

__device__ __forceinline__ void unpack8(const u32x4 w, float* v) { v[0] = bflo(w.x); v[1] = bfhi(w.x); v[2] = bflo(w.y); v[3] = bfhi(w.y); v[4] = bflo(w.z); v[5] = bfhi(w.z); v[6] = bflo(w.w); v[7] = bfhi(w.w); }
__device__ __forceinline__ u32x4 pack8(const float* v) { u32x4 w; w.x = cvt_pk_bf16(v[0], v[1]); w.y = cvt_pk_bf16(v[2], v[3]); w.z = cvt_pk_bf16(v[4], v[5]); w.w = cvt_pk_bf16(v[6], v[7]); return w; }
__device__ __forceinline__ void p_prep(Frame& F, int l) {
    const bf16_t* P1 = WSP(bf16_t, WS_P1);
    const float* ctab = WSP(float, WS_ROPE); const float* stab = ctab + SEQ * 64;
    const int g = F.tid >> 4, li = F.tid & 15, c0 = g * 128 + li * 8;
    const float* qn = inp(F, 9) + l * HD; const float* kn = inp(F, 10) + l * HD; const float* cw = inp(F, 11) + (size_t)l * 3 * 1024;
    for (int row = F.bid; row < NROW; row += F.G) {
        const bool lat = row < NLAT; const int b = lat ? (row >> 12) : ((row - NLAT) >> 8), t = lat ? (row & 4095) : ((row - NLAT) & 255);
        const int pos = lat ? t : SEQ + t;
        float v[8]; unpack8(*(const u32x4*)(P1 + (size_t)row * 4096 + c0), v);
        bf16_t* dst;
        if (g < 10 || (g >= 24 && g < 30)) {
            const bool isq = (g < 8) || (g >= 24 && g < 28);
            if (g < 10) {
                float s = 0.f;
#pragma unroll
                for (int i = 0; i < 8; ++i) s += v[i] * v[i];
                s += xshfl<1>(s); s += xshfl<2>(s); s += xshfl<4>(s); s += xshfl<8>(s);
                const float r = rsqrtf(s * (1.0f / 128.0f) + EPS); const float* gg = (g < 8 ? qn : kn) + li * 8;
#pragma unroll
                for (int i = 0; i < 8; ++i) v[i] = v[i] * r * gg[i];
            }
            if (lat) {
                const int ax = li >> 3, half = (li >> 2) & 1, f0 = (li & 3) * 8;
                const float* cp = ctab + (size_t)t * 64 + ax * 32 + f0; const float* sp = stab + (size_t)t * 64 + ax * 32 + f0;
#pragma unroll
                for (int i = 0; i < 8; ++i) { const float o = xshfl<4>(v[i]); const float c = cp[i], s = sp[i]; v[i] = half ? (v[i] * c + o * s) : (v[i] * c - o * s); }
            }
            if (g < 8) dst = lat ? WSP(bf16_t, WS_QA) + ((size_t)(b * 8 + g) * SEQ + t) * HD : WSP(bf16_t, WS_QAC) + ((size_t)(b * 8 + g) * CTXL + t) * HD;
            else if (g < 10) dst = WSP(bf16_t, WS_KA) + ((size_t)(b * 2 + (g - 8)) * KVL + pos) * HD;
            else if (g < 28) dst = lat ? WSP(bf16_t, WS_QC) + ((size_t)(b * 4 + (g - 24)) * SEQ + t) * HD : WSP(bf16_t, WS_QCC) + ((size_t)(b * 4 + (g - 24)) * CTXL + t) * HD;
            else dst = WSP(bf16_t, WS_KC) + ((size_t)(b * 2 + (g - 28)) * KVL + pos) * HD;
            (void)isq;
        } else if (g >= 12 && g < 20) {
            const int T = lat ? SEQ : CTXL; const int ch = (g - 12) * 128 + li * 8;
            float vm[8], vp[8];
            if (t > 0) unpack8(*(const u32x4*)(P1 + (size_t)(row - 1) * 4096 + c0), vm); else {
#pragma unroll
                for (int i = 0; i < 8; ++i) vm[i] = 0.f; }
            if (t < T - 1) unpack8(*(const u32x4*)(P1 + (size_t)(row + 1) * 4096 + c0), vp); else {
#pragma unroll
                for (int i = 0; i < 8; ++i) vp[i] = 0.f; }
            const float ksc = (g >= 16) ? 0.088388347648318440f : 1.0f;
#pragma unroll
            for (int i = 0; i < 8; ++i) { const float y = cw[ch + i] * vm[i] + cw[1024 + ch + i] * v[i] + cw[2048 + ch + i] * vp[i]; v[i] = siluf_(y) * ksc; }
            dst = (g < 16 ? WSP(bf16_t, WS_QM) : WSP(bf16_t, WS_KM)) + ((size_t)(b * 4 + ((g - 12) & 3)) * KVL + pos) * HD;
        } else if (g < 12) dst = WSP(bf16_t, WS_VA) + ((size_t)(b * 2 + (g - 10)) * KVL + pos) * HD;
        else if (g < 24) dst = WSP(bf16_t, WS_VM) + ((size_t)(b * 4 + (g - 20)) * KVL + pos) * HD;
        else dst = WSP(bf16_t, WS_VC) + ((size_t)(b * 2 + (g - 30)) * KVL + pos) * HD;
        *(u32x4*)(dst + li * 8) = pack8(v);
    }
    const float* GRAW = WSP(float, WS_GRAW); float* GI = WSP(float, WS_GATE); float* GF = GI + NB * 2 * 4 * KVL;
    const float* igb = inp(F, 12) + l * 8; const float* fgb = inp(F, 13) + l * 8;
    for (int i = F.bid * NTHR + F.tid; i < NROW * 8; i += F.G * NTHR) {
        const int row = i >> 3, dh = i & 7; const bool lat = row < NLAT; const int b = lat ? (row >> 12) : ((row - NLAT) >> 8), pos = lat ? (row & 4095) : SEQ + ((row - NLAT) & 255);
        const float gi = GRAW[(size_t)row * 16 + dh] + igb[dh]; const float xf = GRAW[(size_t)row * 16 + 8 + dh] + fgb[dh];
        const float lf = fminf(xf, 0.f) - log1pf(__expf(-fabsf(xf)));
        GI[(size_t)(b * 8 + dh) * KVL + pos] = gi; GF[(size_t)(b * 8 + dh) * KVL + pos] = lf;
    }
}
__device__ __forceinline__ void p_omprep(Frame& F, int l, int nrows) {
    const float* HM = WSP(float, WS_HM); const bf16_t* MO = WSP(bf16_t, WS_MO); bf16_t* OALL = WSP(bf16_t, WS_OALL);
    const float* mg = inp(F, 14) + l * 512;
    const int li = F.tid & 15;
    for (int it = F.bid * 32 + (F.tid >> 4); it < nrows * 4; it += F.G * 32) {
        const int row = it >> 2, h = it & 3; const size_t o = (size_t)row * 512 + h * 128 + li * 8;
        const bool lat = row < NLAT; const int b = lat ? (row >> 12) : ((row - NLAT) >> 8), t = lat ? (row & 4095) : ((row - NLAT) & 255);
        const int p0 = lat ? CTXL + t : t, p1 = lat ? CTXL + (SEQ - 1 - t) : (CTXL - 1 - t);
        const float* h0 = HM + ((size_t)((0 * 4 + b) * 4 + h) * KVL + p0) * HD + li * 8; const float* h1 = HM + ((size_t)((1 * 4 + b) * 4 + h) * KVL + p1) * HD + li * 8;
        const f32x4 a0 = *(const f32x4*)(h0), a1 = *(const f32x4*)(h0 + 4), b0 = *(const f32x4*)(h1), b1 = *(const f32x4*)(h1 + 4);
        float v[8] = {a0[0] + b0[0], a0[1] + b0[1], a0[2] + b0[2], a0[3] + b0[3], a1[0] + b1[0], a1[1] + b1[1], a1[2] + b1[2], a1[3] + b1[3]};
        float s = 0.f;
#pragma unroll
        for (int i = 0; i < 8; ++i) s += v[i] * v[i];
        s += xshfl<1>(s); s += xshfl<2>(s); s += xshfl<4>(s); s += xshfl<8>(s);
        const float r = rsqrtf(s * (1.0f / 128.0f) + EPS);
        float gt[8]; unpack8(*(const u32x4*)(MO + o), gt);
#pragma unroll
        for (int i = 0; i < 8; ++i) v[i] = v[i] * r * mg[h * 128 + li * 8 + i] * gt[i];
        *(u32x4*)(OALL + (size_t)row * DM + 1024 + h * 128 + li * 8) = pack8(v);
    }
}
__device__ __forceinline__ int mixer_pop(Frame& F, int l, int kind, int x) {
    __syncthreads();
    if (F.tid == 0) F.LC[LC_Q] = atomicAdd(F.ctl + CW_QCTR + ((l * 3 + kind) * 8 + x) * 64, 1u);
    __syncthreads();
    return (int)F.LC[LC_Q];
}
__device__ __forceinline__ void p_mixers(Frame& F, int l) {
    const int x0 = (int)(xb_xcc_id() & 7u);
    bf16_t* OALL = WSP(bf16_t, WS_OALL);
    LAS char* lds = (LAS char*)F.lds3;
#ifndef MIX_EN
#define MIX_EN 7
#endif
    if (MIX_EN & 1) for (int dx = 0; dx < 8; ++dx) { const int x = (x0 + dx) & 7, b = x >> 1, kvh = x & 1;
        for (;;) { const int u = mixer_pop(F, l, 0, x); if (u >= 4) break;
            const int h = kvh * 2 + (u >> 1), dir = u & 1;
            ml::Args a; const size_t ho = (size_t)(b * 4 + h) * KVL * HD;
            a.Q = WSP(bf16_t, WS_QM) + ho; a.K = WSP(bf16_t, WS_KM) + ho; a.V = WSP(bf16_t, WS_VM) + ho;
            a.GI = WSP(float, WS_GATE) + (size_t)((b * 2 + dir) * 4 + h) * KVL; a.GF = a.GI + (size_t)NB * 8 * KVL;
            a.HM = WSP(float, WS_HM) + (size_t)((dir * 4 + b) * 4 + h) * KVL * HD; a.dir = dir; a.ctx_out = (l == 0);
            ml::mlstm_seq(a, lds, F.wave); } }
    const int nu1 = (l == 0) ? 70 : 64;
    if (MIX_EN & 2) for (int dx = 0; dx < 8; ++dx) { const int x = (x0 + dx) & 7, b = x >> 1, kvh = x & 1;
        for (;;) { const int u = mixer_pop(F, l, 1, x); if (u >= nu1) break;
            att::Args a; a.ldo = DM; a.base1 = 0; a.qpos0 = 0;
            if (u < 68) {
                a.K = WSP(bf16_t, WS_KA) + (size_t)(b * 2 + kvh) * KVL * HD; a.V = WSP(bf16_t, WS_VA) + (size_t)(b * 2 + kvh) * KVL * HD; a.m_init = -1e30f; a.l_init = 0.f;
                if (u < 64) { const int h = kvh * 4 + (u >> 4), qb = u & 15; a.Q = WSP(bf16_t, WS_QA) + ((size_t)(b * 8 + h) * SEQ + qb * 256) * HD;
                    a.O = OALL + (size_t)(b * SEQ + qb * 256) * DM + h * 128; a.n0 = 68; a.base0 = 0; a.NT = 68; }
                else { const int h = kvh * 4 + (u - 64); a.Q = WSP(bf16_t, WS_QAC) + (size_t)(b * 8 + h) * CTXL * HD;
                    a.O = OALL + (size_t)(NLAT + b * CTXL) * DM + h * 128; a.n0 = 4; a.base0 = SEQ; a.NT = 4; }
            } else {
                const int h = kvh * 2 + (u - 68); a.Q = WSP(bf16_t, WS_QCC) + (size_t)(b * 4 + h) * CTXL * HD;
                a.K = WSP(bf16_t, WS_KC) + (size_t)(b * 2 + kvh) * KVL * HD; a.V = WSP(bf16_t, WS_VC) + (size_t)(b * 2 + kvh) * KVL * HD;
                a.O = OALL + (size_t)(NLAT + b * CTXL) * DM + 1536 + h * 128; a.n0 = 4; a.base0 = SEQ; a.NT = 4;
                a.m_init = inp(F, 15)[l * 4 + h] * (1.0f / att::SCALE); a.l_init = 1.f; }
            att::attn_body<false>(a, lds, F.wave); } }
    if (MIX_EN & 4) for (int dx = 0; dx < 8; ++dx) { const int x = (x0 + dx) & 7, b = x >> 1, kvh = x & 1;
        for (;;) { const int u = mixer_pop(F, l, 2, x); if (u >= 32) break;
            const int h = kvh * 2 + (u >> 4), qb = u & 15;
            const int w0 = qb == 0 ? 0 : qb * 256 - 128, w1 = qb == 15 ? SEQ : qb * 256 + 384;
            att::Args a; a.Q = WSP(bf16_t, WS_QC) + ((size_t)(b * 4 + h) * SEQ + qb * 256) * HD;
            a.K = WSP(bf16_t, WS_KC) + (size_t)(b * 2 + kvh) * KVL * HD; a.V = WSP(bf16_t, WS_VC) + (size_t)(b * 2 + kvh) * KVL * HD;
            a.O = OALL + (size_t)(b * SEQ + qb * 256) * DM + 1536 + h * 128; a.ldo = DM; a.n0 = (w1 - w0) >> 6; a.base0 = w0; a.base1 = SEQ; a.NT = a.n0 + 4; a.qpos0 = qb * 256;
            a.m_init = inp(F, 15)[l * 4 + h] * (1.0f / att::SCALE); a.l_init = 1.f;
            att::attn_body<true>(a, lds, F.wave); } }
}

__device__ __forceinline__ bool ph_in(int lo, int hi, int k) { asm volatile("" : "+s"(lo), "+s"(hi)); return lo <= k && k < hi; }
constexpr int PH_PRE = 0, PH_MODR = 1, PH_L0 = 2, PH_PER_LAYER = 11, PH_FINAL = PH_L0 + 2 * PH_PER_LAYER, N_PHASES = PH_FINAL + 1;
struct Params { const float* in[28]; float* out; unsigned char* ws; int ph_lo, ph_hi; };
__global__ void __launch_bounds__(NTHR, 2) fwd(Params p) {
    extern __shared__ __attribute__((aligned(16))) unsigned char lds[];
    Frame F;
    F.lds = (char*)lds; F.lds3 = (LAS unsigned char*)lds; F.LC = (volatile LAS unsigned*)((LAS unsigned char*)lds + LDSCTL_OFF);
    F.wave = __builtin_amdgcn_readfirstlane((int)threadIdx.x >> 6); F.tid = tid_of(F.wave); F.lane = F.tid & 63; F.G = gridDim.x; F.bid = blockIdx.x;
    F.ws = p.ws; F.ctl = (unsigned*)(p.ws + WS_CTL);
    F.karg = (const float* const __attribute__((address_space(4)))*)__builtin_amdgcn_kernarg_segment_ptr();
    for (int u = F.tid; u < (LDS_BYTES - LDSCTL_OFF) / 4; u += NTHR) F.LC[u] = 0u;
    __syncthreads();
    const int lo = p.ph_lo, hi = p.ph_hi;
    XcdBarrier bar; bar.bar = F.ctl + CW_BAR; bar.x = 0; bar.st = nullptr;
    if (hi - lo > 1) bar = xcd_barrier_post(F.ctl + CW_BAR, F.LC + LC_BAR, F.tid);
#ifndef PH_ENABLE
#define PH_ENABLE 0xFFFF
#endif
#define EN(kind) ((PH_ENABLE >> (kind)) & 1)
#define IN(k) ph_in(lo, hi, (k))
#define PB() do { F.tid = tid_of(F.wave); F.lane = F.tid & 63; asm volatile("" : "+s"(F.ws)); } while (0)
#define SEAM(k) do { if (IN(k) && IN((k) + 1)) xcd_barrier(bar, tid_of(F.wave)); } while (0)
    LAS unsigned char* ring = (LAS unsigned char*)lds;

    if (EN(0) && IN(PH_PRE)) { PB(); p_mod_partial(F); p_rope_tables(F); p_convert_weights(F, 0); } SEAM(PH_PRE);
    if (EN(1) && IN(PH_MODR)) { PB(); p_mod_reduce(F); } SEAM(PH_MODR);
#pragma unroll 1
    for (int l = 0; l < 2; ++l) {
        const int P = PH_L0 + l * PH_PER_LAYER;
        const int mrows = (l == 0) ? NROW : NLAT;
        if (EN(2) && IN(P + 0)) { PB(); if (l > 0) p_convert_weights(F, l); p_norm1(F, l); } SEAM(P + 0);
        if (EN(3) && IN(P + 1)) { PB(); pg8::Gemm g{WSP(bf16_t, WS_H), WSP(bf16_t, WS_WIN), NROW, NPIN, DM}; pg8::StaticOrder S; S.init(NROW, NPIN, F.G, F.bid);
            pg8::EpiInProj E{WSP(bf16_t, WS_P1), WSP(bf16_t, WS_MO), WSP(bf16_t, WS_G), WSP(float, WS_GRAW)};
            pg8::gemm_phase<pg8::EpiInProj, pg8::StaticOrder>(ring, g, S, E, F.wave); } SEAM(P + 1);
        if (EN(4) && IN(P + 2)) { PB(); p_prep(F, l); } SEAM(P + 2);
        if (EN(5) && IN(P + 3)) { PB(); p_mixers(F, l); } SEAM(P + 3);
        if (EN(6) && IN(P + 4)) { PB(); p_omprep(F, l, mrows); } SEAM(P + 4);
        if (EN(7) && IN(P + 5)) { PB(); pg8::Gemm g{WSP(bf16_t, WS_OALL), WSP(bf16_t, WS_WBR), mrows, DM, DM}; pg8::StaticOrder S; S.init(mrows, DM, F.G, F.bid);
            pg8::EpiBranch E{WSP(bf16_t, WS_G), WSP(bf16_t, WS_Y)};
            pg8::gemm_phase<pg8::EpiBranch, pg8::StaticOrder>(ring, g, S, E, F.wave); } SEAM(P + 5);
        if (EN(8) && IN(P + 6)) { PB(); pg8::Gemm g{WSP(bf16_t, WS_Y), WSP(bf16_t, WS_WOUT), mrows, DM, DM}; pg8::StaticOrder S; S.init(mrows, DM, F.G, F.bid);
            pg8::EpiOut E{l == 0 ? inp(F, 0) : WSP(float, WS_XL), l == 0 ? inp(F, 2) : WSP(float, WS_XC), WSP(float, WS_XL), WSP(float, WS_XC), WSP(float, WS_MOD) + (size_t)l * 5 * 12288};
            pg8::gemm_phase<pg8::EpiOut, pg8::StaticOrder>(ring, g, S, E, F.wave); } SEAM(P + 6);
        if (EN(9) && IN(P + 7)) { PB(); p_norm2_route(F, l, mrows); } SEAM(P + 7);
        if (EN(10) && IN(P + 8)) { PB(); p_gather(F, l, mrows); } SEAM(P + 8);
        if (EN(11) && IN(P + 9)) { PB(); const int ntl = moe_tables(F, l);
            pg8::Gemm g{WSP(bf16_t, WS_XS), WSP(bf16_t, WS_WGU), 0, 0, DM}; pg8::MoeOrder S{ntl, 4, F.G, F.bid, (const LAS int*)(F.LC + LC_TILE)};
            pg8::EpiMoe1 E{WSP(bf16_t, WS_MID), (const float*)(F.ws + WS_ROUTE + RT_WSORT)};
            pg8::gemm_phase<pg8::EpiMoe1, pg8::MoeOrder>(ring, g, S, E, F.wave); } SEAM(P + 9);
        if (EN(12) && IN(P + 10)) { PB(); const int ntl = moe_tables(F, l);
            pg8::Gemm g{WSP(bf16_t, WS_MID), WSP(bf16_t, WS_WD), 0, 0, DFF}; pg8::MoeOrder S{ntl, 8, F.G, F.bid, (const LAS int*)(F.LC + LC_TILE)};
            pg8::EpiMoe2 E{WSP(bf16_t, WS_MOEOUT)};
            pg8::gemm_phase<pg8::EpiMoe2, pg8::MoeOrder>(ring, g, S, E, F.wave); } SEAM(P + 10);
    }
    if (EN(13) && IN(PH_FINAL)) { PB(); p_final(F); }
#undef IN
#undef SEAM
}

extern "C" void kernel_launch(void* const* d_in, const int* in_sizes, int n_in, void* d_out, int out_size, void* d_ws, size_t ws_size, hipStream_t stream) {
    static int grid = 0;
    if (grid == 0) {
        if (n_in != 28 || out_size != NLAT * DM || ws_size < WS_END) { fprintf(stderr, "kernel_launch: unexpected shapes (n_in %d, out %d, ws %zu < %zu)\n", n_in, out_size, ws_size, (size_t)WS_END); grid = -1; return; }
        int dev = 0, cus = 0, per_cu = 0;
        if (hipGetDevice(&dev) != hipSuccess || hipDeviceGetAttribute(&cus, hipDeviceAttributeMultiprocessorCount, dev) != hipSuccess) { grid = -1; return; }
        if (hipFuncSetAttribute((const void*)fwd, hipFuncAttributeMaxDynamicSharedMemorySize, LDS_BYTES) != hipSuccess) { fprintf(stderr, "kernel_launch: hipFuncSetAttribute failed\n"); grid = -1; return; }
        if (hipOccupancyMaxActiveBlocksPerMultiprocessor(&per_cu, (const void*)fwd, NTHR, LDS_BYTES) != hipSuccess || per_cu < 1) { fprintf(stderr, "kernel_launch: occupancy query says %d\n", per_cu); (void)hipGetLastError(); grid = -1; return; }
        grid = cus;
    }
    if (grid < 0) return;
    (void)hipMemsetAsync((char*)d_ws + WS_CTL, 0, CTL_ZERO_BYTES, stream);
    Params p{};
    for (int i = 0; i < 28; ++i) p.in[i] = (const float*)d_in[i];
    p.out = (float*)d_out; p.ws = (unsigned char*)d_ws;
#if MK_PER_PHASE
    for (int k = 0; k < N_PHASES; ++k) { p.ph_lo = k; p.ph_hi = k + 1; hipLaunchKernelGGL(fwd, dim3(grid), dim3(NTHR), LDS_BYTES, stream, p); }
#else
    p.ph_lo = 0; p.ph_hi = N_PHASES; hipLaunchKernelGGL(fwd, dim3(grid), dim3(NTHR), LDS_BYTES, stream, p);
#endif
}
```

```cpp
#include <hip/hip_runtime.h>
#include <cstdio>
#include <cstdint>

#ifndef MK_PER_PHASE
#define MK_PER_PHASE 0
#endif

#define GAS __attribute__((address_space(1)))
#define LAS __attribute__((address_space(3)))
typedef unsigned short bf16_t;
typedef short bf16x8 __attribute__((ext_vector_type(8)));
typedef short s16x4 __attribute__((ext_vector_type(4)));
typedef float f32x2 __attribute__((ext_vector_type(2)));
typedef float f32x4 __attribute__((ext_vector_type(4)));
typedef float f32x8 __attribute__((ext_vector_type(8)));
typedef float f32x16 __attribute__((ext_vector_type(16)));
typedef unsigned u32x2 __attribute__((ext_vector_type(2)));
typedef unsigned u32x4 __attribute__((ext_vector_type(4)));

constexpr int DM = 2048, NB = 4, SEQ = 4096, CTXL = 256, HD = 128;
constexpr int NLAT = NB * SEQ, NCTX = NB * CTXL, NROW = NLAT + NCTX;
constexpr int KVL = SEQ + CTXL;
constexpr int PIN = 10768, NPIN = 11008;
constexpr int NEXP = 16, DFF = 512;
constexpr int MOE_TILES_MAX = 152, MOE_ROWS_MAX = MOE_TILES_MAX * 256;
constexpr float EPS = 1e-6f;
constexpr int NWAVES = 8, NTHR = 512;

constexpr size_t MiB = 1u << 20;
constexpr size_t WS_CTL = 0, CTL_ZERO_BYTES = 1 * MiB;
constexpr size_t WS_MOD = 1 * MiB;
constexpr size_t WS_ROPE = 2 * MiB;
constexpr size_t WS_MODP = 4 * MiB;
constexpr size_t WS_ROUTE = 12 * MiB;
constexpr size_t WS_GRAW = 14 * MiB;
constexpr size_t WS_GATE = 16 * MiB;
constexpr size_t WS_WIN = 20 * MiB;
constexpr size_t WS_WBR = 63 * MiB;
constexpr size_t WS_WOUT = 71 * MiB;
constexpr size_t WS_WGU = 79 * MiB;
constexpr size_t WS_WD = 143 * MiB;
constexpr size_t WS_XL = 175 * MiB;
constexpr size_t WS_XC = 303 * MiB;
constexpr size_t WS_H = 311 * MiB;
constexpr size_t WS_MO = 379 * MiB;
constexpr size_t WS_P1 = 396 * MiB;
constexpr size_t WS_G = 532 * MiB;
constexpr size_t WS_OALL = 396 * MiB;
constexpr size_t WS_HM = 464 * MiB;
constexpr size_t WS_XS = 396 * MiB;
constexpr size_t WS_MID = 548 * MiB;
constexpr size_t WS_MOEOUT = 586 * MiB;
constexpr size_t WS_QA = 738 * MiB;
constexpr size_t WS_QAC = 770 * MiB;
constexpr size_t WS_KA = 772 * MiB;
constexpr size_t WS_VA = 781 * MiB;
constexpr size_t WS_QC = 790 * MiB;
constexpr size_t WS_QCC = 806 * MiB;
constexpr size_t WS_KC = 807 * MiB;
constexpr size_t WS_VC = 816 * MiB;
constexpr size_t WS_QM = 825 * MiB;
constexpr size_t WS_KM = 842 * MiB;
constexpr size_t WS_VM = 859 * MiB;
constexpr size_t WS_Y = 738 * MiB;
constexpr size_t WS_END = 876 * MiB;

constexpr int CW_BAR = 4096;
constexpr int CW_QCTR = 8192;
constexpr int CW_ECNT = 12288;
constexpr size_t RT_SLOTE = 0;
constexpr size_t RT_SLOTP = 160 * 1024;
constexpr size_t RT_SLOTW = 320 * 1024;
constexpr size_t RT_SLOTD = 480 * 1024;
constexpr size_t RT_WSORT = 640 * 1024;

constexpr int RING_BYTES = 131072;
constexpr int ML_SM = 131072;
constexpr int LDSCTL_OFF = 143360;
constexpr int LDS_BYTES = 147456;
constexpr int LC_BAR = 8;
constexpr int LC_Q = 16;
constexpr int LC_TILE = 64;

__device__ __forceinline__ float bflo(unsigned w) { return __uint_as_float(w << 16); }
__device__ __forceinline__ float bfhi(unsigned w) { return __uint_as_float(w & 0xffff0000u); }
__device__ __forceinline__ unsigned cvt_pk_bf16(float lo, float hi) { unsigned r; asm volatile("v_cvt_pk_bf16_f32 %0, %1, %2" : "=v"(r) : "v"(lo), "v"(hi)); return r; }
template <int O> __device__ __forceinline__ float xshfl(float v) {
    if constexpr (O < 32) return __int_as_float(__builtin_amdgcn_ds_swizzle(__float_as_int(v), (O << 10) | 0x1f));
    else { auto rr = __builtin_amdgcn_permlane32_swap(__float_as_uint(v), __float_as_uint(v), false, false); return __uint_as_float(rr[0]) == v ? __uint_as_float(rr[1]) : __uint_as_float(rr[0]); }
}
__device__ __forceinline__ float wave_sum(float v) {
    v += xshfl<1>(v); v += xshfl<2>(v); v += xshfl<4>(v); v += xshfl<8>(v); v += xshfl<16>(v);
    { auto rr = __builtin_amdgcn_permlane32_swap(__float_as_uint(v), __float_as_uint(v), false, false); v = __uint_as_float(rr[0]) + __uint_as_float(rr[1]); }
    return v;
}
__device__ __forceinline__ float sigmoidf_(float x) { return __builtin_amdgcn_rcpf(1.0f + __expf(-x)); }
__device__ __forceinline__ float siluf_(float x) { return x * sigmoidf_(x); }
__device__ __forceinline__ int opaque(int x) { asm volatile("" : "+v"(x)); return x; }
__device__ __forceinline__ int tid_of(int wave) { int l; asm volatile("v_mbcnt_lo_u32_b32 %0, -1, 0\n\tv_mbcnt_hi_u32_b32 %0, -1, %0" : "=v"(l)); return wave * 64 + l; }
#define LDS_WAIT() asm volatile("s_waitcnt lgkmcnt(0)" ::: "memory")
#define VM_WAIT() asm volatile("s_waitcnt vmcnt(0)" ::: "memory")

#define XB_TMO      128
#define XB_XCNT(j)  (256  + 64 * (j))
#define XB_XSUB(j)  (1280 + 64 * (j))
#define XB_XGEN(j)  (2304 + 64 * (j))
#define XB_TOP      3328
#define XB_TOPGEN   3392
#define XCD_BAR_WORDS 3456
#define XB_SPIN_CAP (1u << 18)
__device__ __forceinline__ unsigned xb_ld(unsigned* p)              { return __hip_atomic_load(p, __ATOMIC_RELAXED, __HIP_MEMORY_SCOPE_AGENT); }
__device__ __forceinline__ unsigned xb_add(unsigned* p, unsigned v) { return __hip_atomic_fetch_add(p, v, __ATOMIC_RELAXED, __HIP_MEMORY_SCOPE_AGENT); }
__device__ __forceinline__ unsigned xb_xcc_id() { return (unsigned)__builtin_amdgcn_s_getreg((3 << 11) | 20) & 0xFu; }
#define XB_SPIN(cond, bar) do { unsigned _sp = 0; while (cond) { __builtin_amdgcn_s_sleep(1); \
    if ((++_sp & 255u) == 0u) { if (xb_ld(&(bar)[XB_TMO])) break; if (_sp > XB_SPIN_CAP) { atomicAdd(&(bar)[XB_TMO], 1u); break; } } } } while (0)
struct XcdBarrier { unsigned* bar; unsigned x; volatile LAS unsigned* st; };
__device__ __forceinline__ XcdBarrier xcd_barrier_post(unsigned* bar, volatile LAS unsigned* st, int tid) {
    XcdBarrier b; b.bar = bar; b.x = xb_xcc_id(); b.st = st;
    if (tid == 0) (void)xb_add(&bar[XB_XCNT(b.x)], 1u);
    return b;
}
__device__ __forceinline__ void xcd_barrier_complete(unsigned* bar, unsigned x, unsigned& nloc, unsigned& nx) {
    const unsigned G = gridDim.x * gridDim.y * gridDim.z;
    unsigned sum, cnt, mine, sp = 0u;
    for (;;) {
        sum = 0u; cnt = 0u; mine = 0u;
#pragma unroll
        for (unsigned j = 0; j < 16; ++j) { const unsigned c = xb_ld(&bar[XB_XCNT(j)]); sum += c; cnt += (c > 0u) ? 1u : 0u; mine = (j == x) ? c : mine; }
        if (sum == G) break;
        __builtin_amdgcn_s_sleep(1);
        if ((++sp & 255u) == 0u) { if (xb_ld(&bar[XB_TMO])) break; if (sp > XB_SPIN_CAP) { atomicAdd(&bar[XB_TMO], 1u); break; } }
    }
    nloc = mine > 0u ? mine : 1u; nx = cnt > 0u ? cnt : 1u;
}
__device__ __forceinline__ void xcd_barrier(const XcdBarrier& b, int tid) {
    asm volatile("s_waitcnt vmcnt(0)" ::: "memory");
    __syncthreads();
    if (tid == 0) {
        unsigned* bar = b.bar;
        __builtin_amdgcn_s_waitcnt(0);
        unsigned nloc = b.st[0], nx = b.st[1];
        if (nloc == 0u) { xcd_barrier_complete(bar, b.x, nloc, nx); b.st[0] = nloc; b.st[1] = nx; }
        const unsigned old = xb_add(&bar[XB_XSUB(b.x)], 1u);
        const unsigned gen = old / nloc;
        if (old + 1u == (gen + 1u) * nloc) {
            __builtin_amdgcn_fence(__ATOMIC_RELEASE, "agent");
            asm volatile("s_waitcnt vmcnt(0)" ::: "memory");
            const unsigned og = xb_add(&bar[XB_TOP], 1u);
            const unsigned tg = og / nx;
            if (og + 1u == (tg + 1u) * nx) xb_add(&bar[XB_TOPGEN], 1u);
            else XB_SPIN(xb_ld(&bar[XB_TOPGEN]) == tg, bar);
            __builtin_amdgcn_fence(__ATOMIC_ACQUIRE, "agent");
            xb_add(&bar[XB_XGEN(b.x)], 1u);
            asm volatile("s_waitcnt vmcnt(0)" ::: "memory");
        } else {
            XB_SPIN(xb_ld(&bar[XB_XGEN(b.x)]) == gen, bar);
            __builtin_amdgcn_fence(__ATOMIC_ACQUIRE, "agent");
            asm volatile("s_waitcnt vmcnt(0)" ::: "memory");
        }
    }
    __syncthreads();
}
namespace pg8 {
constexpr int BM = 256, BK = 64, HALF = 128, HTB = HALF * BK * 2, STAGE_BYTES = 8 * HTB, NXCD = 8, WGM = 8;
__host__ __device__ __forceinline__ int lds_byte(int r, int c) { const int st = (r >> 4) * 2 + (c >> 5), rr = r & 15, cc = c & 31, ob = rr * 64 + cc * 2; return st * 1024 + (ob ^ (((ob >> 9) & 1) << 5)); }
__host__ __device__ __forceinline__ void stage_rc(int b, int& R, int& C) { const int st = b / 1024, sb = b % 1024, swz = sb ^ (((sb >> 9) & 1) << 5); R = (st >> 1) * 16 + swz / 64; C = (st & 1) * 32 + (swz % 64) / 2; }
__host__ __device__ __forceinline__ int perm32(int rho) { const int n = rho >> 4, i = rho & 15; return 8 * (i >> 2) + 4 * n + (i & 3); }

struct Unit { int pm, pn; };
struct Gemm { const bf16_t* A; const bf16_t* Bt; int M, N, K; };

struct StaticOrder {
    int nM, nN, nwg, G, c;
    __host__ __device__ void init(int M, int N, int G_, int c_) { nM = M / BM; nN = N / BM; nwg = nM * nN; G = G_; c = c_; }
    __host__ __device__ bool next(int i, Unit& u) const {
        const long L = (long)i * G + c; if (L >= nwg) return false;
        int wgid = (int)L; { const int q = nwg / NXCD, r = nwg % NXCD, xcd = wgid % NXCD, off = wgid / NXCD; wgid = (xcd < r ? xcd * (q + 1) : r * (q + 1) + (xcd - r) * q) + off; }
        const int nig = WGM * nN, gid = wgid / nig, fm = gid * WGM, gsz = (nM - fm) < WGM ? (nM - fm) : WGM;
        u.pm = fm + ((wgid % nig) % gsz); u.pn = (wgid % nig) / gsz; return true;
    }
    __device__ __forceinline__ void a_ready(const Unit&) const {}
    __device__ __forceinline__ void done(const Unit&) const {}
};
struct MoeOrder {
    int ntiles, nN, G, c; const LAS int* tile_e;
    __device__ __forceinline__ bool next(int i, Unit& u) const {
        const long L = (long)i * G + c; if (L >= (long)ntiles * nN) return false;
        const int rt = (int)(L / nN), ct = (int)(L % nN); u.pm = rt; u.pn = tile_e[rt] * nN + ct; return true;
    }
    __device__ __forceinline__ void a_ready(const Unit&) const {}
    __device__ __forceinline__ void done(const Unit&) const {}
};

typedef f32x4 Acc[2][2][4][2];

struct EpiInProj {
    static constexpr bool PERM = true, AFTER_DRAIN = false, HAS_MID = false; static constexpr int MID0 = -1, MID1 = -1;
    bf16_t* P1; bf16_t* MO; bf16_t* G; float* GRAW;
    __device__ __forceinline__ void mid(Acc&, const Unit&, int, int, int, int, int) const {}
    __device__ __forceinline__ void operator()(const Acc& acc, const Unit& u, int wr, int wc, int fr, int fq) const {
        const int row0 = u.pm * BM + wr * 64 + fr, pn = u.pn;
        if (pn == 42) {
            if (wc == 0 && fq < 2) {
#pragma unroll
                for (int ai = 0; ai < 2; ++ai)
#pragma unroll
                    for (int m = 0; m < 4; ++m) { float* rowp = GRAW + (size_t)(row0 + ai * HALF + m * 16) * 16 + 8 * fq;
                        *(f32x4*)(rowp) = acc[ai][0][m][0]; *(f32x4*)(rowp + 4) = acc[ai][0][m][1]; }
            }
            return;
        }
        bf16_t* base; int ldc, colt; bool sig;
        if (pn < 12) { base = P1; ldc = 4096; colt = pn * BM; sig = false; }
        else if (pn < 14) { base = MO; ldc = 512; colt = (pn - 12) * BM; sig = true; }
        else if (pn < 18) { base = P1; ldc = 4096; colt = 3072 + (pn - 14) * BM; sig = false; }
        else { base = G; ldc = 6144; colt = (pn - 18) * BM; sig = true; }
        const int col0 = colt + wc * 32 + 8 * fq;
#pragma unroll
        for (int ai = 0; ai < 2; ++ai)
#pragma unroll
            for (int m = 0; m < 4; ++m) { bf16_t* rowp = base + (size_t)(row0 + ai * HALF + m * 16) * ldc + col0;
#pragma unroll
                for (int bj = 0; bj < 2; ++bj) { f32x4 v0 = acc[ai][bj][m][0], v1 = acc[ai][bj][m][1];
                    if (sig) {
#pragma unroll
                        for (int j = 0; j < 4; ++j) { v0[j] = fmaxf(sigmoidf_(v0[j]), 1e-6f); v1[j] = fmaxf(sigmoidf_(v1[j]), 1e-6f); } }
                    u32x4 w; w.x = cvt_pk_bf16(v0[0], v0[1]); w.y = cvt_pk_bf16(v0[2], v0[3]); w.z = cvt_pk_bf16(v1[0], v1[1]); w.w = cvt_pk_bf16(v1[2], v1[3]);
                    *(u32x4*)(rowp + bj * HALF) = w; } }
    }
};
struct EpiBranch {
    static constexpr bool PERM = true, AFTER_DRAIN = false, HAS_MID = true; static constexpr int MID0 = 16, MID1 = 24;
    const bf16_t* G; bf16_t* Y;
    __device__ __forceinline__ void mid(Acc& acc, const Unit& u, int t, int wr, int wc, int fr_, int fq_) const {
        const int fr = opaque(fr_), fq = opaque(fq_);
        const int row0 = u.pm * BM + wr * 64 + fr, col0 = u.pn * BM + wc * 32 + 8 * fq;
        const int cn = (t == 16) ? 0 : 2048;
#pragma unroll
        for (int ai = 0; ai < 2; ++ai)
#pragma unroll
            for (int m = 0; m < 4; ++m) { const bf16_t* rowp = G + (size_t)(row0 + ai * HALF + m * 16) * 6144 + col0 + cn;
#pragma unroll
                for (int bj = 0; bj < 2; ++bj) { const u32x4 a = *(const u32x4*)(rowp + bj * HALF), b = *(const u32x4*)(rowp + bj * HALF + 2048);
                    f32x4 r0, r1;
                    r0[0] = bflo(a.x) * __builtin_amdgcn_rcpf(bflo(b.x)); r0[1] = bfhi(a.x) * __builtin_amdgcn_rcpf(bfhi(b.x));
                    r0[2] = bflo(a.y) * __builtin_amdgcn_rcpf(bflo(b.y)); r0[3] = bfhi(a.y) * __builtin_amdgcn_rcpf(bfhi(b.y));
                    r1[0] = bflo(a.z) * __builtin_amdgcn_rcpf(bflo(b.z)); r1[1] = bfhi(a.z) * __builtin_amdgcn_rcpf(bfhi(b.z));
                    r1[2] = bflo(a.w) * __builtin_amdgcn_rcpf(bflo(b.w)); r1[3] = bfhi(a.w) * __builtin_amdgcn_rcpf(bfhi(b.w));
                    acc[ai][bj][m][0] *= r0; acc[ai][bj][m][1] *= r1; }
                asm volatile("" ::: "memory"); }
    }
    __device__ __forceinline__ void operator()(const Acc& acc, const Unit& u, int wr, int wc, int fr, int fq) const {
        const int row0 = u.pm * BM + wr * 64 + fr, col0 = u.pn * BM + wc * 32 + 8 * fq;
#pragma unroll
        for (int ai = 0; ai < 2; ++ai)
#pragma unroll
            for (int m = 0; m < 4; ++m) { const size_t r = (size_t)(row0 + ai * HALF + m * 16);
#pragma unroll
                for (int bj = 0; bj < 2; ++bj) { const u32x4 g = *(const u32x4*)(G + r * 6144 + 4096 + col0 + bj * HALF);
                    const f32x4 v0 = acc[ai][bj][m][0], v1 = acc[ai][bj][m][1];
                    u32x4 w; w.x = cvt_pk_bf16(v0[0] * bflo(g.x), v0[1] * bfhi(g.x)); w.y = cvt_pk_bf16(v0[2] * bflo(g.y), v0[3] * bfhi(g.y));
                    w.z = cvt_pk_bf16(v1[0] * bflo(g.z), v1[1] * bfhi(g.z)); w.w = cvt_pk_bf16(v1[2] * bflo(g.w), v1[3] * bfhi(g.w));
                    *(u32x4*)(Y + r * 2048 + col0 + bj * HALF) = w; }
                asm volatile("" ::: "memory"); }
    }
};
struct EpiOut {
    static constexpr bool PERM = false, AFTER_DRAIN = false, HAS_MID = false; static constexpr int MID0 = -1, MID1 = -1;
    const float* res_lat; const float* res_ctx; float* out_lat; float* out_ctx; const float* modl;
    __device__ __forceinline__ void mid(Acc&, const Unit&, int, int, int, int, int) const {}
    __device__ __forceinline__ void operator()(const Acc& acc, const Unit& u, int wr, int wc, int fr, int fq) const {
        const bool lat = u.pm < 64; const int rbase = lat ? u.pm * BM : (u.pm - 64) * BM;
        const float* res = lat ? res_lat : res_ctx; float* out = lat ? out_lat : out_ctx;
        const float* gv = modl + (size_t)(lat ? (u.pm >> 4) : 4) * 12288 + 4096;
        const int row0 = rbase + wr * 64 + fr, col0 = u.pn * BM + wc * 32 + 4 * fq;
        f32x4 g[2][2];
#pragma unroll
        for (int bj = 0; bj < 2; ++bj)
#pragma unroll
            for (int n = 0; n < 2; ++n) g[bj][n] = *(const f32x4*)(gv + col0 + bj * HALF + n * 16);
#pragma unroll
        for (int ai = 0; ai < 2; ++ai)
#pragma unroll
            for (int m = 0; m < 4; ++m) { const size_t off = (size_t)(row0 + ai * HALF + m * 16) * DM + col0;
#pragma unroll
                for (int bj = 0; bj < 2; ++bj)
#pragma unroll
                    for (int n = 0; n < 2; ++n) { const f32x4 r = *(const f32x4*)(res + off + bj * HALF + n * 16);
                        *(f32x4*)(out + off + bj * HALF + n * 16) = r + g[bj][n] * acc[ai][bj][m][n]; } }
    }
};
struct EpiMoe1 {
    static constexpr bool PERM = true, AFTER_DRAIN = false, HAS_MID = false; static constexpr int MID0 = -1, MID1 = -1;
    bf16_t* MID; const float* wsort;
    __device__ __forceinline__ void mid(Acc&, const Unit&, int, int, int, int, int) const {}
    __device__ __forceinline__ void operator()(const Acc& acc, const Unit& u, int wr, int wc, int fr, int fq) const {
        const int row0 = u.pm * BM + wr * 64 + fr, ct = u.pn & 3, col0 = ct * 128 + wc * 16 + 4 * fq;
#pragma unroll
        for (int ai = 0; ai < 2; ++ai)
#pragma unroll
            for (int m = 0; m < 4; ++m) { const size_t r = (size_t)(row0 + ai * HALF + m * 16); const float w = wsort[r];
#pragma unroll
                for (int bj = 0; bj < 2; ++bj) { const f32x4 a = acc[ai][bj][m][0], up = acc[ai][bj][m][1];
                    u32x2 o; o.x = cvt_pk_bf16(siluf_(a[0]) * up[0] * w, siluf_(a[1]) * up[1] * w); o.y = cvt_pk_bf16(siluf_(a[2]) * up[2] * w, siluf_(a[3]) * up[3] * w);
                    *(u32x2*)(MID + r * DFF + col0 + bj * 64) = o; } }
    }
};
struct EpiMoe2 {
    static constexpr bool PERM = true, AFTER_DRAIN = false, HAS_MID = false; static constexpr int MID0 = -1, MID1 = -1;
    bf16_t* O;
    __device__ __forceinline__ void mid(Acc&, const Unit&, int, int, int, int, int) const {}
    __device__ __forceinline__ void operator()(const Acc& acc, const Unit& u, int wr, int wc, int fr, int fq) const {
        const int row0 = u.pm * BM + wr * 64 + fr, col0 = (u.pn & 7) * BM + wc * 32 + 8 * fq;
#pragma unroll
        for (int ai = 0; ai < 2; ++ai)
#pragma unroll
            for (int m = 0; m < 4; ++m) { bf16_t* rowp = O + (size_t)(row0 + ai * HALF + m * 16) * DM + col0;
#pragma unroll
                for (int bj = 0; bj < 2; ++bj) { const f32x4 v0 = acc[ai][bj][m][0], v1 = acc[ai][bj][m][1];
                    u32x4 w; w.x = cvt_pk_bf16(v0[0], v0[1]); w.y = cvt_pk_bf16(v0[2], v0[3]); w.z = cvt_pk_bf16(v1[0], v1[1]); w.w = cvt_pk_bf16(v1[2], v1[3]);
                    *(u32x4*)(rowp + bj * HALF) = w; } }
    }
};

template <class Epi, class Sched>
__device__ __forceinline__ void gemm_phase(LAS unsigned char* lds, const Gemm g, const Sched& S, const Epi& E, int wave) {
    const int tid = tid_of(wave), wid = wave, lane = tid & 63, wr = wid >> 2, wc = wid & 3, fr = lane & 15, fq = lane >> 4;
    const int K = g.K, nt = K / BK;
    unsigned voffA[2], voffB[2];
#pragma unroll
    for (int i = 0; i < 2; ++i) { int R, C; stage_rc(tid * 16 + i * 8192, R, C); const int Rb = Epi::PERM ? ((R & ~31) + perm32(R & 31)) : R;
        voffA[i] = (unsigned)(R * K + C) * 2u; voffB[i] = (unsigned)(Rb * K + C) * 2u; }
    const size_t kstep = (size_t)(BK * 2);
    const size_t hstep = (size_t)HALF * K * 2;
    const size_t tstep = 2 * hstep;
    const unsigned ldsw = (unsigned)wid * 1024u;
    const int aoff = lds_byte(wr * 64 + fr, fq * 8), boff = lds_byte(wc * 32 + fr, fq * 8);
#define PG8_SA(b, h) (((b) * 2 + (h)) * HTB)
#define PG8_SB(b, h) ((4 + (b) * 2 + (h)) * HTB)
#define PG8_STAGE(bufoff, gbase, voff) do { _Pragma("unroll") for (int _i = 0; _i < 2; ++_i) \
        __builtin_amdgcn_global_load_lds((const unsigned*)((const char*)(gbase) + (voff)[_i]), (LAS unsigned*)(lds + (bufoff) + ldsw + _i * 8192), 16, 0, 0); } while (0)
#define PG8_LDA(dst, b, h) do { _Pragma("unroll") for (int m = 0; m < 4; ++m) _Pragma("unroll") for (int k = 0; k < 2; ++k) dst[m][k] = *(const LAS bf16x8*)(lds + PG8_SA(b, h) + aoff + m * 2048 + k * 1024); } while (0)
#define PG8_LDB(dst, b, h) do { _Pragma("unroll") for (int n = 0; n < 2; ++n) _Pragma("unroll") for (int k = 0; k < 2; ++k) dst[n][k] = *(const LAS bf16x8*)(lds + PG8_SB(b, h) + boff + n * 2048 + k * 1024); } while (0)
#define PG8_MMA(ai, bj, At, Bt) do { __builtin_amdgcn_s_setprio(1); _Pragma("unroll") for (int m = 0; m < 4; ++m) _Pragma("unroll") for (int n = 0; n < 2; ++n) _Pragma("unroll") for (int k = 0; k < 2; ++k) \
        acc[ai][bj][m][n] = __builtin_amdgcn_mfma_f32_16x16x32_bf16(Bt[n][k], At[m][k], acc[ai][bj][m][n], 0, 0, 0); __builtin_amdgcn_s_setprio(0); } while (0)
#define PG8_WAIT_V(n) asm volatile("s_waitcnt vmcnt(" #n ")" ::: "memory")
#define PG8_WAIT_L(n) asm volatile("s_waitcnt lgkmcnt(" #n ")" ::: "memory")
#define PG8_BAR __builtin_amdgcn_s_barrier()
#define PG8_SCHED __builtin_amdgcn_sched_barrier(0)
    Unit cur, nxt; int ui = 0;
    if (!S.next(0, cur)) return;
    f32x4 acc[2][2][4][2];
#pragma unroll
    for (int a = 0; a < 2; ++a)
#pragma unroll
        for (int b = 0; b < 2; ++b)
#pragma unroll
            for (int m = 0; m < 4; ++m)
#pragma unroll
                for (int n = 0; n < 2; ++n) acc[a][b][m][n] = (f32x4){0.f, 0.f, 0.f, 0.f};
    bf16x8 At[4][2], B0[2][2], B1[2][2];
    const char* cA = (const char*)g.A + (size_t)cur.pm * tstep; const char* cB = (const char*)g.Bt + (size_t)cur.pn * tstep;
    S.a_ready(cur);
    PG8_STAGE(PG8_SB(0, 0), cB, voffB); PG8_STAGE(PG8_SB(0, 1), cB + hstep, voffB); PG8_STAGE(PG8_SA(0, 0), cA, voffA); PG8_STAGE(PG8_SA(0, 1), cA + hstep, voffA);
    if (wr == 1) PG8_BAR;
    PG8_WAIT_V(2); PG8_BAR;
    PG8_STAGE(PG8_SB(1, 0), cB + kstep, voffB); PG8_STAGE(PG8_SA(1, 0), cA + kstep, voffA); PG8_STAGE(PG8_SB(1, 1), cB + hstep + kstep, voffB);
    PG8_WAIT_V(6); PG8_BAR;
    for (;;) {
        const bool has_next = S.next(ui + 1, nxt);
        const char* nA = has_next ? (const char*)g.A + (size_t)nxt.pm * tstep : cA; const char* nB = has_next ? (const char*)g.Bt + (size_t)nxt.pn * tstep : cB;
        for (int t = 0; t < nt; t += 2) {
            const bool last = (t == nt - 2);
            const char* a1 = cA + (size_t)(t + 1) * kstep;
            const char* a2 = last ? nA : cA + (size_t)(t + 2) * kstep; const char* b2 = last ? nB : cB + (size_t)(t + 2) * kstep;
            const char* a3 = a2 + kstep; const char* b3 = b2 + kstep;
            if (last && has_next) S.a_ready(nxt);
            if constexpr (Epi::HAS_MID) { if (t == Epi::MID0 || t == Epi::MID1) { E.mid(acc, cur, t, wr, wc, fr, fq); PG8_SCHED; } }
            PG8_LDB(B0, 0, 0); PG8_LDB(B1, 0, 1); PG8_SCHED; PG8_LDA(At, 0, 0); PG8_STAGE(PG8_SA(1, 1), a1 + hstep, voffA);
            PG8_WAIT_V(8); PG8_WAIT_L(0); PG8_BAR; PG8_MMA(0, 0, At, B0); PG8_MMA(0, 1, At, B1); PG8_BAR; PG8_SCHED;
            PG8_LDA(At, 0, 1); PG8_STAGE(PG8_SB(0, 0), b2, voffB); PG8_STAGE(PG8_SB(0, 1), b2 + hstep, voffB); PG8_STAGE(PG8_SA(0, 0), a2, voffA);
            PG8_WAIT_V(8); PG8_WAIT_L(0); PG8_BAR; PG8_MMA(1, 0, At, B0); PG8_MMA(1, 1, At, B1); PG8_BAR; PG8_SCHED;
            PG8_LDB(B0, 1, 0); PG8_LDB(B1, 1, 1); PG8_SCHED; PG8_LDA(At, 1, 0); PG8_STAGE(PG8_SA(0, 1), a2 + hstep, voffA);
            PG8_WAIT_V(8); PG8_WAIT_L(0); PG8_BAR; PG8_MMA(0, 0, At, B0); PG8_MMA(0, 1, At, B1); PG8_BAR; PG8_SCHED;
            PG8_LDA(At, 1, 1); PG8_STAGE(PG8_SB(1, 0), b3, voffB); PG8_STAGE(PG8_SB(1, 1), b3 + hstep, voffB); PG8_STAGE(PG8_SA(1, 0), a3, voffA);
            PG8_WAIT_V(8); PG8_WAIT_L(0); PG8_BAR; PG8_MMA(1, 0, At, B0); PG8_MMA(1, 1, At, B1); PG8_BAR; PG8_SCHED;
        }
        if (wr == 0) PG8_BAR;
        E(acc, cur, wr, wc, fr, fq); S.done(cur);
        if (!has_next) break;
#pragma unroll
        for (int a = 0; a < 2; ++a)
#pragma unroll
            for (int b = 0; b < 2; ++b)
#pragma unroll
                for (int m = 0; m < 4; ++m)
#pragma unroll
                    for (int n = 0; n < 2; ++n) acc[a][b][m][n] = (f32x4){0.f, 0.f, 0.f, 0.f};
        cur = nxt; cA = nA; cB = nB; ++ui;
        if (wr == 1) PG8_BAR;
    }
    PG8_WAIT_V(0);
    PG8_BAR;
#undef PG8_SA
#undef PG8_SB
#undef PG8_STAGE
#undef PG8_LDA
#undef PG8_LDB
#undef PG8_MMA
#undef PG8_WAIT_V
#undef PG8_WAIT_L
#undef PG8_BAR
#undef PG8_SCHED
}
}
namespace att {
constexpr int D = 128, QBLK = 32, KVBLK = 64;
constexpr float SCALE = 0.088388347648318440f;
constexpr float THR = 8.f;
constexpr size_t SHM_V = KVBLK * D * 2, SHM_K = KVBLK * D * 2;
#define KSWZ(row, colB) ((row) * 256 + ((colB) ^ (((row) & 7) << 4)))
#define SBAR() __builtin_amdgcn_sched_barrier(0)
__device__ __forceinline__ int crow(int r, int hi) { return (r & 3) + 8 * (r >> 2) + 4 * hi; }

template <bool MASK>
__device__ __forceinline__ void partialSM(f32x16& p0, f32x16& p1, float& m_reg, float& mn, float& alpha, int dq, int hi) {
  constexpr float C = SCALE * 1.4426950408889634f;
  if (MASK) { if (dq < 100000) { const int dl = dq - 4 * hi - 128, dh = dq - 4 * hi + 128;
#pragma unroll
      for (int r = 0; r < 16; ++r) { const int k0 = (r & 3) + 8 * (r >> 2), k1 = k0 + 32;
        p0[r] = (k0 >= dl && k0 <= dh) ? p0[r] : -1e30f; p1[r] = (k1 >= dl && k1 <= dh) ? p1[r] : -1e30f; } } }
  float pmax = p0[0];
#pragma unroll
  for (int r = 1; r < 16; ++r) pmax = fmaxf(pmax, p0[r]);
#pragma unroll
  for (int r = 0; r < 16; ++r) pmax = fmaxf(pmax, p1[r]);
  { auto rr = __builtin_amdgcn_permlane32_swap(__float_as_uint(pmax), __float_as_uint(pmax), false, false);
    pmax = fmaxf(__uint_as_float(rr[0]), __uint_as_float(rr[1])); }
  if (__builtin_expect(__all(pmax - m_reg <= THR / SCALE), 1)) { mn = m_reg; alpha = 1.f; }
  else { mn = fmaxf(m_reg, pmax); alpha = __builtin_amdgcn_exp2f((m_reg - mn) * C); m_reg = mn; }
  float mnC = -mn * C;
#pragma unroll
  for (int r = 0; r < 16; ++r) p0[r] = fmaf(p0[r], C, mnC);
#pragma unroll
  for (int r = 0; r < 16; ++r) p1[r] = fmaf(p1[r], C, mnC);
#pragma unroll
  for (int r = 0; r < 16; ++r) p0[r] = __builtin_amdgcn_exp2f(p0[r]);
}
#define PK4(P, BASE, OUT) do { unsigned a0 = cvt_pk_bf16(P[BASE + 0], P[BASE + 1]), a1 = cvt_pk_bf16(P[BASE + 2], P[BASE + 3]);   \
    unsigned b0 = cvt_pk_bf16(P[BASE + 4], P[BASE + 5]), b1 = cvt_pk_bf16(P[BASE + 6], P[BASE + 7]);                              \
    auto r0 = __builtin_amdgcn_permlane32_swap(a0, b0, false, false); auto r1 = __builtin_amdgcn_permlane32_swap(a1, b1, false, false); \
    u32x4 w = {r0[0], r1[0], r0[1], r1[1]}; OUT = *reinterpret_cast<bf16x8*>(&w); } while (0)
__device__ __forceinline__ void finishSM(f32x16& p0, f32x16& p1, float alpha, float& l_reg, bf16x8& pa0, bf16x8& pa1, bf16x8& pa2, bf16x8& pa3) {
#pragma unroll
  for (int r = 0; r < 16; ++r) p1[r] = __builtin_amdgcn_exp2f(p1[r]);
  float ps = 0;
#pragma unroll
  for (int r = 0; r < 16; ++r) ps += p0[r];
#pragma unroll
  for (int r = 0; r < 16; ++r) ps += p1[r];
  { auto rr = __builtin_amdgcn_permlane32_swap(__float_as_uint(ps), __float_as_uint(ps), false, false);
    ps = __uint_as_float(rr[0]) + __uint_as_float(rr[1]); }
  l_reg = l_reg * alpha + ps;
  PK4(p0, 0, pa0); PK4(p0, 8, pa1); PK4(p1, 0, pa2); PK4(p1, 8, pa3);
}
__device__ __forceinline__ void qkt(f32x16& p0, f32x16& p1, const LAS char* Ks, const bf16x8* qr, int r32, int hi) {
  p0 = f32x16{}; p1 = f32x16{};
#pragma unroll
  for (int d0 = 0; d0 < 8; ++d0) { int cb = (d0 * 16 + hi * 8) * 2;
    bf16x8 b0 = *reinterpret_cast<const LAS bf16x8*>(Ks + KSWZ(r32, cb));
    bf16x8 b1 = *reinterpret_cast<const LAS bf16x8*>(Ks + KSWZ(32 + r32, cb));
    p0 = __builtin_amdgcn_mfma_f32_32x32x16_bf16(b0, qr[d0], p0, 0, 0, 0);
    p1 = __builtin_amdgcn_mfma_f32_32x32x16_bf16(b1, qr[d0], p1, 0, 0, 0); }
}
__device__ __forceinline__ int v_st(int k, int c) { const int kk = (k & ~0xC) | ((k & 4) << 1) | ((k & 8) >> 1); return ((kk >> 3) * 4 + (c >> 5)) * 512 + ((kk & 7) * 32 + (c & 31)) * 2; }
__device__ __forceinline__ int v_rd_base(int lane) { return ((lane & 3) << 3) | (((lane >> 2) & 3) << 6) | (((lane >> 4) & 1) << 5) | (((lane >> 5) & 1) << 8); }
constexpr int v_rd_off(int d0, int ks, int half) { return d0 * 512 + ks * 4096 + half * 2048; }
template <int OFF> __device__ __forceinline__ s16x4 tr_read(int vb) {
  s16x4 r; asm volatile("ds_read_b64_tr_b16 %0, %1 offset:%2" : "=&v"(r) : "v"(vb), "i"(OFF) : "memory"); return r;
}
#define PKV(L, H) (bf16x8){L[0], L[1], L[2], L[3], H[0], H[1], H[2], H[3]}
template <int D0> __device__ __forceinline__ void pv_one(f32x16& od, int vb, bf16x8 pa0, bf16x8 pa1, bf16x8 pa2, bf16x8 pa3) {
  const s16x4 l0 = tr_read<v_rd_off(D0, 0, 0)>(vb), h0 = tr_read<v_rd_off(D0, 0, 1)>(vb), l1 = tr_read<v_rd_off(D0, 1, 0)>(vb), h1 = tr_read<v_rd_off(D0, 1, 1)>(vb);
  const s16x4 l2 = tr_read<v_rd_off(D0, 2, 0)>(vb), h2 = tr_read<v_rd_off(D0, 2, 1)>(vb), l3 = tr_read<v_rd_off(D0, 3, 0)>(vb), h3 = tr_read<v_rd_off(D0, 3, 1)>(vb);
  asm volatile("s_waitcnt lgkmcnt(0)" ::: "memory"); SBAR();
  od = __builtin_amdgcn_mfma_f32_32x32x16_bf16(pa0, PKV(l0, h0), od, 0, 0, 0);
  od = __builtin_amdgcn_mfma_f32_32x32x16_bf16(pa1, PKV(l1, h1), od, 0, 0, 0);
  od = __builtin_amdgcn_mfma_f32_32x32x16_bf16(pa2, PKV(l2, h2), od, 0, 0, 0);
  od = __builtin_amdgcn_mfma_f32_32x32x16_bf16(pa3, PKV(l3, h3), od, 0, 0, 0);
}
__device__ __forceinline__ void pv_d0(f32x16* o, int vb, bf16x8 pa0, bf16x8 pa1, bf16x8 pa2, bf16x8 pa3) {
  pv_one<0>(o[0], vb, pa0, pa1, pa2, pa3); pv_one<1>(o[1], vb, pa0, pa1, pa2, pa3); pv_one<2>(o[2], vb, pa0, pa1, pa2, pa3); pv_one<3>(o[3], vb, pa0, pa1, pa2, pa3);
}

struct Args { const bf16_t* Q; const bf16_t* K; const bf16_t* V; bf16_t* O; int ldo, n0, base0, base1, NT, qpos0; float m_init, l_init; };
template <bool MASK>
__device__ __forceinline__ void attn_body(const Args a, LAS char* lds, int wave) {
  const int tid = tid_of(wave), wid = wave, lane = tid & 63, r32 = lane & 31, hi = lane >> 5;
  LAS char* V_lds = lds; LAS char* K_lds = lds + 2 * SHM_V;
  LAS float* ws = (LAS float*)(lds + 2 * SHM_V + 2 * SHM_K) + wid * 64; LAS float* li_l = ws; LAS float* al_l = ws + 32;
  float m_reg = a.m_init, l_reg = a.l_init; f32x16 o[4] = {}; bf16x8 qr[8];
  const bf16_t* Qw = a.Q + (long)(wid * QBLK + r32) * D + hi * 8;
#pragma unroll
  for (int d0 = 0; d0 < 8; ++d0) qr[d0] = *reinterpret_cast<const bf16x8*>(Qw + d0 * 16);
  const int sr = tid >> 4, sc = (tid & 15) * 8, vst0 = v_st(sr, sc), vst1 = v_st(32 + sr, sc);
  const int vb0 = (int)(unsigned)(uintptr_t)V_lds + v_rd_base(lane);
  const int qpos = a.qpos0 + wid * QBLK + r32;
  struct { bf16x8 vs0, vs1, ks0, ks1; } sr_[2];
#define KROW(j) (((j) < a.n0) ? (a.base0 + 64 * (j)) : (a.base1 + 64 * ((j) - a.n0)))
#define DQ(j) (((j) < a.n0) ? (qpos - (a.base0 + 64 * (j))) : 1000000)
#define SLOAD(i, j) do { const long k0_ = KROW(j); sr_[i].vs0 = *reinterpret_cast<const bf16x8*>(&a.V[(k0_ + sr) * D + sc]); sr_[i].vs1 = *reinterpret_cast<const bf16x8*>(&a.V[(k0_ + 32 + sr) * D + sc]); \
    sr_[i].ks0 = *reinterpret_cast<const bf16x8*>(&a.K[(k0_ + sr) * D + sc]); sr_[i].ks1 = *reinterpret_cast<const bf16x8*>(&a.K[(k0_ + 32 + sr) * D + sc]); } while (0)
#define SWRITE(b, i) do { *(LAS bf16x8*)(V_lds + (b) * SHM_V + vst0) = sr_[i].vs0;          \
    *(LAS bf16x8*)(V_lds + (b) * SHM_V + vst1) = sr_[i].vs1; int kc = sc * 2;               \
    *(LAS bf16x8*)(K_lds + (b) * SHM_K + KSWZ(sr, kc)) = sr_[i].ks0;                       \
    *(LAS bf16x8*)(K_lds + (b) * SHM_K + KSWZ(32 + sr, kc)) = sr_[i].ks1; } while (0)
#define SWAIT() asm volatile("s_waitcnt vmcnt(4)" ::: "memory")
#define RESC(al) do { if (__any((al) < 1.f)) { if (hi == 0) al_l[r32] = (al); asm volatile("s_waitcnt lgkmcnt(0)" ::: "memory"); \
    _Pragma("unroll") for (int d = 0; d < 4; ++d) _Pragma("unroll") for (int r = 0; r < 16; ++r) o[d][r] *= al_l[crow(r, hi)]; } } while (0)
  f32x16 pA0, pA1, pB0, pB1; float mnA, mnB, alA, alB; bf16x8 pa0, pa1, pa2, pa3; const int NT = a.NT;
  constexpr int SE = 0, SO = 1;
  SLOAD(SE, 0); asm volatile("s_waitcnt vmcnt(0)" ::: "memory"); SWRITE(0, SE); __syncthreads();
  qkt(pA0, pA1, K_lds, qr, r32, hi); partialSM<MASK>(pA0, pA1, m_reg, mnA, alA, DQ(0), hi);
  SLOAD(SO, 1); if (2 < NT) SLOAD(SE, 2);
  SWAIT(); SWRITE(1, SO); __syncthreads();
  for (int j = 1; j + 1 < NT; j += 2) {
    SBAR(); qkt(pB0, pB1, K_lds + SHM_K, qr, r32, hi);
    finishSM(pA0, pA1, alA, l_reg, pa0, pa1, pa2, pa3); SBAR();
    SLOAD(SO, j + 2); SBAR();
    pv_d0(o, vb0, pa0, pa1, pa2, pa3); partialSM<MASK>(pB0, pB1, m_reg, mnB, alB, DQ(j), hi);
    __syncthreads(); SWAIT(); SWRITE(0, SE);
    RESC(alB); __syncthreads();
    SBAR(); qkt(pA0, pA1, K_lds, qr, r32, hi);
    finishSM(pB0, pB1, alB, l_reg, pa0, pa1, pa2, pa3); SBAR();
    if (j + 3 < NT) SLOAD(SE, j + 3); SBAR();
    pv_d0(o, vb0 + (int)SHM_V, pa0, pa1, pa2, pa3); partialSM<MASK>(pA0, pA1, m_reg, mnA, alA, DQ(j + 1), hi);
    __syncthreads(); SWAIT(); SWRITE(1, SO);
    RESC(alA); __syncthreads();
  }
  SBAR(); qkt(pB0, pB1, K_lds + SHM_K, qr, r32, hi);
  finishSM(pA0, pA1, alA, l_reg, pa0, pa1, pa2, pa3); SBAR();
  pv_d0(o, vb0, pa0, pa1, pa2, pa3); partialSM<MASK>(pB0, pB1, m_reg, mnB, alB, DQ(NT - 1), hi);
  __syncthreads(); RESC(alB);
  finishSM(pB0, pB1, alB, l_reg, pa0, pa1, pa2, pa3); SBAR();
  pv_d0(o, vb0 + (int)SHM_V, pa0, pa1, pa2, pa3);
  if (hi == 0) li_l[r32] = l_reg; asm volatile("s_waitcnt lgkmcnt(0)" ::: "memory");
  float rli[16];
#pragma unroll
  for (int r = 0; r < 16; ++r) rli[r] = __builtin_amdgcn_rcpf(li_l[crow(r, hi)]);
  bf16_t* Ow = a.O + (long)(wid * QBLK) * a.ldo;
#pragma unroll
  for (int r = 0; r < 16; ++r) { int orow = crow(r, hi);
#pragma unroll
    for (int d0 = 0; d0 < 4; ++d0) { const float v = o[d0][r] * rli[r]; Ow[(long)orow * a.ldo + d0 * 32 + r32] = (bf16_t)(cvt_pk_bf16(v, v) & 0xffffu); } }
  __syncthreads();
#undef KROW
#undef DQ
#undef SLOAD
#undef SWRITE
#undef SWAIT
#undef RESC
}
}
namespace ml {
using namespace att;
struct Args { const bf16_t* Q; const bf16_t* K; const bf16_t* V; const float* GI; const float* GF; float* HM; int dir, ctx_out; };
constexpr int G_A = 0, G_M = 512, G_EBM = 1024, G_WINT = 1536, G_WK = 2048, G_STRIDE = 2560;
constexpr int SM_N = 5120, SM_RDEN = 5632, SM_SCAL = 6656, SM_NACC = 6720;

__device__ __forceinline__ void chunk_map(int c, int dir, int& P0, int& sgn) {
  const int cc = c < 2 ? c : c - 2, pbase = c < 2 ? SEQ : 0, nseg = c < 2 ? CTXL : SEQ;
  if (dir == 0) { P0 = pbase + cc * 128; sgn = 1; } else { P0 = pbase + nseg - 1 - cc * 128; sgn = -1; }
}
__device__ __forceinline__ float scan_add(float x, int lane) {
#pragma unroll
  for (int o = 1; o < 64; o <<= 1) { const float t = __int_as_float(__builtin_amdgcn_ds_bpermute((lane - o) << 2, __float_as_int(x))); if (lane >= o) x += t; }
  return x;
}
__device__ __forceinline__ float scan_max(float x, int lane) {
#pragma unroll
  for (int o = 1; o < 64; o <<= 1) { const float t = __int_as_float(__builtin_amdgcn_ds_bpermute((lane - o) << 2, __float_as_int(x))); if (lane >= o) x = fmaxf(x, t); }
  return x;
}
__device__ __forceinline__ void gate_tables(LAS char* gt, LAS float* scal, float ig0, float ig1, float lf0, float lf1, float m_prev, int lane) {
  float b0 = scan_add(lf0, lane); const float t0 = __int_as_float(__builtin_amdgcn_readlane(__float_as_int(b0), 63)); float b1 = scan_add(lf1, lane) + t0;
  const float a0 = ig0 - b0, a1 = ig1 - b1;
  float A0 = scan_max(a0, lane); const float tA = __int_as_float(__builtin_amdgcn_readlane(__float_as_int(A0), 63)); float A1 = fmaxf(scan_max(a1, lane), tA);
  const float M0 = fmaxf(m_prev, A0), M1 = fmaxf(m_prev, A1), Ml = __int_as_float(__builtin_amdgcn_readlane(__float_as_int(M1), 63)), bl = __int_as_float(__builtin_amdgcn_readlane(__float_as_int(b1), 63));
  LAS float* fa = (LAS float*)(gt + G_A); LAS float* fM = (LAS float*)(gt + G_M); LAS float* fe = (LAS float*)(gt + G_EBM); LAS float* fw = (LAS float*)(gt + G_WINT); LAS float* fk = (LAS float*)(gt + G_WK);
  fa[lane] = a0; fa[64 + lane] = a1; fM[lane] = M0; fM[64 + lane] = M1;
  fe[lane] = __expf(-(b0 + M0)); fe[64 + lane] = __expf(-(b1 + M1));
  fw[lane] = __expf(m_prev - M0); fw[64 + lane] = __expf(m_prev - M1);
  fk[lane] = __expf(a0 - Ml); fk[64 + lane] = __expf(a1 - Ml);
  if (lane == 0) { scal[0] = __expf(m_prev - Ml); scal[1] = bl + Ml; }
}

__device__ __forceinline__ void mlstm_seq(const Args a, LAS char* lds, int wave) {
  int tid = tid_of(wave); const int wid = wave, jb = wid & 3, eh = wid >> 2;
  int lane = tid & 63, r32 = lane & 31, hi = lane >> 5;
  LAS char* K_lds = lds; LAS char* V_lds = lds + 32768; LAS char* KW_lds = lds + 65536; LAS char* C_lds = lds + 98304; LAS char* sm = lds + ML_SM;
  LAS float* n_lds = (LAS float*)(sm + SM_N); LAS float* rden = (LAS float*)(sm + SM_RDEN) + wid * 32;
  LAS float* nacc = (LAS float*)(sm + SM_NACC);
  f32x16 cst[2] = {};
  for (int i = tid; i < 2048; i += NTHR) ((LAS u32x4*)C_lds)[i] = (u32x4){0u, 0u, 0u, 0u};
  if (tid < 128) { n_lds[tid] = 0.f; nacc[tid] = 0.f; nacc[128 + tid] = 0.f; }
  __syncthreads();
  int sr = tid >> 4, sc = (tid & 15) * 8;
  int vbV = (int)(unsigned)(uintptr_t)V_lds + v_rd_base(lane) + eh * 1024;
  int vbC = (int)(unsigned)(uintptr_t)C_lds + v_rd_base(lane) + eh * 1024;
  int vbKW = (int)(unsigned)(uintptr_t)KW_lds + v_rd_base(lane) + jb * 512;
  bf16x8 qr[8]; bf16x8 stK[4], stV[4];
  float gi0 = 0.f, gi1 = 0.f, gf0 = 0.f, gf1 = 0.f;
  constexpr int NCH = 34;
#define ML_LOADKV(c) do { int P0_, sg_; chunk_map((c), a.dir, P0_, sg_); _Pragma("unroll") for (int i = 0; i < 4; ++i) { const long pos = P0_ + sg_ * (sr + 32 * i); \
    stK[i] = *reinterpret_cast<const bf16x8*>(a.K + pos * 128 + sc); stV[i] = *reinterpret_cast<const bf16x8*>(a.V + pos * 128 + sc); } } while (0)
#define ML_LOADQ(c) do { int P0_, sg_; chunk_map((c), a.dir, P0_, sg_); const long pos = P0_ + sg_ * (jb * 32 + r32); \
    _Pragma("unroll") for (int d0 = 0; d0 < 8; ++d0) qr[d0] = *reinterpret_cast<const bf16x8*>(a.Q + pos * 128 + d0 * 16 + hi * 8); } while (0)
#define ML_LOADG(c) do { int P0_, sg_; chunk_map((c), a.dir, P0_, sg_); gi0 = a.GI[P0_ + sg_ * lane]; gi1 = a.GI[P0_ + sg_ * (64 + lane)]; gf0 = a.GF[P0_ + sg_ * lane]; gf1 = a.GF[P0_ + sg_ * (64 + lane)]; } while (0)
#define ML_WRITEKV(gt, nac) do { const LAS float* fk_ = (const LAS float*)((gt) + G_WK); float cs_[8] = {0.f, 0.f, 0.f, 0.f, 0.f, 0.f, 0.f, 0.f}; _Pragma("unroll") for (int i = 0; i < 4; ++i) { const int s = sr + 32 * i, tl = s >> 6, rr = s & 63; \
    *(LAS bf16x8*)(K_lds + tl * 16384 + KSWZ(rr, sc * 2)) = stK[i]; *(LAS bf16x8*)(V_lds + tl * 16384 + v_st(rr, sc)) = stV[i]; \
    const float w_ = fk_[s]; const u32x4 kk = *reinterpret_cast<const u32x4*>(&stK[i]); u32x4 o_; \
    o_.x = cvt_pk_bf16(bflo(kk.x) * w_, bfhi(kk.x) * w_); o_.y = cvt_pk_bf16(bflo(kk.y) * w_, bfhi(kk.y) * w_); o_.z = cvt_pk_bf16(bflo(kk.z) * w_, bfhi(kk.z) * w_); o_.w = cvt_pk_bf16(bflo(kk.w) * w_, bfhi(kk.w) * w_); \
    cs_[0] += bflo(o_.x); cs_[1] += bfhi(o_.x); cs_[2] += bflo(o_.y); cs_[3] += bfhi(o_.y); cs_[4] += bflo(o_.z); cs_[5] += bfhi(o_.z); cs_[6] += bflo(o_.w); cs_[7] += bfhi(o_.w); \
    *(LAS u32x4*)(KW_lds + tl * 16384 + v_st(rr, sc)) = o_; } \
    _Pragma("unroll") for (int i = 0; i < 8; ++i) (void)__hip_atomic_fetch_add((nac) + sc + i, cs_[i], __ATOMIC_RELAXED, __HIP_MEMORY_SCOPE_WORKGROUP); } while (0)
  if (wid == 0) { ML_LOADG(0); gate_tables(sm, (LAS float*)(sm + SM_SCAL), gi0, gi1, gf0, gf1, -1e30f, lane); ML_LOADG(1); }
  ML_LOADKV(0); ML_LOADQ(0);
  __syncthreads();
  ML_WRITEKV(sm, nacc);
  __syncthreads();
  for (int c = 0; c < NCH; ++c) {
    asm volatile("" : "+v"(tid)); lane = tid & 63; r32 = lane & 31; hi = lane >> 5; sr = tid >> 4; sc = (tid & 15) * 8;
    vbV = (int)(unsigned)(uintptr_t)V_lds + v_rd_base(lane) + eh * 1024; vbC = (int)(unsigned)(uintptr_t)C_lds + v_rd_base(lane) + eh * 1024; vbKW = (int)(unsigned)(uintptr_t)KW_lds + v_rd_base(lane) + jb * 512;
    const int par = c & 1; LAS char* gt = sm + par * G_STRIDE; LAS char* gtn = sm + (par ^ 1) * G_STRIDE;
    const LAS float* scal = (const LAS float*)(sm + SM_SCAL) + par * 4; LAS float* scaln = (LAS float*)(sm + SM_SCAL) + (par ^ 1) * 4;
    const float decay = scal[0];
    if (c + 1 < NCH) { if (wid == 0) { gate_tables(gtn, scaln, gi0, gi1, gf0, gf1, scal[1], lane); if (c + 2 < NCH) ML_LOADG(c + 2); } }
    const bool want_out = (c >= 2) || (a.ctx_out != 0);
    if (want_out) {
      const LAS float* fa = (const LAS float*)(gt + G_A); const LAS float* fM = (const LAS float*)(gt + G_M); const LAS float* fe = (const LAS float*)(gt + G_EBM); const LAS float* fw = (const LAS float*)(gt + G_WINT);
      const int j = jb * 32 + r32; const float Mj = fM[j], wintj = fw[j];
      f32x16 o[2] = {};
      pv_one<0>(o[0], vbC, qr[0], qr[1], qr[2], qr[3]); pv_one<1>(o[1], vbC, qr[0], qr[1], qr[2], qr[3]);
      pv_one<0>(o[0], vbC + 16384, qr[4], qr[5], qr[6], qr[7]); pv_one<1>(o[1], vbC + 16384, qr[4], qr[5], qr[6], qr[7]);
#pragma unroll
      for (int r = 0; r < 16; ++r) { const float w = fw[jb * 32 + crow(r, hi)]; o[0][r] *= w; o[1][r] *= w; }
      float qn = 0.f;
#pragma unroll
      for (int d0 = 0; d0 < 8; ++d0) { const u32x4 qq = *reinterpret_cast<const u32x4*>(&qr[d0]); const f32x4 n0 = *(const LAS f32x4*)(n_lds + d0 * 16 + hi * 8), n1 = *(const LAS f32x4*)(n_lds + d0 * 16 + hi * 8 + 4);
        qn += bflo(qq.x) * n0[0] + bfhi(qq.x) * n0[1] + bflo(qq.y) * n0[2] + bfhi(qq.y) * n0[3] + bflo(qq.z) * n1[0] + bfhi(qq.z) * n1[1] + bflo(qq.w) * n1[2] + bfhi(qq.w) * n1[3]; }
      { auto rr = __builtin_amdgcn_permlane32_swap(__float_as_uint(qn), __float_as_uint(qn), false, false); qn = __uint_as_float(rr[0]) + __uint_as_float(rr[1]); }
      float den = wintj * qn;
#pragma unroll
      for (int t = 0; t < 2; ++t) {
        if (t * 64 <= jb * 32 + 31) {
          f32x16 p0, p1; qkt(p0, p1, K_lds + t * 16384, qr, r32, hi);
          float ps = 0.f;
#pragma unroll
          for (int r = 0; r < 16; ++r) { const int s0 = t * 64 + crow(r, hi), s1 = s0 + 32;
            const float e0 = __expf(fa[s0] - Mj), e1 = __expf(fa[s1] - Mj);
            p0[r] = (s0 <= j) ? p0[r] * e0 : 0.f; p1[r] = (s1 <= j) ? p1[r] * e1 : 0.f; ps += p0[r] + p1[r]; }
          { auto rr = __builtin_amdgcn_permlane32_swap(__float_as_uint(ps), __float_as_uint(ps), false, false); ps = __uint_as_float(rr[0]) + __uint_as_float(rr[1]); }
          den += ps;
          bf16x8 pa0, pa1, pa2, pa3; PK4(p0, 0, pa0); PK4(p0, 8, pa1); PK4(p1, 0, pa2); PK4(p1, 8, pa3);
          pv_one<0>(o[0], vbV + t * 16384, pa0, pa1, pa2, pa3); pv_one<1>(o[1], vbV + t * 16384, pa0, pa1, pa2, pa3);
        }
      }
      const float rd = __builtin_amdgcn_rcpf(fmaxf(fabsf(den), fe[j]));
      if (hi == 0) rden[r32] = rd;
      asm volatile("s_waitcnt lgkmcnt(0)" ::: "memory");
      float* hp = a.HM + ((size_t)c * 128 + jb * 32 + 4 * hi) * 128 + eh * 64 + r32;
#pragma unroll
      for (int r = 0; r < 16; ++r) { const int jr = (r & 3) + 8 * (r >> 2); const float rv = rden[jr + 4 * hi];
        hp[jr * 128] = o[0][r] * rv; hp[jr * 128 + 32] = o[1][r] * rv; }
    }
    if (c + 1 < NCH) { ML_LOADQ(c + 1); ML_LOADKV(c + 1); }
    if (c + 1 < NCH) {
#pragma unroll
      for (int r = 0; r < 16; ++r) { cst[0][r] *= decay; cst[1][r] *= decay; }
#pragma unroll
      for (int t = 0; t < 2; ++t) {
#define ML_UPD(KS) do { const s16x4 kl = tr_read<v_rd_off(0, KS, 0)>(vbKW + t * 16384), kh = tr_read<v_rd_off(0, KS, 1)>(vbKW + t * 16384); \
        const s16x4 v0l = tr_read<v_rd_off(0, KS, 0)>(vbV + t * 16384), v0h = tr_read<v_rd_off(0, KS, 1)>(vbV + t * 16384); \
        const s16x4 v1l = tr_read<v_rd_off(1, KS, 0)>(vbV + t * 16384), v1h = tr_read<v_rd_off(1, KS, 1)>(vbV + t * 16384); \
        asm volatile("s_waitcnt lgkmcnt(0)" ::: "memory"); SBAR(); \
        const bf16x8 ka = PKV(kl, kh); \
        cst[0] = __builtin_amdgcn_mfma_f32_32x32x16_bf16(ka, PKV(v0l, v0h), cst[0], 0, 0, 0); \
        cst[1] = __builtin_amdgcn_mfma_f32_32x32x16_bf16(ka, PKV(v1l, v1h), cst[1], 0, 0, 0); } while (0)
        ML_UPD(0); ML_UPD(1); ML_UPD(2); ML_UPD(3);
#undef ML_UPD
      }
    }
    __syncthreads();
    if (c + 1 < NCH) {
#pragma unroll
      for (int i = 0; i < 2; ++i)
#pragma unroll
        for (int r = 0; r < 16; ++r) { const int dk = jb * 32 + crow(r, hi), e = (2 * eh + i) * 32 + r32;
          *(LAS bf16_t*)(C_lds + (dk >> 6) * 16384 + v_st(dk & 63, e)) = (bf16_t)(cvt_pk_bf16(cst[i][r], cst[i][r]) & 0xffffu); }
      if (tid < 128) { n_lds[tid] = decay * n_lds[tid] + nacc[par * 128 + tid]; nacc[par * 128 + tid] = 0.f; }
      ML_WRITEKV(gtn, nacc + (par ^ 1) * 128);
    }
    __syncthreads();
  }
#undef ML_LOADKV
#undef ML_LOADQ
#undef ML_LOADG
#undef ML_WRITEKV
}
}
struct Frame {
    char* lds; LAS unsigned char* lds3; volatile LAS unsigned* LC; unsigned* ctl; unsigned char* ws;
    int tid, lane, wave, G, bid;
    const float* const __attribute__((address_space(4)))* karg;
};
__device__ __forceinline__ const float* inp(const Frame& F, int k) { auto p = F.karg; asm volatile("" : "+s"(p)); return p[k]; }
__device__ __forceinline__ float* outp(const Frame& F) { auto p = F.karg; asm volatile("" : "+s"(p)); return (float*)p[28]; }
#define WSP(T, off) ((T*)(F.ws + (off)))

__device__ __forceinline__ void p_mod_partial(Frame& F) {
    float* sv = (float*)F.lds;
    float* MODP = WSP(float, WS_MODP);
    for (int it = F.bid; it < 2 * 16 * 24; it += F.G) {
        const int l = it / 384, ks = (it % 384) / 24, cc = it % 24, k0 = ks * 128, n = cc * 512 + F.tid;
        __syncthreads();
        for (int i = F.tid; i < 640; i += NTHR) { const int r = i >> 7, k = i & 127; const float c = (r < 4) ? inp(F, 1)[r * DM + k0 + k] : inp(F, 3)[k0 + k]; sv[i] = siluf_(c); }
        __syncthreads();
        const float* w = inp(F, 6) + (size_t)l * DM * 12288 + (size_t)k0 * 12288 + n;
        float a0 = 0.f, a1 = 0.f, a2 = 0.f, a3 = 0.f, a4 = 0.f;
#pragma unroll 8
        for (int k = 0; k < 128; ++k) { const float wv = w[(size_t)k * 12288]; a0 += sv[k] * wv; a1 += sv[128 + k] * wv; a2 += sv[256 + k] * wv; a3 += sv[384 + k] * wv; a4 += sv[512 + k] * wv; }
        float* o = MODP + ((size_t)(l * 16 + ks) * 5) * 12288 + n;
        o[0] = a0; o[12288] = a1; o[2 * 12288] = a2; o[3 * 12288] = a3; o[4 * 12288] = a4;
    }
    __syncthreads();
}
__device__ __forceinline__ void p_rope_tables(Frame& F) {
    float* ct = WSP(float, WS_ROPE); float* st = ct + SEQ * 64;
    for (int i = F.bid * NTHR + F.tid; i < SEQ * 64; i += F.G * NTHR) {
        const int t = i >> 6, j = i & 63, ax = j >> 5, f = j & 31;
        const float inv = powf(10000.0f, -(float)(2 * f) / 64.0f);
        const float ang = (float)(ax == 0 ? (t >> 6) : (t & 63)) * inv;
        ct[i] = __cosf(ang); st[i] = __sinf(ang);
    }
}
__device__ __forceinline__ void p_mod_reduce(Frame& F) {
    const float* MODP = WSP(float, WS_MODP); float* MOD = WSP(float, WS_MOD);
    for (int i = F.bid * NTHR + F.tid; i < 2 * 5 * 12288; i += F.G * NTHR) {
        const int l = i / 61440, r = (i % 61440) / 12288, n = i % 12288;
        float s = inp(F, 7)[l * 12288 + n];
#pragma unroll
        for (int ks = 0; ks < 16; ++ks) s += MODP[((size_t)(l * 16 + ks) * 5 + r) * 12288 + n];
        MOD[i] = s;
    }
}
__device__ __forceinline__ void tr_item(const float* src, size_t lds_, int k0, int ns0, int nvalid, bf16_t* dst, size_t ldd, int kd0, int mode, int rowbase, float* scr, int lane) {
    const int cl = lane & 31;
#pragma unroll 8
    for (int i = 0; i < 32; ++i) { const int kk = 2 * i + (lane >> 5); scr[kk * 33 + cl] = (cl < nvalid) ? src[(size_t)(k0 + kk) * lds_ + ns0 + cl] : 0.f; }
    LDS_WAIT(); asm volatile("" ::: "memory");
    const int c = lane & 7;
#pragma unroll
    for (int j = 0; j < 4; ++j) { const int n = (lane >> 3) + 8 * j; const float* s = scr + (8 * c) * 33 + n;
        u32x4 o; o.x = cvt_pk_bf16(s[0 * 33], s[1 * 33]); o.y = cvt_pk_bf16(s[2 * 33], s[3 * 33]); o.z = cvt_pk_bf16(s[4 * 33], s[5 * 33]); o.w = cvt_pk_bf16(s[6 * 33], s[7 * 33]);
        const int drow = mode == 0 ? rowbase + n : rowbase + 8 * (n >> 2) + (n & 3);
        *(u32x4*)(dst + (size_t)drow * ldd + kd0 + 8 * c) = o; }
    LDS_WAIT(); asm volatile("" ::: "memory");
}
__device__ __forceinline__ void p_convert_weights(Frame& F, int l) {
    float* scr = (float*)(F.lds + F.wave * 16384);
    const int gw = F.bid * NWAVES + F.wave, NGW = F.G * NWAVES;
    bf16_t* WIN = WSP(bf16_t, WS_WIN); bf16_t* WBR = WSP(bf16_t, WS_WBR); bf16_t* WOUT = WSP(bf16_t, WS_WOUT); bf16_t* WGU = WSP(bf16_t, WS_WGU); bf16_t* WD = WSP(bf16_t, WS_WD);
    const float* w_in = inp(F, 8) + (size_t)l * DM * PIN;
    const float* w_a = inp(F, 16) + (size_t)l * 1024 * DM; const float* w_m = inp(F, 17) + (size_t)l * 512 * DM; const float* w_c = inp(F, 18) + (size_t)l * 512 * DM;
    const float* w_o = inp(F, 19) + (size_t)l * DM * DM;
    const float* w_g = inp(F, 24) + (size_t)l * NEXP * DM * DFF; const float* w_u = inp(F, 25) + (size_t)l * NEXP * DM * DFF; const float* w_d = inp(F, 26) + (size_t)l * NEXP * DFF * DM;
    constexpr int I_IN = 344 * 32, I_A = 16 * 64, I_M = 8 * 64, I_O = 32 * 64, I_G = NEXP * 32 * 16, I_D = NEXP * 8 * 64;
    constexpr int NIT = I_IN + I_A + 2 * I_M + I_O + 2 * I_G + I_D;
    for (int it = gw; it < NIT; it += NGW) {
        int r = it;
        if (r < I_IN) { const int nb = r >> 5, kb = r & 31;
            int ns0, nv; if (nb < 112) { ns0 = nb * 32; nv = 32; } else if (nb < 336) { ns0 = nb * 32 + 16; nv = 32; } else if (nb == 336) { ns0 = 3584; nv = 16; } else { ns0 = 0; nv = 0; }
            tr_item(w_in, PIN, kb * 64, ns0, nv, WIN, DM, kb * 64, 0, nb * 32, scr, F.lane); continue; } r -= I_IN;
        if (r < I_A) { const int kb = r >> 6, nb = r & 63; tr_item(w_a, DM, kb * 64, nb * 32, 32, WBR, DM, kb * 64, 0, nb * 32, scr, F.lane); continue; } r -= I_A;
        if (r < I_M) { const int kb = r >> 6, nb = r & 63; tr_item(w_m, DM, kb * 64, nb * 32, 32, WBR, DM, 1024 + kb * 64, 0, nb * 32, scr, F.lane); continue; } r -= I_M;
        if (r < I_M) { const int kb = r >> 6, nb = r & 63; tr_item(w_c, DM, kb * 64, nb * 32, 32, WBR, DM, 1536 + kb * 64, 0, nb * 32, scr, F.lane); continue; } r -= I_M;
        if (r < I_O) { const int kb = r >> 6, nb = r & 63; tr_item(w_o, DM, kb * 64, nb * 32, 32, WOUT, DM, kb * 64, 0, nb * 32, scr, F.lane); continue; } r -= I_O;
        if (r < I_G) { const int e = r >> 9, kb = (r >> 4) & 31, fb = r & 15; tr_item(w_g + (size_t)e * DM * DFF, DFF, kb * 64, fb * 32, 32, WGU, DM, kb * 64, 1, e * 1024 + fb * 64, scr, F.lane); continue; } r -= I_G;
        if (r < I_G) { const int e = r >> 9, kb = (r >> 4) & 31, fb = r & 15; tr_item(w_u + (size_t)e * DM * DFF, DFF, kb * 64, fb * 32, 32, WGU, DM, kb * 64, 1, e * 1024 + fb * 64 + 4, scr, F.lane); continue; } r -= I_G;
        { const int e = r >> 9, kb = (r >> 6) & 7, nb = r & 63; tr_item(w_d + (size_t)e * DFF * DM, DM, kb * 64, nb * 32, 32, WD, DFF, kb * 64, 0, e * 2048 + nb * 32, scr, F.lane); }
    }
}

struct RowVec { f32x4 v[8]; };
__device__ __forceinline__ void row_load(RowVec& x, const float* p, int lane) {
#pragma unroll
    for (int j = 0; j < 8; ++j) x.v[j] = *(const f32x4*)(p + (j * 64 + lane) * 4);
}
__device__ __forceinline__ float row_rms(const RowVec& x) {
    float s = 0.f;
#pragma unroll
    for (int j = 0; j < 8; ++j) s += (x.v[j][0] * x.v[j][0] + x.v[j][1] * x.v[j][1]) + (x.v[j][2] * x.v[j][2] + x.v[j][3] * x.v[j][3]);
    return rsqrtf(wave_sum(s) * (1.0f / DM) + EPS);
}
__device__ __forceinline__ void row_add_moe(RowVec& x, const bf16_t* MOEOUT, int d0, int d1, const float* g2, int lane) {
#pragma unroll
    for (int j = 0; j < 8; ++j) { const int c = (j * 64 + lane) * 4;
        const u32x2 a = *(const u32x2*)(MOEOUT + (size_t)d0 * DM + c), b = *(const u32x2*)(MOEOUT + (size_t)d1 * DM + c); const f32x4 g = *(const f32x4*)(g2 + c);
        x.v[j][0] += g[0] * (bflo(a.x) + bflo(b.x)); x.v[j][1] += g[1] * (bfhi(a.x) + bfhi(b.x)); x.v[j][2] += g[2] * (bflo(a.y) + bflo(b.y)); x.v[j][3] += g[3] * (bfhi(a.y) + bfhi(b.y)); }
}
__device__ __forceinline__ void row_modulate(RowVec& x, float rms, const float* ng, const float* sh, const float* sc, int lane) {
#pragma unroll
    for (int j = 0; j < 8; ++j) { const int c = (j * 64 + lane) * 4; const f32x4 g = *(const f32x4*)(ng + c), s = *(const f32x4*)(sc + c), h = *(const f32x4*)(sh + c);
        x.v[j] = (x.v[j] * rms * g) * (s + 1.0f) + h; }
}
__device__ __forceinline__ void row_store_bf16(const RowVec& x, bf16_t* p, int lane) {
#pragma unroll
    for (int j = 0; j < 8; ++j) { u32x2 o; o.x = cvt_pk_bf16(x.v[j][0], x.v[j][1]); o.y = cvt_pk_bf16(x.v[j][2], x.v[j][3]); *(u32x2*)(p + (j * 64 + lane) * 4) = o; }
}
__device__ __forceinline__ void row_store_f32(const RowVec& x, float* p, int lane) {
#pragma unroll
    for (int j = 0; j < 8; ++j) *(f32x4*)(p + (j * 64 + lane) * 4) = x.v[j];
}
__device__ __forceinline__ void p_norm1(Frame& F, int l) {
    const int gw = F.bid * NWAVES + F.wave, NGW = F.G * NWAVES;
    const float* MOD = WSP(float, WS_MOD); bf16_t* H = WSP(bf16_t, WS_H); float* XL = WSP(float, WS_XL); float* XC = WSP(float, WS_XC);
    const bf16_t* MOEOUT = WSP(bf16_t, WS_MOEOUT); const int* SLOTD = (const int*)(F.ws + WS_ROUTE + RT_SLOTD);
    const float* ng = inp(F, 4) + l * DM;
    for (int row = gw; row < NROW; row += NGW) {
        const bool lat = row < NLAT; const int mr = lat ? (row >> 12) : 4;
        RowVec x;
        if (l == 0) row_load(x, lat ? inp(F, 0) + (size_t)row * DM : inp(F, 2) + (size_t)(row - NLAT) * DM, F.lane);
        else { float* xp = lat ? XL + (size_t)row * DM : XC + (size_t)(row - NLAT) * DM; row_load(x, xp, F.lane);
            row_add_moe(x, MOEOUT, SLOTD[row * 2], SLOTD[row * 2 + 1], MOD + (size_t)((l - 1) * 5 + mr) * 12288 + 10240, F.lane); row_store_f32(x, xp, F.lane); }
        const float rms = row_rms(x); const float* m = MOD + (size_t)(l * 5 + mr) * 12288;
        row_modulate(x, rms, ng, m, m + 2048, F.lane);
        row_store_bf16(x, H + (size_t)row * DM, F.lane);
    }
}
__device__ __forceinline__ void p_final(Frame& F) {
    const int gw = F.bid * NWAVES + F.wave, NGW = F.G * NWAVES;
    const float* MOD = WSP(float, WS_MOD); const float* XL = WSP(float, WS_XL);
    const bf16_t* MOEOUT = WSP(bf16_t, WS_MOEOUT); const int* SLOTD = (const int*)(F.ws + WS_ROUTE + RT_SLOTD);
    float* out_ = outp(F); const float* fg_ = inp(F, 27);
    for (int row = gw; row < NLAT; row += NGW) {
        RowVec x; row_load(x, XL + (size_t)row * DM, F.lane);
        row_add_moe(x, MOEOUT, SLOTD[row * 2], SLOTD[row * 2 + 1], MOD + (size_t)(5 + (row >> 12)) * 12288 + 10240, F.lane);
        const float rms = row_rms(x);
#pragma unroll
        for (int j = 0; j < 8; ++j) { const int c = (j * 64 + F.lane) * 4; const f32x4 g = *(const f32x4*)(fg_ + c); *(f32x4*)(out_ + (size_t)row * DM + c) = x.v[j] * rms * g; }
    }
}
__device__ __forceinline__ void p_norm2_route(Frame& F, int l, int nrows) {
    const int gw = F.bid * NWAVES + F.wave, NGW = F.G * NWAVES;
    const float* MOD = WSP(float, WS_MOD); bf16_t* H = WSP(bf16_t, WS_H); const float* XL = WSP(float, WS_XL); const float* XC = WSP(float, WS_XC);
    const float* ng = inp(F, 5) + l * DM; const float* w_rg = inp(F, 20) + (size_t)l * DM * 4; const float* w_re = inp(F, 22) + (size_t)l * DM * 16;
    const float* b_rg = inp(F, 21) + l * 4; const float* b_re = inp(F, 23) + l * 16;
    int* lc = (int*)F.lds;
    if (F.tid < 64) lc[F.tid] = 0;
    __syncthreads();
    for (int row = gw; row < nrows; row += NGW) {
        const bool lat = row < NLAT; const int mr = lat ? (row >> 12) : 4;
        RowVec x; row_load(x, lat ? XL + (size_t)row * DM : XC + (size_t)(row - NLAT) * DM, F.lane);
        const float rms = row_rms(x); const float* m = MOD + (size_t)(l * 5 + mr) * 12288;
        row_modulate(x, rms, ng, m + 6144, m + 8192, F.lane);
        row_store_bf16(x, H + (size_t)row * DM, F.lane);
        float lg[20];
#pragma unroll
        for (int i = 0; i < 20; ++i) lg[i] = 0.f;
        const int lane_o = opaque(F.lane);
#pragma unroll
        for (int j = 0; j < 8; ++j)
#pragma unroll
            for (int i = 0; i < 4; ++i) { const int k = (j * 64 + lane_o) * 4 + i; const float hv = x.v[j][i];
                const f32x4 wg = *(const f32x4*)(w_rg + (size_t)k * 4);
                const f32x4 e0 = *(const f32x4*)(w_re + (size_t)k * 16), e1 = *(const f32x4*)(w_re + (size_t)k * 16 + 4), e2 = *(const f32x4*)(w_re + (size_t)k * 16 + 8), e3 = *(const f32x4*)(w_re + (size_t)k * 16 + 12);
#pragma unroll
                for (int q = 0; q < 4; ++q) { lg[q] += hv * wg[q]; lg[4 + q] += hv * e0[q]; lg[8 + q] += hv * e1[q]; lg[12 + q] += hv * e2[q]; lg[16 + q] += hv * e3[q]; }
                if (i == 3) asm volatile("" ::: "memory"); }
#pragma unroll
        for (int i = 0; i < 20; ++i) lg[i] = wave_sum(lg[i]);
        if (F.lane == 0) {
            const float g0 = lg[0] + b_rg[0], g1 = lg[1] + b_rg[1], g2 = lg[2] + b_rg[2], g3 = lg[3] + b_rg[3];
            int gs = 0; float gm = g0; if (g1 > gm) { gm = g1; gs = 1; } if (g2 > gm) { gm = g2; gs = 2; } if (g3 > gm) { gm = g3; gs = 3; }
            const float pg = 1.0f / (__expf(g0 - gm) + __expf(g1 - gm) + __expf(g2 - gm) + __expf(g3 - gm));
            float el[4];
#pragma unroll
            for (int q = 0; q < 4; ++q) { float v = 0.f;
#pragma unroll
                for (int g = 0; g < 4; ++g) v = (g == gs) ? lg[4 + g * 4 + q] + b_re[g * 4 + q] : v; el[q] = v; }
            int i0 = 0; float m0 = el[0];
#pragma unroll
            for (int q = 1; q < 4; ++q) if (el[q] > m0) { m0 = el[q]; i0 = q; }
            int i1 = -1; float m1 = -3.0e38f;
#pragma unroll
            for (int q = 0; q < 4; ++q) if (q != i0 && el[q] > m1) { m1 = el[q]; i1 = q; }
            const float p1 = __expf(m1 - m0);
            const float w0 = pg / (1.0f + p1), w1 = pg * p1 / (1.0f + p1);
            const int e0 = gs * 4 + i0, e1 = gs * 4 + i1;
            const int n = atomicAdd(&lc[32], 2);
            const int q0 = atomicAdd(&lc[e0], 1), q1 = atomicAdd(&lc[e1], 1);
            int* en = lc + 64 + n * 4;
            en[0] = row * 2; en[1] = e0; en[2] = q0; ((float*)en)[3] = w0;
            en[4] = row * 2 + 1; en[5] = e1; en[6] = q1; ((float*)en)[7] = w1;
        }
    }
    __syncthreads();
    if (F.tid < 16) lc[16 + F.tid] = (int)atomicAdd(F.ctl + CW_ECNT + (l * 16 + F.tid) * 64, (unsigned)lc[F.tid]);
    __syncthreads();
    int* SLOTE = (int*)(F.ws + WS_ROUTE + RT_SLOTE); int* SLOTP = (int*)(F.ws + WS_ROUTE + RT_SLOTP); float* SLOTW = (float*)(F.ws + WS_ROUTE + RT_SLOTW);
    const int ne = lc[32];
    for (int i = F.tid; i < ne; i += NTHR) { const int* en = lc + 64 + i * 4; const int s = en[0], e = en[1]; SLOTE[s] = e; SLOTP[s] = lc[16 + e] + en[2]; SLOTW[s] = ((const float*)en)[3]; }
    __syncthreads();
}
__device__ __forceinline__ int moe_tables(Frame& F, int l) {
    volatile LAS int* T = (volatile LAS int*)(F.LC + LC_TILE);
    __syncthreads();
    if (F.tid == 0) {
        int off = 0, nt = 0;
#pragma unroll 1
        for (int e = 0; e < NEXP; ++e) { const int c = (int)__hip_atomic_load(F.ctl + CW_ECNT + (l * 16 + e) * 64, __ATOMIC_RELAXED, __HIP_MEMORY_SCOPE_AGENT); const int t = (c + 255) >> 8;
            T[160 + e] = off;
#pragma unroll 1
            for (int i = 0; i < t; ++i) T[nt + i] = e;
            nt += t; off += t * 256; }
        T[176] = off; T[180] = nt;
    }
    __syncthreads();
    return T[180];
}
__device__ __forceinline__ void p_gather(Frame& F, int l, int nrows) {
    (void)moe_tables(F, l);
    volatile LAS int* T = (volatile LAS int*)(F.LC + LC_TILE);
    const int gw = F.bid * NWAVES + F.wave, NGW = F.G * NWAVES;
    const int* SLOTE = (const int*)(F.ws + WS_ROUTE + RT_SLOTE); const int* SLOTP = (const int*)(F.ws + WS_ROUTE + RT_SLOTP); const float* SLOTW = (const float*)(F.ws + WS_ROUTE + RT_SLOTW);
    int* SLOTD = (int*)(F.ws + WS_ROUTE + RT_SLOTD); float* WSORT = (float*)(F.ws + WS_ROUTE + RT_WSORT);
    const bf16_t* H = WSP(bf16_t, WS_H); bf16_t* XS = WSP(bf16_t, WS_XS);
    for (int s = gw; s < nrows * 2; s += NGW) {
        const int e = SLOTE[s], d = T[160 + e] + SLOTP[s], row = s >> 1;
        const u32x4* src = (const u32x4*)(H + (size_t)row * DM); u32x4* dst = (u32x4*)(XS + (size_t)d * DM);
        const u32x4 a = src[F.lane], b = src[64 + F.lane], c = src[128 + F.lane], dd = src[192 + F.lane];
        dst[F.lane] = a; dst[64 + F.lane] = b; dst[128 + F.lane] = c; dst[192 + F.lane] = dd;
        if (F.lane == 0) { SLOTD[s] = d; WSORT[d] = SLOTW[s]; }
    }
    for (int i = F.bid * NTHR + F.tid; i < NEXP * 256; i += F.G * NTHR) { const int e = i >> 8, j = i & 255;
        const int c = (int)__hip_atomic_load(F.ctl + CW_ECNT + (l * 16 + e) * 64, __ATOMIC_RELAXED, __HIP_MEMORY_SCOPE_AGENT); const int pad = ((c + 255) & ~255) - c;
        if (j < pad) WSORT[T[160 + e] + c + j] = 0.f; }
}

__device__ __forceinline__ void unpack8(const u32x4 w, float* v) { v[0] = bflo(w.x); v[1] = bfhi(w.x); v[2] = bflo(w.y); v[3] = bfhi(w.y); v[4] = bflo(w.z); v[5] = bfhi(w.z); v[6] = bflo(w.w); v[7] = bfhi(w.w); }
__device__ __forceinline__ u32x4 pack8(const float* v) { u32x4 w; w.x = cvt_pk_bf16(v[0], v[1]); w.y = cvt_pk_bf16(v[2], v[3]); w.z = cvt_pk_bf16(v[4], v[5]); w.w = cvt_pk_bf16(v[6], v[7]); return w; }
__device__ __forceinline__ void p_prep(Frame& F, int l) {
    const bf16_t* P1 = WSP(bf16_t, WS_P1);
    const float* ctab = WSP(float, WS_ROPE); const float* stab = ctab + SEQ * 64;
    const int g = F.tid >> 4, li = F.tid & 15, c0 = g * 128 + li * 8;
    const float* qn = inp(F, 9) + l * HD; const float* kn = inp(F, 10) + l * HD; const float* cw = inp(F, 11) + (size_t)l * 3 * 1024;
    for (int row = F.bid; row < NROW; row += F.G) {
        const bool lat = row < NLAT; const int b = lat ? (row >> 12) : ((row - NLAT) >> 8), t = lat ? (row & 4095) : ((row - NLAT) & 255);
        const int pos = lat ? t : SEQ + t;
        float v[8]; unpack8(*(const u32x4*)(P1 + (size_t)row * 4096 + c0), v);
        bf16_t* dst;
        if (g < 10 || (g >= 24 && g < 30)) {
            const bool isq = (g < 8) || (g >= 24 && g < 28);
            if (g < 10) {
                float s = 0.f;
#pragma unroll
                for (int i = 0; i < 8; ++i) s += v[i] * v[i];
                s += xshfl<1>(s); s += xshfl<2>(s); s += xshfl<4>(s); s += xshfl<8>(s);
                const float r = rsqrtf(s * (1.0f / 128.0f) + EPS); const float* gg = (g < 8 ? qn : kn) + li * 8;
#pragma unroll
                for (int i = 0; i < 8; ++i) v[i] = v[i] * r * gg[i];
            }
            if (lat) {
                const int ax = li >> 3, half = (li >> 2) & 1, f0 = (li & 3) * 8;
                const float* cp = ctab + (size_t)t * 64 + ax * 32 + f0; const float* sp = stab + (size_t)t * 64 + ax * 32 + f0;
#pragma unroll
                for (int i = 0; i < 8; ++i) { const float o = xshfl<4>(v[i]); const float c = cp[i], s = sp[i]; v[i] = half ? (v[i] * c + o * s) : (v[i] * c - o * s); }
            }
            if (g < 8) dst = lat ? WSP(bf16_t, WS_QA) + ((size_t)(b * 8 + g) * SEQ + t) * HD : WSP(bf16_t, WS_QAC) + ((size_t)(b * 8 + g) * CTXL + t) * HD;
            else if (g < 10) dst = WSP(bf16_t, WS_KA) + ((size_t)(b * 2 + (g - 8)) * KVL + pos) * HD;
            else if (g < 28) dst = lat ? WSP(bf16_t, WS_QC) + ((size_t)(b * 4 + (g - 24)) * SEQ + t) * HD : WSP(bf16_t, WS_QCC) + ((size_t)(b * 4 + (g - 24)) * CTXL + t) * HD;
            else dst = WSP(bf16_t, WS_KC) + ((size_t)(b * 2 + (g - 28)) * KVL + pos) * HD;
            (void)isq;
        } else if (g >= 12 && g < 20) {
            const int T = lat ? SEQ : CTXL; const int ch = (g - 12) * 128 + li * 8;
            float vm[8], vp[8];
            if (t > 0) unpack8(*(const u32x4*)(P1 + (size_t)(row - 1) * 4096 + c0), vm); else {
#pragma unroll
                for (int i = 0; i < 8; ++i) vm[i] = 0.f; }
            if (t < T - 1) unpack8(*(const u32x4*)(P1 + (size_t)(row + 1) * 4096 + c0), vp); else {
#pragma unroll
                for (int i = 0; i < 8; ++i) vp[i] = 0.f; }
            const float ksc = (g >= 16) ? 0.088388347648318440f : 1.0f;
#pragma unroll
            for (int i = 0; i < 8; ++i) { const float y = cw[ch + i] * vm[i] + cw[1024 + ch + i] * v[i] + cw[2048 + ch + i] * vp[i]; v[i] = siluf_(y) * ksc; }
            dst = (g < 16 ? WSP(bf16_t, WS_QM) : WSP(bf16_t, WS_KM)) + ((size_t)(b * 4 + ((g - 12) & 3)) * KVL + pos) * HD;
        } else if (g < 12) dst = WSP(bf16_t, WS_VA) + ((size_t)(b * 2 + (g - 10)) * KVL + pos) * HD;
        else if (g < 24) dst = WSP(bf16_t, WS_VM) + ((size_t)(b * 4 + (g - 20)) * KVL + pos) * HD;
        else dst = WSP(bf16_t, WS_VC) + ((size_t)(b * 2 + (g - 30)) * KVL + pos) * HD;
        *(u32x4*)(dst + li * 8) = pack8(v);
    }
    const float* GRAW = WSP(float, WS_GRAW); float* GI = WSP(float, WS_GATE); float* GF = GI + NB * 2 * 4 * KVL;
    const float* igb = inp(F, 12) + l * 8; const float* fgb = inp(F, 13) + l * 8;
    for (int i = F.bid * NTHR + F.tid; i < NROW * 8; i += F.G * NTHR) {
        const int row = i >> 3, dh = i & 7; const bool lat = row < NLAT; const int b = lat ? (row >> 12) : ((row - NLAT) >> 8), pos = lat ? (row & 4095) : SEQ + ((row - NLAT) & 255);
        const float gi = GRAW[(size_t)row * 16 + dh] + igb[dh]; const float xf = GRAW[(size_t)row * 16 + 8 + dh] + fgb[dh];
        const float lf = fminf(xf, 0.f) - log1pf(__expf(-fabsf(xf)));
        GI[(size_t)(b * 8 + dh) * KVL + pos] = gi; GF[(size_t)(b * 8 + dh) * KVL + pos] = lf;
    }
}
__device__ __forceinline__ void p_omprep(Frame& F, int l, int nrows) {
    const float* HM = WSP(float, WS_HM); const bf16_t* MO = WSP(bf16_t, WS_MO); bf16_t* OALL = WSP(bf16_t, WS_OALL);
    const float* mg = inp(F, 14) + l * 512;
    const int li = F.tid & 15;
    for (int it = F.bid * 32 + (F.tid >> 4); it < nrows * 4; it += F.G * 32) {
        const int row = it >> 2, h = it & 3; const size_t o = (size_t)row * 512 + h * 128 + li * 8;
        const bool lat = row < NLAT; const int b = lat ? (row >> 12) : ((row - NLAT) >> 8), t = lat ? (row & 4095) : ((row - NLAT) & 255);
        const int p0 = lat ? CTXL + t : t, p1 = lat ? CTXL + (SEQ - 1 - t) : (CTXL - 1 - t);
        const float* h0 = HM + ((size_t)((0 * 4 + b) * 4 + h) * KVL + p0) * HD + li * 8; const float* h1 = HM + ((size_t)((1 * 4 + b) * 4 + h) * KVL + p1) * HD + li * 8;
        const f32x4 a0 = *(const f32x4*)(h0), a1 = *(const f32x4*)(h0 + 4), b0 = *(const f32x4*)(h1), b1 = *(const f32x4*)(h1 + 4);
        float v[8] = {a0[0] + b0[0], a0[1] + b0[1], a0[2] + b0[2], a0[3] + b0[3], a1[0] + b1[0], a1[1] + b1[1], a1[2] + b1[2], a1[3] + b1[3]};
        float s = 0.f;
#pragma unroll
        for (int i = 0; i < 8; ++i) s += v[i] * v[i];
        s += xshfl<1>(s); s += xshfl<2>(s); s += xshfl<4>(s); s += xshfl<8>(s);
        const float r = rsqrtf(s * (1.0f / 128.0f) + EPS);
        float gt[8]; unpack8(*(const u32x4*)(MO + o), gt);
#pragma unroll
        for (int i = 0; i < 8; ++i) v[i] = v[i] * r * mg[h * 128 + li * 8 + i] * gt[i];
        *(u32x4*)(OALL + (size_t)row * DM + 1024 + h * 128 + li * 8) = pack8(v);
    }
}
__device__ __forceinline__ int mixer_pop(Frame& F, int l, int kind, int x) {
    __syncthreads();
    if (F.tid == 0) F.LC[LC_Q] = atomicAdd(F.ctl + CW_QCTR + ((l * 3 + kind) * 8 + x) * 64, 1u);
    __syncthreads();
    return (int)F.LC[LC_Q];
}
__device__ __forceinline__ void p_mixers(Frame& F, int l) {
    const int x0 = (int)(xb_xcc_id() & 7u);
    bf16_t* OALL = WSP(bf16_t, WS_OALL);
    LAS char* lds = (LAS char*)F.lds3;
#ifndef MIX_EN
#define MIX_EN 7
#endif
    if (MIX_EN & 1) for (int dx = 0; dx < 8; ++dx) { const int x = (x0 + dx) & 7, b = x >> 1, kvh = x & 1;
        for (;;) { const int u = mixer_pop(F, l, 0, x); if (u >= 4) break;
            const int h = kvh * 2 + (u >> 1), dir = u & 1;
            ml::Args a; const size_t ho = (size_t)(b * 4 + h) * KVL * HD;
            a.Q = WSP(bf16_t, WS_QM) + ho; a.K = WSP(bf16_t, WS_KM) + ho; a.V = WSP(bf16_t, WS_VM) + ho;
            a.GI = WSP(float, WS_GATE) + (size_t)((b * 2 + dir) * 4 + h) * KVL; a.GF = a.GI + (size_t)NB * 8 * KVL;
            a.HM = WSP(float, WS_HM) + (size_t)((dir * 4 + b) * 4 + h) * KVL * HD; a.dir = dir; a.ctx_out = (l == 0);
            ml::mlstm_seq(a, lds, F.wave); } }
    const int nu1 = (l == 0) ? 70 : 64;
    if (MIX_EN & 2) for (int dx = 0; dx < 8; ++dx) { const int x = (x0 + dx) & 7, b = x >> 1, kvh = x & 1;
        for (;;) { const int u = mixer_pop(F, l, 1, x); if (u >= nu1) break;
            att::Args a; a.ldo = DM; a.base1 = 0; a.qpos0 = 0;
            if (u < 68) {
                a.K = WSP(bf16_t, WS_KA) + (size_t)(b * 2 + kvh) * KVL * HD; a.V = WSP(bf16_t, WS_VA) + (size_t)(b * 2 + kvh) * KVL * HD; a.m_init = -1e30f; a.l_init = 0.f;
                if (u < 64) { const int h = kvh * 4 + (u >> 4), qb = u & 15; a.Q = WSP(bf16_t, WS_QA) + ((size_t)(b * 8 + h) * SEQ + qb * 256) * HD;
                    a.O = OALL + (size_t)(b * SEQ + qb * 256) * DM + h * 128; a.n0 = 68; a.base0 = 0; a.NT = 68; }
                else { const int h = kvh * 4 + (u - 64); a.Q = WSP(bf16_t, WS_QAC) + (size_t)(b * 8 + h) * CTXL * HD;
                    a.O = OALL + (size_t)(NLAT + b * CTXL) * DM + h * 128; a.n0 = 4; a.base0 = SEQ; a.NT = 4; }
            } else {
                const int h = kvh * 2 + (u - 68); a.Q = WSP(bf16_t, WS_QCC) + (size_t)(b * 4 + h) * CTXL * HD;
                a.K = WSP(bf16_t, WS_KC) + (size_t)(b * 2 + kvh) * KVL * HD; a.V = WSP(bf16_t, WS_VC) + (size_t)(b * 2 + kvh) * KVL * HD;
                a.O = OALL + (size_t)(NLAT + b * CTXL) * DM + 1536 + h * 128; a.n0 = 4; a.base0 = SEQ; a.NT = 4;
                a.m_init = inp(F, 15)[l * 4 + h] * (1.0f / att::SCALE); a.l_init = 1.f; }
            att::attn_body<false>(a, lds, F.wave); } }
    if (MIX_EN & 4) for (int dx = 0; dx < 8; ++dx) { const int x = (x0 + dx) & 7, b = x >> 1, kvh = x & 1;
        for (;;) { const int u = mixer_pop(F, l, 2, x); if (u >= 32) break;
            const int h = kvh * 2 + (u >> 4), qb = u & 15;
            const int w0 = qb == 0 ? 0 : qb * 256 - 128, w1 = qb == 15 ? SEQ : qb * 256 + 384;
            att::Args a; a.Q = WSP(bf16_t, WS_QC) + ((size_t)(b * 4 + h) * SEQ + qb * 256) * HD;
            a.K = WSP(bf16_t, WS_KC) + (size_t)(b * 2 + kvh) * KVL * HD; a.V = WSP(bf16_t, WS_VC) + (size_t)(b * 2 + kvh) * KVL * HD;
            a.O = OALL + (size_t)(b * SEQ + qb * 256) * DM + 1536 + h * 128; a.ldo = DM; a.n0 = (w1 - w0) >> 6; a.base0 = w0; a.base1 = SEQ; a.NT = a.n0 + 4; a.qpos0 = qb * 256;
            a.m_init = inp(F, 15)[l * 4 + h] * (1.0f / att::SCALE); a.l_init = 1.f;
            att::attn_body<true>(a, lds, F.wave); } }
}

__device__ __forceinline__ bool ph_in(int lo, int hi, int k) { asm volatile("" : "+s"(lo), "+s"(hi)); return lo <= k && k < hi; }
constexpr int PH_PRE = 0, PH_MODR = 1, PH_L0 = 2, PH_PER_LAYER = 11, PH_FINAL = PH_L0 + 2 * PH_PER_LAYER, N_PHASES = PH_FINAL + 1;
struct Params { const float* in[28]; float* out; unsigned char* ws; int ph_lo, ph_hi; };
__global__ void __launch_bounds__(NTHR, 2) fwd(Params p) {
    extern __shared__ __attribute__((aligned(16))) unsigned char lds[];
    Frame F;
    F.lds = (char*)lds; F.lds3 = (LAS unsigned char*)lds; F.LC = (volatile LAS unsigned*)((LAS unsigned char*)lds + LDSCTL_OFF);
    F.wave = __builtin_amdgcn_readfirstlane((int)threadIdx.x >> 6); F.tid = tid_of(F.wave); F.lane = F.tid & 63; F.G = gridDim.x; F.bid = blockIdx.x;
    F.ws = p.ws; F.ctl = (unsigned*)(p.ws + WS_CTL);
    F.karg = (const float* const __attribute__((address_space(4)))*)__builtin_amdgcn_kernarg_segment_ptr();
    for (int u = F.tid; u < (LDS_BYTES - LDSCTL_OFF) / 4; u += NTHR) F.LC[u] = 0u;
    __syncthreads();
    const int lo = p.ph_lo, hi = p.ph_hi;
    XcdBarrier bar; bar.bar = F.ctl + CW_BAR; bar.x = 0; bar.st = nullptr;
    if (hi - lo > 1) bar = xcd_barrier_post(F.ctl + CW_BAR, F.LC + LC_BAR, F.tid);
#ifndef PH_ENABLE
#define PH_ENABLE 0xFFFF
#endif
#define EN(kind) ((PH_ENABLE >> (kind)) & 1)
#define IN(k) ph_in(lo, hi, (k))
#define PB() do { F.tid = tid_of(F.wave); F.lane = F.tid & 63; asm volatile("" : "+s"(F.ws)); } while (0)
#define SEAM(k) do { if (IN(k) && IN((k) + 1)) xcd_barrier(bar, tid_of(F.wave)); } while (0)
    LAS unsigned char* ring = (LAS unsigned char*)lds;

    if (EN(0) && IN(PH_PRE)) { PB(); p_mod_partial(F); p_rope_tables(F); p_convert_weights(F, 0); } SEAM(PH_PRE);
    if (EN(1) && IN(PH_MODR)) { PB(); p_mod_reduce(F); } SEAM(PH_MODR);
#pragma unroll 1
    for (int l = 0; l < 2; ++l) {
        const int P = PH_L0 + l * PH_PER_LAYER;
        const int mrows = (l == 0) ? NROW : NLAT;
        if (EN(2) && IN(P + 0)) { PB(); if (l > 0) p_convert_weights(F, l); p_norm1(F, l); } SEAM(P + 0);
        if (EN(3) && IN(P + 1)) { PB(); pg8::Gemm g{WSP(bf16_t, WS_H), WSP(bf16_t, WS_WIN), NROW, NPIN, DM}; pg8::StaticOrder S; S.init(NROW, NPIN, F.G, F.bid);
            pg8::EpiInProj E{WSP(bf16_t, WS_P1), WSP(bf16_t, WS_MO), WSP(bf16_t, WS_G), WSP(float, WS_GRAW)};
            pg8::gemm_phase<pg8::EpiInProj, pg8::StaticOrder>(ring, g, S, E, F.wave); } SEAM(P + 1);
        if (EN(4) && IN(P + 2)) { PB(); p_prep(F, l); } SEAM(P + 2);
        if (EN(5) && IN(P + 3)) { PB(); p_mixers(F, l); } SEAM(P + 3);
        if (EN(6) && IN(P + 4)) { PB(); p_omprep(F, l, mrows); } SEAM(P + 4);
        if (EN(7) && IN(P + 5)) { PB(); pg8::Gemm g{WSP(bf16_t, WS_OALL), WSP(bf16_t, WS_WBR), mrows, DM, DM}; pg8::StaticOrder S; S.init(mrows, DM, F.G, F.bid);
            pg8::EpiBranch E{WSP(bf16_t, WS_G), WSP(bf16_t, WS_Y)};
            pg8::gemm_phase<pg8::EpiBranch, pg8::StaticOrder>(ring, g, S, E, F.wave); } SEAM(P + 5);
        if (EN(8) && IN(P + 6)) { PB(); pg8::Gemm g{WSP(bf16_t, WS_Y), WSP(bf16_t, WS_WOUT), mrows, DM, DM}; pg8::StaticOrder S; S.init(mrows, DM, F.G, F.bid);
            pg8::EpiOut E{l == 0 ? inp(F, 0) : WSP(float, WS_XL), l == 0 ? inp(F, 2) : WSP(float, WS_XC), WSP(float, WS_XL), WSP(float, WS_XC), WSP(float, WS_MOD) + (size_t)l * 5 * 12288};
            pg8::gemm_phase<pg8::EpiOut, pg8::StaticOrder>(ring, g, S, E, F.wave); } SEAM(P + 6);
        if (EN(9) && IN(P + 7)) { PB(); p_norm2_route(F, l, mrows); } SEAM(P + 7);
        if (EN(10) && IN(P + 8)) { PB(); p_gather(F, l, mrows); } SEAM(P + 8);
        if (EN(11) && IN(P + 9)) { PB(); const int ntl = moe_tables(F, l);
            pg8::Gemm g{WSP(bf16_t, WS_XS), WSP(bf16_t, WS_WGU), 0, 0, DM}; pg8::MoeOrder S{ntl, 4, F.G, F.bid, (const LAS int*)(F.LC + LC_TILE)};
            pg8::EpiMoe1 E{WSP(bf16_t, WS_MID), (const float*)(F.ws + WS_ROUTE + RT_WSORT)};
            pg8::gemm_phase<pg8::EpiMoe1, pg8::MoeOrder>(ring, g, S, E, F.wave); } SEAM(P + 9);
        if (EN(12) && IN(P + 10)) { PB(); const int ntl = moe_tables(F, l);
            pg8::Gemm g{WSP(bf16_t, WS_MID), WSP(bf16_t, WS_WD), 0, 0, DFF}; pg8::MoeOrder S{ntl, 8, F.G, F.bid, (const LAS int*)(F.LC + LC_TILE)};
            pg8::EpiMoe2 E{WSP(bf16_t, WS_MOEOUT)};
            pg8::gemm_phase<pg8::EpiMoe2, pg8::MoeOrder>(ring, g, S, E, F.wave); } SEAM(P + 10);
    }
    if (EN(13) && IN(PH_FINAL)) { PB(); p_final(F); }
#undef IN
#undef SEAM
}

extern "C" void kernel_launch(void* const* d_in, const int* in_sizes, int n_in, void* d_out, int out_size, void* d_ws, size_t ws_size, hipStream_t stream) {
    static int grid = 0;
    if (grid == 0) {
        if (n_in != 28 || out_size != NLAT * DM || ws_size < WS_END) { fprintf(stderr, "kernel_launch: unexpected shapes (n_in %d, out %d, ws %zu < %zu)\n", n_in, out_size, ws_size, (size_t)WS_END); grid = -1; return; }
        int dev = 0, cus = 0, per_cu = 0;
        if (hipGetDevice(&dev) != hipSuccess || hipDeviceGetAttribute(&cus, hipDeviceAttributeMultiprocessorCount, dev) != hipSuccess) { grid = -1; return; }
        if (hipFuncSetAttribute((const void*)fwd, hipFuncAttributeMaxDynamicSharedMemorySize, LDS_BYTES) != hipSuccess) { fprintf(stderr, "kernel_launch: hipFuncSetAttribute failed\n"); grid = -1; return; }
        if (hipOccupancyMaxActiveBlocksPerMultiprocessor(&per_cu, (const void*)fwd, NTHR, LDS_BYTES) != hipSuccess || per_cu < 1) { fprintf(stderr, "kernel_launch: occupancy query says %d\n", per_cu); (void)hipGetLastError(); grid = -1; return; }
        grid = cus;
    }
    if (grid < 0) return;
    (void)hipMemsetAsync((char*)d_ws + WS_CTL, 0, CTL_ZERO_BYTES, stream);
    Params p{};
    for (int i = 0; i < 28; ++i) p.in[i] = (const float*)d_in[i];
    p.out = (float*)d_out; p.ws = (unsigned char*)d_ws;
#if MK_PER_PHASE
    for (int k = 0; k < N_PHASES; ++k) { p.ph_lo = k; p.ph_hi = k + 1; hipLaunchKernelGGL(fwd, dim3(grid), dim3(NTHR), LDS_BYTES, stream, p); }
#else
    p.ph_lo = 0; p.ph_hi = N_PHASES; hipLaunchKernelGGL(fwd, dim3(grid), dim3(NTHR), LDS_BYTES, stream, p);
#endif
}
```

```cpp
#include <hip/hip_runtime.h>
#include <cstdio>
#include <cstdint>

#ifndef MK_PER_PHASE
#define MK_PER_PHASE 0
#endif

#define GAS __attribute__((address_space(1)))
#define LAS __attribute__((address_space(3)))
typedef unsigned short bf16_t;
typedef short bf16x8 __attribute__((ext_vector_type(8)));
typedef short s16x4 __attribute__((ext_vector_type(4)));
typedef float f32x2 __attribute__((ext_vector_type(2)));
typedef float f32x4 __attribute__((ext_vector_type(4)));
typedef float f32x8 __attribute__((ext_vector_type(8)));
typedef float f32x16 __attribute__((ext_vector_type(16)));
typedef unsigned u32x2 __attribute__((ext_vector_type(2)));
typedef unsigned u32x4 __attribute__((ext_vector_type(4)));

constexpr int DM = 2048, NB = 4, SEQ = 4096, CTXL = 256, HD = 128;
constexpr int NLAT = NB * SEQ, NCTX = NB * CTXL, NROW = NLAT + NCTX;
constexpr int KVL = SEQ + CTXL;
constexpr int PIN = 10768, NPIN = 11008;
constexpr int NEXP = 16, DFF = 512;
constexpr int MOE_TILES_MAX = 152, MOE_ROWS_MAX = MOE_TILES_MAX * 256;
constexpr float EPS = 1e-6f;
constexpr int NWAVES = 8, NTHR = 512;

constexpr size_t MiB = 1u << 20;
constexpr size_t WS_CTL = 0, CTL_ZERO_BYTES = 1 * MiB;
constexpr size_t WS_MOD = 1 * MiB;
constexpr size_t WS_ROPE = 2 * MiB;
constexpr size_t WS_MODP = 4 * MiB;
constexpr size_t WS_ROUTE = 12 * MiB;
constexpr size_t WS_GRAW = 14 * MiB;
constexpr size_t WS_GATE = 16 * MiB;
constexpr size_t WS_WIN = 20 * MiB;
constexpr size_t WS_WBR = 63 * MiB;
constexpr size_t WS_WOUT = 71 * MiB;
constexpr size_t WS_WGU = 79 * MiB;
constexpr size_t WS_WD = 143 * MiB;
constexpr size_t WS_XL = 175 * MiB;
constexpr size_t WS_XC = 303 * MiB;
constexpr size_t WS_H = 311 * MiB;
constexpr size_t WS_MO = 379 * MiB;
constexpr size_t WS_P1 = 396 * MiB;
constexpr size_t WS_G = 532 * MiB;
constexpr size_t WS_OALL = 396 * MiB;
constexpr size_t WS_HM = 464 * MiB;
constexpr size_t WS_XS = 396 * MiB;
constexpr size_t WS_MID = 548 * MiB;
constexpr size_t WS_MOEOUT = 586 * MiB;
constexpr size_t WS_QA = 738 * MiB;
constexpr size_t WS_QAC = 770 * MiB;
constexpr size_t WS_KA = 772 * MiB;
constexpr size_t WS_VA = 781 * MiB;
constexpr size_t WS_QC = 790 * MiB;
constexpr size_t WS_QCC = 806 * MiB;
constexpr size_t WS_KC = 807 * MiB;
constexpr size_t WS_VC = 816 * MiB;
constexpr size_t WS_QM = 825 * MiB;
constexpr size_t WS_KM = 842 * MiB;
constexpr size_t WS_VM = 859 * MiB;
constexpr size_t WS_Y = 738 * MiB;
constexpr size_t WS_H8 = 876 * MiB;
constexpr size_t WS_HS = 16 * MiB + 1280 * 1024;
constexpr size_t WS_WS8 = 16 * MiB + 1408 * 1024;
constexpr size_t WS_CIMG = 876 * MiB;
constexpr size_t WS_NST = 912 * MiB;
constexpr size_t WS_GT = 913 * MiB;
constexpr size_t WS_END = 916 * MiB;

constexpr int CW_BAR = 4096;
constexpr int CW_QCTR = 8192;
constexpr int CW_ECNT = 12288;
constexpr int CW_WMAX = 65536;
constexpr int CW_WMAX2 = 98304;
constexpr int CW_PROG = 16384;
constexpr size_t RT_SLOTE = 0;
constexpr size_t RT_SLOTP = 160 * 1024;
constexpr size_t RT_SLOTW = 320 * 1024;
constexpr size_t RT_SLOTD = 480 * 1024;
constexpr size_t RT_WSORT = 640 * 1024;
constexpr size_t RT_XSS = 800 * 1024;
constexpr size_t RT_HS2 = 960 * 1024;
constexpr size_t RT_WRT = 1280 * 1024;
constexpr size_t RT_WGS = 1040 * 1024;

constexpr int RING_BYTES = 131072;
constexpr int ML_SM = 131072;
constexpr int LDSCTL_OFF = 143360;
constexpr int LDS_BYTES = 147456;
constexpr int LC_BAR = 8;
constexpr int LC_Q = 16;
constexpr int LC_TILE = 64;

__device__ __forceinline__ float bflo(unsigned w) { return __uint_as_float(w << 16); }
__device__ __forceinline__ float bfhi(unsigned w) { return __uint_as_float(w & 0xffff0000u); }
typedef __bf16 bf16x2_t __attribute__((ext_vector_type(2)));
__device__ __forceinline__ unsigned cvt_pk_bf16(float lo, float hi) { const f32x2 v = {lo, hi}; return __builtin_bit_cast(unsigned, __builtin_convertvector(v, bf16x2_t)); }
template <int O> __device__ __forceinline__ float xshfl(float v) {
    if constexpr (O < 32) return __int_as_float(__builtin_amdgcn_ds_swizzle(__float_as_int(v), (O << 10) | 0x1f));
    else { auto rr = __builtin_amdgcn_permlane32_swap(__float_as_uint(v), __float_as_uint(v), false, false); return __uint_as_float(rr[0]) == v ? __uint_as_float(rr[1]) : __uint_as_float(rr[0]); }
}
__device__ __forceinline__ float wave_sum(float v) {
    v += xshfl<1>(v); v += xshfl<2>(v); v += xshfl<4>(v); v += xshfl<8>(v); v += xshfl<16>(v);
    { auto rr = __builtin_amdgcn_permlane32_swap(__float_as_uint(v), __float_as_uint(v), false, false); v = __uint_as_float(rr[0]) + __uint_as_float(rr[1]); }
    return v;
}
__device__ __forceinline__ float wave_max(float v) {
    v = fmaxf(v, xshfl<1>(v)); v = fmaxf(v, xshfl<2>(v)); v = fmaxf(v, xshfl<4>(v)); v = fmaxf(v, xshfl<8>(v)); v = fmaxf(v, xshfl<16>(v));
    { auto rr = __builtin_amdgcn_permlane32_swap(__float_as_uint(v), __float_as_uint(v), false, false); v = fmaxf(__uint_as_float(rr[0]), __uint_as_float(rr[1])); }
    return v;
}
__device__ __forceinline__ float sigmoidf_(float x) { return __builtin_amdgcn_rcpf(1.0f + __expf(-x)); }
__device__ __forceinline__ float siluf_(float x) { return x * sigmoidf_(x); }
__device__ __forceinline__ int opaque_s(int x) { asm volatile("" : "+s"(x)); return x; }
__device__ __forceinline__ int opaque(int x) { asm volatile("" : "+v"(x)); return x; }
__device__ __forceinline__ int tid_of(int wave) { int l; asm volatile("v_mbcnt_lo_u32_b32 %0, -1, 0\n\tv_mbcnt_hi_u32_b32 %0, -1, %0" : "=v"(l)); return wave * 64 + l; }
#define LDS_WAIT() asm volatile("s_waitcnt lgkmcnt(0)" ::: "memory")
#define VM_WAIT() asm volatile("s_waitcnt vmcnt(0)" ::: "memory")

#define XB_TMO      128
#define XB_XCNT(j)  (256  + 64 * (j))
#define XB_XSUB(j)  (1280 + 64 * (j))
#define XB_XGEN(j)  (2304 + 64 * (j))
#define XB_TOP      3328
#define XB_TOPGEN   3392
#define XCD_BAR_WORDS 3456
#define XB_SPIN_CAP (1u << 18)
__device__ __forceinline__ unsigned xb_ld(unsigned* p)              { return __hip_atomic_load(p, __ATOMIC_RELAXED, __HIP_MEMORY_SCOPE_AGENT); }
__device__ __forceinline__ unsigned xb_add(unsigned* p, unsigned v) { return __hip_atomic_fetch_add(p, v, __ATOMIC_RELAXED, __HIP_MEMORY_SCOPE_AGENT); }
__device__ __forceinline__ unsigned xb_xcc_id() { return (unsigned)__builtin_amdgcn_s_getreg((3 << 11) | 20) & 0xFu; }
#define XB_SPIN(cond, bar) do { unsigned _sp = 0; while (cond) { __builtin_amdgcn_s_sleep(1); \
    if ((++_sp & 255u) == 0u) { if (xb_ld(&(bar)[XB_TMO])) break; if (_sp > XB_SPIN_CAP) { atomicAdd(&(bar)[XB_TMO], 1u); break; } } } } while (0)
struct XcdBarrier { unsigned* bar; unsigned x; volatile LAS unsigned* st; };
__device__ __forceinline__ XcdBarrier xcd_barrier_post(unsigned* bar, volatile LAS unsigned* st, int tid) {
    XcdBarrier b; b.bar = bar; b.x = xb_xcc_id(); b.st = st;
    if (tid == 0) (void)xb_add(&bar[XB_XCNT(b.x)], 1u);
    return b;
}
__device__ __forceinline__ void xcd_barrier_complete(unsigned* bar, unsigned x, unsigned& nloc, unsigned& nx) {
    const unsigned G = gridDim.x * gridDim.y * gridDim.z;
    unsigned sum, cnt, mine, sp = 0u;
    for (;;) {
        sum = 0u; cnt = 0u; mine = 0u;
#pragma unroll
        for (unsigned j = 0; j < 16; ++j) { const unsigned c = xb_ld(&bar[XB_XCNT(j)]); sum += c; cnt += (c > 0u) ? 1u : 0u; mine = (j == x) ? c : mine; }
        if (sum == G) break;
        __builtin_amdgcn_s_sleep(1);
        if ((++sp & 255u) == 0u) { if (xb_ld(&bar[XB_TMO])) break; if (sp > XB_SPIN_CAP) { atomicAdd(&bar[XB_TMO], 1u); break; } }
    }
    nloc = mine > 0u ? mine : 1u; nx = cnt > 0u ? cnt : 1u;
}
__device__ __forceinline__ void xcd_barrier(const XcdBarrier& b, int tid) {
    asm volatile("s_waitcnt vmcnt(0)" ::: "memory");
    __syncthreads();
    if (tid == 0) {
        unsigned* bar = b.bar;
        __builtin_amdgcn_s_waitcnt(0);
        unsigned nloc = b.st[0], nx = b.st[1];
        if (nloc == 0u) { xcd_barrier_complete(bar, b.x, nloc, nx); b.st[0] = nloc; b.st[1] = nx; }
        const unsigned old = xb_add(&bar[XB_XSUB(b.x)], 1u);
        const unsigned gen = old / nloc;
        if (old + 1u == (gen + 1u) * nloc) {
            __builtin_amdgcn_fence(__ATOMIC_RELEASE, "agent");
            asm volatile("s_waitcnt vmcnt(0)" ::: "memory");
            const unsigned og = xb_add(&bar[XB_TOP], 1u);
            const unsigned tg = og / nx;
            if (og + 1u == (tg + 1u) * nx) xb_add(&bar[XB_TOPGEN], 1u);
            else XB_SPIN(xb_ld(&bar[XB_TOPGEN]) == tg, bar);
            __builtin_amdgcn_fence(__ATOMIC_ACQUIRE, "agent");
            xb_add(&bar[XB_XGEN(b.x)], 1u);
            asm volatile("s_waitcnt vmcnt(0)" ::: "memory");
        } else {
            XB_SPIN(xb_ld(&bar[XB_XGEN(b.x)]) == gen, bar);
            __builtin_amdgcn_fence(__ATOMIC_ACQUIRE, "agent");
            asm volatile("s_waitcnt vmcnt(0)" ::: "memory");
        }
    }
    __syncthreads();
}
namespace pg8 {
constexpr int BM = 256, BK = 64, HALF = 128, HTB = HALF * BK * 2, STAGE_BYTES = 8 * HTB, NXCD = 8, WGM = 4;
__host__ __device__ __forceinline__ int lds_byte(int r, int c) { const int st = (r >> 4) * 2 + (c >> 5), rr = r & 15, cc = c & 31, ob = rr * 64 + cc * 2; return st * 1024 + (ob ^ (((ob >> 9) & 1) << 5)); }
__host__ __device__ __forceinline__ void stage_rc(int b, int& R, int& C) { const int st = b / 1024, sb = b % 1024, swz = sb ^ (((sb >> 9) & 1) << 5); R = (st >> 1) * 16 + swz / 64; C = (st & 1) * 32 + (swz % 64) / 2; }
__host__ __device__ __forceinline__ int perm32(int rho) { const int n = rho >> 4, i = rho & 15; return 8 * (i >> 2) + 4 * n + (i & 3); }

struct Unit { int pm, pn; int sub = 0; };
struct Gemm { const bf16_t* A; const bf16_t* Bt; int M, N, K; };

struct StaticOrder {
    static constexpr bool HALFM = false, HALFN = false;
    int nM, nN, nwg, G, c, wgm;
    __host__ __device__ void init(int M, int N, int G_, int c_, int wgm_ = WGM) { nM = M / BM; nN = N / BM; nwg = nM * nN; G = G_; c = c_; wgm = wgm_; }
    __host__ __device__ bool next(int i, Unit& u) const {
        const long L = (long)i * G + c; if (L >= nwg) return false;
        int wgid = (int)L; { const int q = nwg / NXCD, r = nwg % NXCD, xcd = wgid % NXCD, off = wgid / NXCD; wgid = (xcd < r ? xcd * (q + 1) : r * (q + 1) + (xcd - r) * q) + off; }
        const int nig = wgm * nN, gid = wgid / nig, fm = gid * wgm, gsz = (nM - fm) < wgm ? (nM - fm) : wgm;
        u.pm = fm + ((wgid % nig) % gsz); u.pn = (wgid % nig) / gsz; return true;
    }
    __device__ __forceinline__ void a_ready(const Unit&) const {}
    __device__ __forceinline__ void done(const Unit&) const {}
};
#ifndef HALF_WGM
#define HALF_WGM 4
#endif
struct HalfOrder {
    static constexpr bool HALFM = true, HALFN = false;
    StaticOrder so; int nhalf, G, c;
    __device__ void init(int nhalf_, int G_, int c_) { nhalf = nhalf_; G = G_; c = c_; so.init(NLAT, DM, G_, c_, HALF_WGM); }
    __device__ __forceinline__ bool next(int i, Unit& u) const {
        if (so.next(i, u)) { u.sub = 0; return true; }
        const long L = (long)i * G + c - so.nwg; if (L < 0 || L >= nhalf) return false;
        const int v = (int)(L >> 3); u.pn = (int)(L & 7); u.pm = 64 + (v >> 1); u.sub = 1 + (v & 1); return true;
    }
    __device__ __forceinline__ void a_ready(const Unit&) const {}
    __device__ __forceinline__ void done(const Unit&) const {}
};
#ifndef GATE_WGM
#define GATE_WGM 4
#endif
struct GateOrder {
    static constexpr bool HALFM = false, HALFN = false;
    StaticOrder so; int skipctx, G, c; int fold = 0;
    __device__ void init(int skip, int G_, int c_) { skipctx = skip; G = G_; c = c_; so.init(skip ? NLAT : NROW, 43 * BM, G_, c_, GATE_WGM); }
    __device__ __forceinline__ int count() const { return so.nwg + (skipctx ? 36 : 0); }
    __device__ __forceinline__ bool next(int i, Unit& u) const {
        if (so.next(i, u)) { if (fold == 1) u.pn %= 24; if (fold == 2) u.pn = 24 + u.pn % 18; return true; }
        if (!skipctx) return false;
        const long L = (long)i * G + c - so.nwg; if (L < 0 || L >= 36) return false;
        const int q = (int)(L % 9); u.pm = 64 + (int)(L / 9); u.pn = 24 + (q < 2 ? 4 + q : (q < 6 ? 6 + q : (q < 8 ? 10 + q : 18))); return true;
    }
    __device__ __forceinline__ void a_ready(const Unit&) const {}
    __device__ __forceinline__ void done(const Unit&) const {}
};
__device__ __forceinline__ int rest_tile(int) { return 42; }
struct RestOrder {
    static constexpr bool HALFM = false, HALFN = true;
    StaticOrder so; int skipctx, off, G;
    __device__ void init(int skip, int G_, int c_, int n1) { skipctx = skip; G = G_; off = ((c_ - n1 % G_) % G_ + G_) % G_; so.init(skip ? NLAT : NROW, 1 * BM, G_, 0); }
    __device__ __forceinline__ bool next(int i, Unit& u) const {
        const long j = (long)i * G + off;
        if (j < so.nwg) { StaticOrder t = so; t.c = (int)(j % G); (void)t.next((int)(j / G), u); u.pn = rest_tile(u.pn); return true; }
        if (!skipctx) return false;
        const long L = j - so.nwg; if (L >= 4) return false;
        u.pm = 64 + (int)L; u.pn = 42; return true;
    }
    __device__ __forceinline__ void a_ready(const Unit&) const {}
    __device__ __forceinline__ void done(const Unit&) const {}
};
struct FakeOrder { static constexpr bool HALFM = false, HALFN = false; RestOrder r;
    __device__ __forceinline__ bool next(int i, Unit& u) const { const bool ok = r.next(i, u); u.pm = 0; u.pn = 0; return ok; }
    __device__ __forceinline__ void a_ready(const Unit&) const {}
    __device__ __forceinline__ void done(const Unit&) const {}
};
struct MoeOrder {
    static constexpr bool HALFM = true, HALFN = false;
    int ntiles, nN, G, c; const LAS int* tile_e;
    __device__ __forceinline__ bool next(int i, Unit& u) const {
        const long nun = (long)ntiles * nN, nfull = (nun / G) * G, tail = nun - nfull; const bool split = tail > 0 && tail * 2 <= G;
        const long L = (long)i * G + c; long un; int sub = 0;
        if (L < nfull || !split) { if (L >= nun) return false; un = L; }
        else { const long Lt = L - nfull; if (Lt >= 2 * tail) return false; un = nfull + (Lt >> 1); sub = 1 + (int)(Lt & 1); }
        const int rt = (int)(un / nN), ct = (int)(un % nN); u.pm = rt; u.pn = tile_e[rt] * nN + ct; u.sub = sub; return true;
    }
    __device__ __forceinline__ void a_ready(const Unit&) const {}
    __device__ __forceinline__ void done(const Unit&) const {}
};

typedef f32x4 Acc[2][2][4][2];
typedef int i32x4 __attribute__((ext_vector_type(4)));

struct EpiInProj {
    static constexpr bool PERM = true, AFTER_DRAIN = false, HAS_MID = false, I8 = false; static constexpr int MID0 = -1, MID1 = -1;
    bf16_t* P1; bf16_t* MO; float* GRAW;
    __device__ __forceinline__ void mid(Acc&, const Unit&, int, int, int, int, int) const {}
    __device__ __forceinline__ void operator()(const Acc& acc, const Unit& u, int wr, int wc, int fr, int fq) const {
        const int row0 = u.pm * BM + wr * 64 + fr, pn = u.pn;
        if (pn == 42) {
            if (wc == 0 && fq < 2) {
#pragma unroll
                for (int ai = 0; ai < 2; ++ai)
#pragma unroll
                    for (int m = 0; m < 4; ++m) { float* rowp = GRAW + (size_t)(row0 + ai * HALF + m * 16) * 16 + 8 * fq;
                        *(f32x4*)(rowp) = acc[ai][0][m][0]; *(f32x4*)(rowp + 4) = acc[ai][0][m][1]; }
            }
            return;
        }
        bf16_t* base; int ldc, colt; bool sig;
        if (pn < 12) { base = P1; ldc = 4096; colt = pn * BM; sig = false; }
        else if (pn < 14) { base = MO; ldc = 512; colt = (pn - 12) * BM; sig = true; }
        else { base = P1; ldc = 4096; colt = 3072 + (pn - 14) * BM; sig = false; }
        const int col0 = colt + wc * 32 + 8 * fq;
#pragma unroll
        for (int ai = 0; ai < 2; ++ai)
#pragma unroll
            for (int m = 0; m < 4; ++m) { bf16_t* rowp = base + (size_t)(row0 + ai * HALF + m * 16) * ldc + col0;
#pragma unroll
                for (int bj = 0; bj < 2; ++bj) { f32x4 v0 = acc[ai][bj][m][0], v1 = acc[ai][bj][m][1];
                    if (sig) {
#pragma unroll
                        for (int j = 0; j < 4; ++j) { v0[j] = fmaxf(sigmoidf_(v0[j]), 1e-6f); v1[j] = fmaxf(sigmoidf_(v1[j]), 1e-6f); } }
                    u32x4 w; w.x = cvt_pk_bf16(v0[0], v0[1]); w.y = cvt_pk_bf16(v0[2], v0[3]); w.z = cvt_pk_bf16(v1[0], v1[1]); w.w = cvt_pk_bf16(v1[2], v1[3]);
                    *(u32x4*)(rowp + bj * HALF) = w; } }
    }
};
__device__ __forceinline__ size_t gate_tile(int pm, int gb, int pn, int wave) { return ((size_t)((pm * 3 + gb) * 8 + pn) << 16) + (size_t)wave * 8192; }
__device__ __forceinline__ unsigned gate_in(int lane, int ai, int m, int bj) { return (unsigned)(lane * 8 + ((ai * 4 + m) * 2 + bj) * 512); }
__device__ __forceinline__ int i8_tile(int idx) { return idx; }
struct EpiGateI8 {
    static constexpr bool PERM = true, AFTER_DRAIN = false, HAS_MID = false, I8 = true; static constexpr int MID0 = -1, MID1 = -1;
    unsigned char* G; const float* HS; const float* WS8; bf16_t* P1; bf16_t* MO; unsigned char* wsb;
    __device__ __forceinline__ void mid(Acc&, const Unit&, int, int, int, int, int) const {}
    __device__ __forceinline__ void gates(const Acc& acc, const float (&hv)[2][4], const Unit& u, int wave, int lane, int col0) const {
        unsigned char* Gt = G + gate_tile(u.pm, u.pn >> 3, u.pn & 7, wave);
#pragma unroll
        for (int bj = 0; bj < 2; ++bj) { f32x4 w0 = *(const f32x4*)(WS8 + col0 + bj * HALF), w1 = *(const f32x4*)(WS8 + col0 + bj * HALF + 4);
#pragma unroll
            for (int j = 0; j < 4; ++j) { w0[j] *= -1.4426950408889634f; w1[j] *= -1.4426950408889634f; }
#pragma unroll
            for (int ai = 0; ai < 2; ++ai)
#pragma unroll
                for (int m = 0; m < 4; ++m) { const float hs = hv[ai][m];
                    const i32x4 i0 = __builtin_bit_cast(i32x4, acc[ai][bj][m][0]), i1 = __builtin_bit_cast(i32x4, acc[ai][bj][m][1]); u32x2 w = {0u, 0u};
#pragma unroll
                    for (int j = 0; j < 4; ++j) { constexpr float c = 1.0f / 255.0f;
                        const float e0 = __builtin_amdgcn_exp2f((float)i0[j] * hs * w0[j]), e1 = __builtin_amdgcn_exp2f((float)i1[j] * hs * w1[j]);
                        const float q0 = fmaxf(__builtin_rintf(__builtin_amdgcn_rcpf(fmaf(e0, c, c))), 1.0f), q1 = fmaxf(__builtin_rintf(__builtin_amdgcn_rcpf(fmaf(e1, c, c))), 1.0f);
                        w.x = __builtin_amdgcn_cvt_pk_u8_f32(q0, j, w.x); w.y = __builtin_amdgcn_cvt_pk_u8_f32(q1, j, w.y); }
                    *(u32x2*)(Gt + gate_in(lane, ai, m, bj)) = w; } }
    }
    template <bool SIG>
    __device__ __forceinline__ void values(const Acc& acc, const float (&hv)[2][4], int row0, int col0, bf16_t* base, int ldc, int c0) const {
#pragma unroll
        for (int bj = 0; bj < 2; ++bj) { const f32x4 w0 = *(const f32x4*)(WS8 + col0 + bj * HALF), w1 = *(const f32x4*)(WS8 + col0 + bj * HALF + 4);
#pragma unroll
            for (int ai = 0; ai < 2; ++ai)
#pragma unroll
                for (int m = 0; m < 4; ++m) { const int row = row0 + ai * HALF + m * 16; const float hs = hv[ai][m];
                    const i32x4 i0 = __builtin_bit_cast(i32x4, acc[ai][bj][m][0]), i1 = __builtin_bit_cast(i32x4, acc[ai][bj][m][1]); f32x4 v0, v1;
#pragma unroll
                    for (int j = 0; j < 4; ++j) { v0[j] = (float)i0[j] * hs * w0[j]; v1[j] = (float)i1[j] * hs * w1[j]; }
                    if (SIG) {
#pragma unroll
                        for (int j = 0; j < 4; ++j) { v0[j] = fmaxf(sigmoidf_(v0[j]), 1e-6f); v1[j] = fmaxf(sigmoidf_(v1[j]), 1e-6f); } }
                    u32x4 w; w.x = cvt_pk_bf16(v0[0], v0[1]); w.y = cvt_pk_bf16(v0[2], v0[3]); w.z = cvt_pk_bf16(v1[0], v1[1]); w.w = cvt_pk_bf16(v1[2], v1[3]);
                    *(u32x4*)(base + (size_t)row * ldc + c0 + bj * HALF) = w; } }
    }
    __device__ __forceinline__ void values_v(const Acc& acc, const float (&hv)[2][4], const Unit& u, int wr, int wc, int fr, int fq, int col0, int t) const {
        const bool lat = u.pm < 64; const int b = lat ? (u.pm >> 4) : (u.pm - 64), pos0 = lat ? (u.pm & 15) * BM : SEQ;
        const int nh = (t == 10 || t == 11) ? 4 : 2, h0 = (t == 11) ? 2 : 0;
        bf16_t* base = (bf16_t*)(wsb + (t == 5 ? WS_VA : (t == 17 ? WS_VC : WS_VM))) + ((size_t)(b * nh + h0) * KVL + pos0 + wr * 64 + fr) * HD + wc * 32 + 8 * fq;
#pragma unroll
        for (int bj = 0; bj < 2; ++bj) { const f32x4 w0 = *(const f32x4*)(WS8 + col0 + bj * HALF), w1 = *(const f32x4*)(WS8 + col0 + bj * HALF + 4);
#pragma unroll
            for (int ai = 0; ai < 2; ++ai)
#pragma unroll
                for (int m = 0; m < 4; ++m) { const float hs = hv[ai][m];
                    const i32x4 i0 = __builtin_bit_cast(i32x4, acc[ai][bj][m][0]), i1 = __builtin_bit_cast(i32x4, acc[ai][bj][m][1]); f32x4 v0, v1;
#pragma unroll
                    for (int j = 0; j < 4; ++j) { v0[j] = (float)i0[j] * hs * w0[j]; v1[j] = (float)i1[j] * hs * w1[j]; }
                    u32x4 w; w.x = cvt_pk_bf16(v0[0], v0[1]); w.y = cvt_pk_bf16(v0[2], v0[3]); w.z = cvt_pk_bf16(v1[0], v1[1]); w.w = cvt_pk_bf16(v1[2], v1[3]);
                    *(u32x4*)(base + (size_t)bj * KVL * HD + (size_t)(ai * HALF + m * 16) * HD) = w; } }
    }
    __device__ __forceinline__ void graw(const Acc& acc, const float (&hv)[2][4], int row0, int col0, int wc, int fq) const {
        if (wc != 0 || fq >= 2) return;
        float* GR = (float*)(wsb + WS_GRAW);
        const f32x4 w0 = *(const f32x4*)(WS8 + col0), w1 = *(const f32x4*)(WS8 + col0 + 4);
#pragma unroll
        for (int ai = 0; ai < 2; ++ai)
#pragma unroll
            for (int m = 0; m < 4; ++m) { const float hs = hv[ai][m]; float* rowp = GR + (size_t)(row0 + ai * HALF + m * 16) * 16 + 8 * fq;
                const i32x4 i0 = __builtin_bit_cast(i32x4, acc[ai][0][m][0]), i1 = __builtin_bit_cast(i32x4, acc[ai][0][m][1]); f32x4 v0, v1;
#pragma unroll
                for (int j = 0; j < 4; ++j) { v0[j] = (float)i0[j] * hs * w0[j]; v1[j] = (float)i1[j] * hs * w1[j]; }
                *(f32x4*)(rowp) = v0; *(f32x4*)(rowp + 4) = v1; }
    }
    __device__ __forceinline__ void operator()(const Acc& acc, const Unit& u, int wr, int wc, int fr, int fq) const {
        const int row0 = u.pm * BM + wr * 64 + fr, col0 = u.pn * BM + wc * 32 + 8 * fq;
        float hv[2][4];
#pragma unroll
        for (int ai = 0; ai < 2; ++ai)
#pragma unroll
            for (int m = 0; m < 4; ++m) hv[ai][m] = HS[row0 + ai * HALF + m * 16];
        if (u.pn < 24) { gates(acc, hv, u, wr * 4 + wc, fq * 16 + fr, col0); return; }
        const int t = i8_tile(u.pn - 24);
        if (t == 18) { graw(acc, hv, row0, col0, wc, fq); return; }
        if (t == 5 || t == 10 || t == 11 || t == 17) { values_v(acc, hv, u, wr, wc, fr, fq, col0, t); return; }
        if (t == 12 || t == 13) values<true>(acc, hv, row0, col0, MO, 512, (t - 12) * BM + wc * 32 + 8 * fq);
        else values<false>(acc, hv, row0, col0, P1, 4096, (t < 14 ? t * BM : 3072 + (t - 14) * BM) + wc * 32 + 8 * fq);
    }
};
struct EpiBranch {
    static constexpr bool PERM = true, AFTER_DRAIN = false, HAS_MID = true, I8 = false; static constexpr int MID0 = 16, MID1 = 24;
    const unsigned char* G; bf16_t* Y;
    __device__ __forceinline__ void mid(Acc& acc, const Unit& u, int t, int wr, int wc, int fr_, int fq_) const {
        const int fr = opaque(fr_), fq = opaque(fq_);
        const int row0 = u.pm * BM + wr * 64 + fr, col0 = u.pn * BM + wc * 32 + 8 * fq;
        const int gn = (t == 16) ? 0 : 1;
        const int lane = fq * 16 + fr; const unsigned char* Ga = G + gate_tile(u.pm, gn, u.pn, wr * 4 + wc) + (u.sub == 2 ? 4096 : 0); const unsigned char* Gb = Ga + ((size_t)8 << 16);
        const int nai = u.sub ? 1 : 2;
        u32x2 ga[2][4][2], gb[2][4][2];
#pragma unroll
        for (int ai = 0; ai < 2; ++ai) if (ai < nai)
#pragma unroll
            for (int m = 0; m < 4; ++m)
#pragma unroll
                for (int bj = 0; bj < 2; ++bj) { ga[ai][m][bj] = *(const u32x2*)(Ga + gate_in(lane, ai, m, bj)); gb[ai][m][bj] = *(const u32x2*)(Gb + gate_in(lane, ai, m, bj)); }
#pragma unroll
        for (int ai = 0; ai < 2; ++ai) if (ai < nai)
#pragma unroll
            for (int m = 0; m < 4; ++m)
#pragma unroll
                for (int bj = 0; bj < 2; ++bj) { const u32x2 a = ga[ai][m][bj], b = gb[ai][m][bj]; f32x4 r0, r1;
#pragma unroll
                    for (int j = 0; j < 4; ++j) { r0[j] = (float)((a.x >> (8 * j)) & 0xffu) * __builtin_amdgcn_rcpf((float)((b.x >> (8 * j)) & 0xffu)); r1[j] = (float)((a.y >> (8 * j)) & 0xffu) * __builtin_amdgcn_rcpf((float)((b.y >> (8 * j)) & 0xffu)); }
                    acc[ai][bj][m][0] *= r0; acc[ai][bj][m][1] *= r1; }
    }
    __device__ __forceinline__ void operator()(const Acc& acc, const Unit& u, int wr, int wc, int fr, int fq) const {
        const int row0 = u.pm * BM + wr * 64 + fr, col0 = u.pn * BM + wc * 32 + 8 * fq;
        const int lane_ = opaque(fq * 16 + fr); const unsigned char* Gc = G + gate_tile(u.pm, 2, u.pn, wr * 4 + wc) + (u.sub == 2 ? 4096 : 0);
        const int nai = u.sub ? 1 : 2; const size_t rsub = u.sub == 2 ? HALF : 0;
        u32x2 gc[2][4][2];
#pragma unroll
        for (int ai = 0; ai < 2; ++ai) if (ai < nai)
#pragma unroll
            for (int m = 0; m < 4; ++m)
#pragma unroll
                for (int bj = 0; bj < 2; ++bj) gc[ai][m][bj] = *(const u32x2*)(Gc + gate_in(lane_, ai, m, bj));
#pragma unroll
        for (int ai = 0; ai < 2; ++ai) if (ai < nai)
#pragma unroll
            for (int m = 0; m < 4; ++m) { const size_t r = (size_t)(row0 + ai * HALF + m * 16) + rsub;
#pragma unroll
                for (int bj = 0; bj < 2; ++bj) { const u32x2 g = gc[ai][m][bj];
                    f32x4 v0 = acc[ai][bj][m][0], v1 = acc[ai][bj][m][1];
#pragma unroll
                    for (int j = 0; j < 4; ++j) { v0[j] *= (float)((g.x >> (8 * j)) & 0xffu) * (1.0f / 255.0f); v1[j] *= (float)((g.y >> (8 * j)) & 0xffu) * (1.0f / 255.0f); }
                    u32x4 w; w.x = cvt_pk_bf16(v0[0], v0[1]); w.y = cvt_pk_bf16(v0[2], v0[3]); w.z = cvt_pk_bf16(v1[0], v1[1]); w.w = cvt_pk_bf16(v1[2], v1[3]);
                    *(u32x4*)(Y + r * 2048 + col0 + bj * HALF) = w; } }
    }
};
struct EpiOut {
    static constexpr bool PERM = true, AFTER_DRAIN = false, HAS_MID = false, I8 = false; static constexpr int MID0 = -1, MID1 = -1;
    const float* const __attribute__((address_space(4)))* karg; const float* modl; int first;
    __device__ __forceinline__ void mid(Acc&, const Unit&, int, int, int, int, int) const {}
    __device__ __forceinline__ void operator()(const Acc& acc, const Unit& u, int wr, int wc, int fr, int fq) const {
        const bool lat = u.pm < 64; const int rbase = lat ? u.pm * BM : (u.pm - 64) * BM;
        auto kp = karg; asm volatile("" : "+s"(kp));
        unsigned char* wsb = (unsigned char*)kp[29]; bf16_t* xres = (bf16_t*)(wsb + (lat ? WS_XL : WS_XC)); bf16_t* out = xres;
        const float* gv = modl + (size_t)(lat ? (u.pm >> 4) : 4) * 12288 + 4096;
        const int row0 = rbase + wr * 64 + fr + (u.sub == 2 ? HALF : 0), col0 = u.pn * BM + wc * 32 + 8 * fq; const int nai = u.sub ? 1 : 2;
        f32x4 g[2][2];
#pragma unroll
        for (int bj = 0; bj < 2; ++bj)
#pragma unroll
            for (int n = 0; n < 2; ++n) g[bj][n] = *(const f32x4*)(gv + col0 + bj * HALF + n * 4);
#pragma unroll
        for (int ai = 0; ai < 2; ++ai) if (ai < nai) {
#pragma unroll
            for (int mh = 0; mh < 2; ++mh) { f32x4 r[2][2][2];
                if (first) { const float* res = lat ? kp[0] : kp[2];
#pragma unroll
                    for (int m = 0; m < 2; ++m) { const size_t off = (size_t)(row0 + ai * HALF + (mh * 2 + m) * 16) * DM + col0;
#pragma unroll
                        for (int bj = 0; bj < 2; ++bj)
#pragma unroll
                            for (int n = 0; n < 2; ++n) r[m][bj][n] = *(const f32x4*)(res + off + bj * HALF + n * 4); } }
                else { const bf16_t* res = xres;
#pragma unroll
                    for (int m = 0; m < 2; ++m) { const size_t off = (size_t)(row0 + ai * HALF + (mh * 2 + m) * 16) * DM + col0;
#pragma unroll
                        for (int bj = 0; bj < 2; ++bj) { const u32x4 w = *(const u32x4*)(res + off + bj * HALF);
                            r[m][bj][0] = (f32x4){bflo(w.x), bfhi(w.x), bflo(w.y), bfhi(w.y)}; r[m][bj][1] = (f32x4){bflo(w.z), bfhi(w.z), bflo(w.w), bfhi(w.w)}; } } }
#pragma unroll
                for (int m = 0; m < 2; ++m) { const size_t off = (size_t)(row0 + ai * HALF + (mh * 2 + m) * 16) * DM + col0;
#pragma unroll
                    for (int bj = 0; bj < 2; ++bj) { const f32x4 v0 = r[m][bj][0] + g[bj][0] * acc[ai][bj][mh * 2 + m][0], v1 = r[m][bj][1] + g[bj][1] * acc[ai][bj][mh * 2 + m][1];
                        u32x4 w; w.x = cvt_pk_bf16(v0[0], v0[1]); w.y = cvt_pk_bf16(v0[2], v0[3]); w.z = cvt_pk_bf16(v1[0], v1[1]); w.w = cvt_pk_bf16(v1[2], v1[3]);
                        *(u32x4*)(out + off + bj * HALF) = w; } }
                asm volatile("" ::: "memory"); } }
    }
};
struct EpiMoe1 {
    static constexpr bool PERM = true, AFTER_DRAIN = false, HAS_MID = false, I8 = false; static constexpr int MID0 = -1, MID1 = -1;
    bf16_t* MID; const float* wsort;
    __device__ __forceinline__ void mid(Acc&, const Unit&, int, int, int, int, int) const {}
    __device__ __forceinline__ void operator()(const Acc& acc, const Unit& u, int wr, int wc, int fr, int fq) const {
        const int row0 = u.pm * BM + wr * 64 + fr, ct = u.pn & 3, col0 = ct * 128 + wc * 16 + 4 * fq;
        float wv[2][4];
#pragma unroll
        for (int ai = 0; ai < 2; ++ai)
#pragma unroll
            for (int m = 0; m < 4; ++m) wv[ai][m] = wsort[row0 + ai * HALF + m * 16];
#pragma unroll
        for (int ai = 0; ai < 2; ++ai)
#pragma unroll
            for (int m = 0; m < 4; ++m) { const size_t r = (size_t)(row0 + ai * HALF + m * 16); const float w = wv[ai][m];
#pragma unroll
                for (int bj = 0; bj < 2; ++bj) { const f32x4 a = acc[ai][bj][m][0], up = acc[ai][bj][m][1];
                    u32x2 o; o.x = cvt_pk_bf16(siluf_(a[0]) * up[0] * w, siluf_(a[1]) * up[1] * w); o.y = cvt_pk_bf16(siluf_(a[2]) * up[2] * w, siluf_(a[3]) * up[3] * w);
                    *(u32x2*)(MID + r * DFF + col0 + bj * 64) = o; } }
    }
};
struct EpiMoe1I8 {
    static constexpr bool PERM = true, AFTER_DRAIN = false, HAS_MID = false, I8 = true; static constexpr int MID0 = -1, MID1 = -1;
    bf16_t* MID; const float* wsort; const float* xss; const float* wgs;
    __device__ __forceinline__ void mid(Acc&, const Unit&, int, int, int, int, int) const {}
    __device__ __forceinline__ void operator()(const Acc& acc, const Unit& u, int wr, int wc, int fr, int fq) const {
        const int row0 = u.pm * BM + wr * 64 + fr + (u.sub == 2 ? HALF : 0), ct = u.pn & 3, col0 = ct * 128 + wc * 16 + 4 * fq, scol0 = u.pn * BM + wc * 32 + 8 * fq; const int nai = u.sub ? 1 : 2;
        float wv[2][4], rs[2][4];
#pragma unroll
        for (int ai = 0; ai < 2; ++ai)
#pragma unroll
            for (int m = 0; m < 4; ++m) { wv[ai][m] = (ai < nai) ? wsort[row0 + ai * HALF + m * 16] : 0.f; rs[ai][m] = (ai < nai) ? xss[row0 + ai * HALF + m * 16] : 0.f; }
#pragma unroll
        for (int bj = 0; bj < 2; ++bj) { const f32x4 cg = *(const f32x4*)(wgs + scol0 + bj * HALF), cu = *(const f32x4*)(wgs + scol0 + bj * HALF + 4);
#pragma unroll
            for (int ai = 0; ai < 2; ++ai) if (ai < nai)
#pragma unroll
                for (int m = 0; m < 4; ++m) { const size_t r = (size_t)(row0 + ai * HALF + m * 16); const float w = wv[ai][m], s = rs[ai][m];
                    const i32x4 ia = __builtin_bit_cast(i32x4, acc[ai][bj][m][0]), iu = __builtin_bit_cast(i32x4, acc[ai][bj][m][1]); float o[4];
#pragma unroll
                    for (int j = 0; j < 4; ++j) { const float a = (float)ia[j] * s * cg[j], up = (float)iu[j] * s * cu[j]; o[j] = siluf_(a) * up * w; }
                    u32x2 ov; ov.x = cvt_pk_bf16(o[0], o[1]); ov.y = cvt_pk_bf16(o[2], o[3]);
                    *(u32x2*)(MID + r * DFF + col0 + bj * 64) = ov; } }
    }
};
struct EpiMoe2 {
    static constexpr bool PERM = true, AFTER_DRAIN = false, HAS_MID = false, I8 = false; static constexpr int MID0 = -1, MID1 = -1;
    bf16_t* O;
    __device__ __forceinline__ void mid(Acc&, const Unit&, int, int, int, int, int) const {}
    __device__ __forceinline__ void operator()(const Acc& acc, const Unit& u, int wr, int wc, int fr, int fq) const {
        const int row0 = u.pm * BM + wr * 64 + fr + (u.sub == 2 ? HALF : 0), col0 = (u.pn & 7) * BM + wc * 32 + 8 * fq; const int nai = u.sub ? 1 : 2;
#pragma unroll
        for (int ai = 0; ai < 2; ++ai) if (ai < nai)
#pragma unroll
            for (int m = 0; m < 4; ++m) { bf16_t* rowp = O + (size_t)(row0 + ai * HALF + m * 16) * DM + col0;
#pragma unroll
                for (int bj = 0; bj < 2; ++bj) { const f32x4 v0 = acc[ai][bj][m][0], v1 = acc[ai][bj][m][1];
                    u32x4 w; w.x = cvt_pk_bf16(v0[0], v0[1]); w.y = cvt_pk_bf16(v0[2], v0[3]); w.z = cvt_pk_bf16(v1[0], v1[1]); w.w = cvt_pk_bf16(v1[2], v1[3]);
                    __builtin_nontemporal_store(w, (u32x4*)(rowp + bj * HALF)); } }
    }
};

template <class Epi, class Sched>
__device__ __forceinline__ void gemm_phase(LAS unsigned char* lds, const Gemm g, const Sched& S, const Epi& E, int wave) {
    const int tid = tid_of(wave), wid = wave, lane = tid & 63, wr = wid >> 2, wc = wid & 3, fr = lane & 15, fq = lane >> 4;
    const int K = g.K, nt = K / BK;
    unsigned voffA[2], voffB[2];
#pragma unroll
    for (int i = 0; i < 2; ++i) { int R, C; stage_rc(tid * 16 + i * 8192, R, C); const int Rb = Epi::PERM ? ((R & ~31) + perm32(R & 31)) : R;
        voffA[i] = (unsigned)(R * K + C) * 2u; voffB[i] = (unsigned)(Rb * K + C) * 2u; }
    const size_t kstep = (size_t)(BK * 2);
    const size_t hstep = (size_t)HALF * K * 2;
    const size_t tstep = 2 * hstep;
    const unsigned ldsw = (unsigned)wid * 1024u;
    const int aoff = lds_byte(wr * 64 + fr, fq * 8), boff = lds_byte(wc * 32 + fr, fq * 8);
#define PG8_SA(b, h) (((b) * 2 + (h)) * HTB)
#define PG8_SB(b, h) ((4 + (b) * 2 + (h)) * HTB)
#define PG8_STAGE(bufoff, gbase, voff) do { _Pragma("unroll") for (int _i = 0; _i < 2; ++_i) \
        __builtin_amdgcn_global_load_lds((const unsigned*)((const char*)(gbase) + (voff)[_i]), (LAS unsigned*)(lds + (bufoff) + ldsw + _i * 8192), 16, 0, 0); } while (0)
#define PG8_LDA(dst, b, h) do { _Pragma("unroll") for (int m = 0; m < 4; ++m) _Pragma("unroll") for (int k = 0; k < 2; ++k) dst[m][k] = *(const LAS bf16x8*)(lds + PG8_SA(b, h) + aoff + m * 2048 + k * 1024); } while (0)
#define PG8_LDB(dst, b, h) do { _Pragma("unroll") for (int n = 0; n < 2; ++n) _Pragma("unroll") for (int k = 0; k < 2; ++k) dst[n][k] = *(const LAS bf16x8*)(lds + PG8_SB(b, h) + boff + n * 2048 + k * 1024); } while (0)
#define PG8_MMA(ai, bj, At, Bt) do { __builtin_amdgcn_s_setprio(1); _Pragma("unroll") for (int m = 0; m < 4; ++m) _Pragma("unroll") for (int n = 0; n < 2; ++n) _Pragma("unroll") for (int k = 0; k < 2; ++k) { \
        if (Epi::I8) acc[ai][bj][m][n] = __builtin_bit_cast(f32x4, __builtin_amdgcn_mfma_i32_16x16x64_i8(__builtin_bit_cast(i32x4, Bt[n][k]), __builtin_bit_cast(i32x4, At[m][k]), __builtin_bit_cast(i32x4, acc[ai][bj][m][n]), 0, 0, 0)); \
        else acc[ai][bj][m][n] = __builtin_amdgcn_mfma_f32_16x16x32_bf16(Bt[n][k], At[m][k], acc[ai][bj][m][n], 0, 0, 0); } __builtin_amdgcn_s_setprio(0); } while (0)
#define PG8_WAIT_V(n) asm volatile("s_waitcnt vmcnt(" #n ")" ::: "memory")
#define PG8_WAIT_L(n) asm volatile("s_waitcnt lgkmcnt(" #n ")" ::: "memory")
#define PG8_BAR __builtin_amdgcn_s_barrier()
#define PG8_SCHED __builtin_amdgcn_sched_barrier(0)
    Unit cur, nxt; int ui = 0;
    if (!S.next(0, cur)) return;
    f32x4 acc[2][2][4][2];
#pragma unroll
    for (int a = 0; a < 2; ++a)
#pragma unroll
        for (int b = 0; b < 2; ++b)
#pragma unroll
            for (int m = 0; m < 4; ++m)
#pragma unroll
                for (int n = 0; n < 2; ++n) acc[a][b][m][n] = (f32x4){0.f, 0.f, 0.f, 0.f};
    bf16x8 At[4][2], B0[2][2], B1[2][2];
    const char* cA = (const char*)g.A + (size_t)cur.pm * tstep + ((Sched::HALFM && cur.sub == 2) ? hstep : 0); const char* cB = (const char*)g.Bt + (size_t)cur.pn * tstep;
    S.a_ready(cur);
    PG8_STAGE(PG8_SB(0, 0), cB, voffB); PG8_STAGE(PG8_SB(0, 1), cB + hstep, voffB); PG8_STAGE(PG8_SA(0, 0), cA, voffA); PG8_STAGE(PG8_SA(0, 1), cA + hstep, voffA);
    if (wr == 1) PG8_BAR;
    PG8_WAIT_V(2); PG8_BAR;
    PG8_STAGE(PG8_SB(1, 0), cB + kstep, voffB); PG8_STAGE(PG8_SA(1, 0), cA + kstep, voffA); PG8_STAGE(PG8_SB(1, 1), cB + hstep + kstep, voffB);
    PG8_WAIT_V(6); PG8_BAR;
    for (;;) {
        const bool has_next = S.next(ui + 1, nxt);
        const char* nA = has_next ? (const char*)g.A + (size_t)nxt.pm * tstep + ((Sched::HALFM && nxt.sub == 2) ? hstep : 0) : cA;
        const char* nB = has_next ? (const char*)g.Bt + (size_t)nxt.pn * tstep : cB;
        const bool whole = !Sched::HALFM || cur.sub == 0;
        for (int t = 0; t < nt; t += 2) {
            const bool last = (t == nt - 2);
            const char* a1 = cA + (size_t)(t + 1) * kstep;
            const char* a2 = last ? nA : cA + (size_t)(t + 2) * kstep; const char* b2 = last ? nB : cB + (size_t)(t + 2) * kstep;
            const char* a3 = a2 + kstep; const char* b3 = b2 + kstep;
            if (last && has_next) S.a_ready(nxt);
            if constexpr (Epi::HAS_MID) { if (t == Epi::MID0 || t == Epi::MID1) { E.mid(acc, cur, t, wr, wc, fr, fq); PG8_SCHED; } }
            PG8_LDB(B0, 0, 0); PG8_LDB(B1, 0, 1); PG8_SCHED; PG8_LDA(At, 0, 0); PG8_STAGE(PG8_SA(1, 1), a1 + hstep, voffA);
            PG8_WAIT_V(8); PG8_WAIT_L(0); PG8_BAR; PG8_MMA(0, 0, At, B0); if constexpr (!Sched::HALFN) PG8_MMA(0, 1, At, B1); PG8_BAR; PG8_SCHED;
            PG8_LDA(At, 0, 1); PG8_STAGE(PG8_SB(0, 0), b2, voffB); PG8_STAGE(PG8_SB(0, 1), b2 + hstep, voffB); PG8_STAGE(PG8_SA(0, 0), a2, voffA);
            PG8_WAIT_V(8); PG8_WAIT_L(0); PG8_BAR; if (whole) { PG8_MMA(1, 0, At, B0); if constexpr (!Sched::HALFN) PG8_MMA(1, 1, At, B1); } PG8_BAR; PG8_SCHED;
            PG8_LDB(B0, 1, 0); PG8_LDB(B1, 1, 1); PG8_SCHED; PG8_LDA(At, 1, 0); PG8_STAGE(PG8_SA(0, 1), a2 + hstep, voffA);
            PG8_WAIT_V(8); PG8_WAIT_L(0); PG8_BAR; PG8_MMA(0, 0, At, B0); if constexpr (!Sched::HALFN) PG8_MMA(0, 1, At, B1); PG8_BAR; PG8_SCHED;
            PG8_LDA(At, 1, 1); PG8_STAGE(PG8_SB(1, 0), b3, voffB); PG8_STAGE(PG8_SB(1, 1), b3 + hstep, voffB); PG8_STAGE(PG8_SA(1, 0), a3, voffA);
            PG8_WAIT_V(8); PG8_WAIT_L(0); PG8_BAR; if (whole) { PG8_MMA(1, 0, At, B0); if constexpr (!Sched::HALFN) PG8_MMA(1, 1, At, B1); } PG8_BAR; PG8_SCHED;
        }
        if (wr == 0) PG8_BAR;
        E(acc, cur, wr, wc, fr, fq); S.done(cur);
        if (!has_next) break;
#pragma unroll
        for (int a = 0; a < 2; ++a)
#pragma unroll
            for (int b = 0; b < 2; ++b)
#pragma unroll
                for (int m = 0; m < 4; ++m)
#pragma unroll
                    for (int n = 0; n < 2; ++n) acc[a][b][m][n] = (f32x4){0.f, 0.f, 0.f, 0.f};
        cur = nxt; cA = nA; cB = nB; ++ui;
        if (wr == 1) PG8_BAR;
    }
    PG8_WAIT_V(0);
    PG8_BAR;
#undef PG8_SA
#undef PG8_SB
#undef PG8_STAGE
#undef PG8_LDA
#undef PG8_LDB
#undef PG8_MMA
#undef PG8_WAIT_V
#undef PG8_WAIT_L
#undef PG8_BAR
#undef PG8_SCHED
}
}
#ifndef ATT_PREK
#define ATT_PREK 1
#endif
#ifndef ATT_PIPE
#define ATT_PIPE 0
#endif
#ifndef ATT_LSUM
#define ATT_LSUM 0
#endif
namespace att {
constexpr int D = 128, QBLK = 32, KVBLK = 64;
constexpr float SCALE = 0.088388347648318440f;
constexpr float THR = 8.f;
constexpr size_t SHM_V = KVBLK * D * 2, SHM_K = KVBLK * D * 2;
#define KSWZ(row, colB) ((row) * 256 + ((colB) ^ (((row) & 7) << 4)))
#define SBAR() __builtin_amdgcn_sched_barrier(0)
__device__ __forceinline__ int crow(int r, int hi) { return (r & 3) + 8 * (r >> 2) + 4 * hi; }

template <bool MASK, bool FIX, bool INPV = false>
__device__ __forceinline__ void partialSM(f32x16& p0, f32x16& p1, float& m_reg, float& mn, float& alpha, int dq, int hi) {
  constexpr float C = SCALE * 1.4426950408889634f;
  if (FIX) {
    mn = m_reg; alpha = 1.f;
    if (INPV) return;
#pragma unroll
    for (int r = 0; r < 16; ++r) p0[r] = __builtin_amdgcn_exp2f(p0[r]);
    return;
  }
  if (MASK) { if (dq < 100000) { const int dl = dq - 4 * hi - 128, dh = dq - 4 * hi + 128;
#pragma unroll
      for (int r = 0; r < 16; ++r) { const int k0 = (r & 3) + 8 * (r >> 2), k1 = k0 + 32;
        p0[r] = (k0 >= dl && k0 <= dh) ? p0[r] : -1e30f; p1[r] = (k1 >= dl && k1 <= dh) ? p1[r] : -1e30f; } } }
  float pmax = p0[0];
#pragma unroll
  for (int r = 1; r < 16; ++r) pmax = fmaxf(pmax, p0[r]);
#pragma unroll
  for (int r = 0; r < 16; ++r) pmax = fmaxf(pmax, p1[r]);
  { auto rr = __builtin_amdgcn_permlane32_swap(__float_as_uint(pmax), __float_as_uint(pmax), false, false);
    pmax = fmaxf(__uint_as_float(rr[0]), __uint_as_float(rr[1])); }
  if (__builtin_expect(__all(pmax - m_reg <= THR / SCALE), 1)) { mn = m_reg; alpha = 1.f; }
  else { mn = fmaxf(m_reg, pmax); alpha = __builtin_amdgcn_exp2f((m_reg - mn) * C); m_reg = mn; }
  float mnC = -mn * C;
#pragma unroll
  for (int r = 0; r < 16; ++r) p0[r] = fmaf(p0[r], C, mnC);
#pragma unroll
  for (int r = 0; r < 16; ++r) p1[r] = fmaf(p1[r], C, mnC);
#pragma unroll
  for (int r = 0; r < 16; ++r) p0[r] = __builtin_amdgcn_exp2f(p0[r]);
}
#define PK4(P, BASE, OUT) do { unsigned a0 = cvt_pk_bf16(P[BASE + 0], P[BASE + 1]), a1 = cvt_pk_bf16(P[BASE + 2], P[BASE + 3]);   \
    unsigned b0 = cvt_pk_bf16(P[BASE + 4], P[BASE + 5]), b1 = cvt_pk_bf16(P[BASE + 6], P[BASE + 7]);                              \
    auto r0 = __builtin_amdgcn_permlane32_swap(a0, b0, false, false); auto r1 = __builtin_amdgcn_permlane32_swap(a1, b1, false, false); \
    u32x4 w = {r0[0], r1[0], r0[1], r1[1]}; OUT = *reinterpret_cast<bf16x8*>(&w); } while (0)
template <bool FIX>
__device__ __forceinline__ void finishSM(f32x16& p0, f32x16& p1, float alpha, float& l_reg, bf16x8& pa0, bf16x8& pa1, bf16x8& pa2, bf16x8& pa3) {
#pragma unroll
  for (int r = 0; r < 16; ++r) p1[r] = __builtin_amdgcn_exp2f(p1[r]);
#if ATT_LSUM
  if (FIX) { PK4(p0, 0, pa0); PK4(p0, 8, pa1); PK4(p1, 0, pa2); PK4(p1, 8, pa3); return; }
#endif
  float ps = 0;
#pragma unroll
  for (int r = 0; r < 16; ++r) ps += p0[r];
#pragma unroll
  for (int r = 0; r < 16; ++r) ps += p1[r];
  { auto rr = __builtin_amdgcn_permlane32_swap(__float_as_uint(ps), __float_as_uint(ps), false, false);
    ps = __uint_as_float(rr[0]) + __uint_as_float(rr[1]); }
  l_reg = l_reg * alpha + ps;
  PK4(p0, 0, pa0); PK4(p0, 8, pa1); PK4(p1, 0, pa2); PK4(p1, 8, pa3);
}
__device__ __forceinline__ void qkt(f32x16& p0, f32x16& p1, const LAS char* Ks, const bf16x8* qr, int r32, int hi, float init = 0.f) {
#pragma unroll
  for (int r = 0; r < 16; ++r) { p0[r] = init; p1[r] = init; }
#pragma unroll
  for (int d0 = 0; d0 < 8; ++d0) { int cb = (d0 * 16 + hi * 8) * 2;
    bf16x8 b0 = *reinterpret_cast<const LAS bf16x8*>(Ks + KSWZ(r32, cb));
    bf16x8 b1 = *reinterpret_cast<const LAS bf16x8*>(Ks + KSWZ(32 + r32, cb));
    p0 = __builtin_amdgcn_mfma_f32_32x32x16_bf16(b0, qr[d0], p0, 0, 0, 0);
    p1 = __builtin_amdgcn_mfma_f32_32x32x16_bf16(b1, qr[d0], p1, 0, 0, 0); }
}
__device__ __forceinline__ void qkt_pf(f32x16& p0, f32x16& p1, const LAS char* Ks, const bf16x8* qr, int r32, int hi, float init = 0.f) {
#pragma unroll
  for (int r = 0; r < 16; ++r) { p0[r] = init; p1[r] = init; }
  bf16x8 b0 = *reinterpret_cast<const LAS bf16x8*>(Ks + KSWZ(r32, (hi * 8) * 2)), b1 = *reinterpret_cast<const LAS bf16x8*>(Ks + KSWZ(32 + r32, (hi * 8) * 2));
#pragma unroll
  for (int d0 = 0; d0 < 8; ++d0) { const int cb = (((d0 + 1) & 7) * 16 + hi * 8) * 2;
    const bf16x8 n0 = *reinterpret_cast<const LAS bf16x8*>(Ks + KSWZ(r32, cb)), n1 = *reinterpret_cast<const LAS bf16x8*>(Ks + KSWZ(32 + r32, cb));
    p0 = __builtin_amdgcn_mfma_f32_32x32x16_bf16(b0, qr[d0], p0, 0, 0, 0);
    p1 = __builtin_amdgcn_mfma_f32_32x32x16_bf16(b1, qr[d0], p1, 0, 0, 0);
    b0 = n0; b1 = n1; }
}
__device__ __forceinline__ int v_st(int k, int c) { const int kk = (k & ~0xC) | ((k & 4) << 1) | ((k & 8) >> 1); return ((kk >> 3) * 4 + (c >> 5)) * 512 + ((kk & 7) * 32 + (c & 31)) * 2; }
__device__ __forceinline__ int v_rd_base(int lane) { return ((lane & 3) << 3) | (((lane >> 2) & 3) << 6) | (((lane >> 4) & 1) << 5) | (((lane >> 5) & 1) << 8); }
constexpr int v_rd_off(int d0, int ks, int half) { return d0 * 512 + ks * 4096 + half * 2048; }
template <int OFF> __device__ __forceinline__ s16x4 tr_read(int vb) {
  s16x4 r; asm volatile("ds_read_b64_tr_b16 %0, %1 offset:%2" : "=&v"(r) : "v"(vb), "i"(OFF) : "memory"); return r;
}
#define PKV(L, H) (bf16x8){L[0], L[1], L[2], L[3], H[0], H[1], H[2], H[3]}
template <int D0, bool EX> __device__ __forceinline__ void pv_one(f32x16& od, int vb, bf16x8 pa0, bf16x8 pa1, bf16x8 pa2, bf16x8 pa3, f32x16& px) {
  const s16x4 l0 = tr_read<v_rd_off(D0, 0, 0)>(vb), h0 = tr_read<v_rd_off(D0, 0, 1)>(vb), l1 = tr_read<v_rd_off(D0, 1, 0)>(vb), h1 = tr_read<v_rd_off(D0, 1, 1)>(vb);
  const s16x4 l2 = tr_read<v_rd_off(D0, 2, 0)>(vb), h2 = tr_read<v_rd_off(D0, 2, 1)>(vb), l3 = tr_read<v_rd_off(D0, 3, 0)>(vb), h3 = tr_read<v_rd_off(D0, 3, 1)>(vb);
  asm volatile("s_waitcnt lgkmcnt(0)" ::: "memory"); SBAR();
  od = __builtin_amdgcn_mfma_f32_32x32x16_bf16(pa0, PKV(l0, h0), od, 0, 0, 0);
  if (EX) px[4 * D0 + 0] = __builtin_amdgcn_exp2f(px[4 * D0 + 0]);
  od = __builtin_amdgcn_mfma_f32_32x32x16_bf16(pa1, PKV(l1, h1), od, 0, 0, 0);
  if (EX) px[4 * D0 + 1] = __builtin_amdgcn_exp2f(px[4 * D0 + 1]);
  od = __builtin_amdgcn_mfma_f32_32x32x16_bf16(pa2, PKV(l2, h2), od, 0, 0, 0);
  if (EX) px[4 * D0 + 2] = __builtin_amdgcn_exp2f(px[4 * D0 + 2]);
  od = __builtin_amdgcn_mfma_f32_32x32x16_bf16(pa3, PKV(l3, h3), od, 0, 0, 0);
  if (EX) px[4 * D0 + 3] = __builtin_amdgcn_exp2f(px[4 * D0 + 3]);
}
template <int D0> __device__ __forceinline__ void pv_one(f32x16& od, int vb, bf16x8 pa0, bf16x8 pa1, bf16x8 pa2, bf16x8 pa3) { f32x16 dummy; pv_one<D0, false>(od, vb, pa0, pa1, pa2, pa3, dummy); }
template <bool EX> __device__ __forceinline__ void pv_d0(f32x16* o, int vb, bf16x8 pa0, bf16x8 pa1, bf16x8 pa2, bf16x8 pa3, f32x16& px) {
  pv_one<0, EX>(o[0], vb, pa0, pa1, pa2, pa3, px); pv_one<1, EX>(o[1], vb, pa0, pa1, pa2, pa3, px); pv_one<2, EX>(o[2], vb, pa0, pa1, pa2, pa3, px); pv_one<3, EX>(o[3], vb, pa0, pa1, pa2, pa3, px);
}

struct Args { const bf16_t* Q; const bf16_t* K; const bf16_t* V; bf16_t* O; int ldo, n0, base0, base1, NT, qpos0; float m_init, l_init; };
template <bool MASK, bool FIX>
__device__ __forceinline__ void attn_body(const Args a, LAS char* lds, int wave) {
  const int tid = tid_of(wave), wid = wave, lane = tid & 63, r32 = lane & 31, hi = lane >> 5;
  LAS char* V_lds = lds; LAS char* K_lds = lds + 2 * SHM_V;
  LAS float* ws = (LAS float*)(lds + 2 * SHM_V + 2 * SHM_K) + wid * 64; LAS float* li_l = ws; LAS float* al_l = ws + 32;
  float m_reg = a.m_init, l_reg = a.l_init; f32x16 o[4] = {}; bf16x8 qr[8];
  const bf16_t* Qw = a.Q + (long)(wid * QBLK + r32) * D + hi * 8;
#pragma unroll
  for (int d0 = 0; d0 < 8; ++d0) qr[d0] = *reinterpret_cast<const bf16x8*>(Qw + d0 * 16);
  int tidv = tid; int sr = tidv >> 4, sc = (tidv & 15) * 8, vst0 = v_st(sr, sc), vst1 = v_st(32 + sr, sc), slo = sr * D + sc;
  int vb0 = (int)(unsigned)(uintptr_t)V_lds + v_rd_base(lane);
#define LANE_CONSTS() do { asm volatile("" : "+v"(tidv)); sr = tidv >> 4; sc = (tidv & 15) * 8; vst0 = v_st(sr, sc); vst1 = v_st(32 + sr, sc); slo = sr * D + sc; vb0 = (int)(unsigned)(uintptr_t)V_lds + v_rd_base(tidv & 63); } while (0)
  const int qpos = a.qpos0 + wid * QBLK + r32;
  struct { bf16x8 vs0, vs1, ks0, ks1; } sr_[2];
#define KROW(j) (((j) < a.n0) ? (a.base0 + 64 * (j)) : (a.base1 + 64 * ((j) - a.n0)))
#define DQ(j) (((j) < a.n0) ? (qpos - (a.base0 + 64 * (j))) : 1000000)
#define SLOAD(i, j) do { const long k0_ = KROW(j); const bf16_t* vt_ = a.V + k0_ * D; const bf16_t* kt_ = a.K + k0_ * D;     \
    sr_[i].vs0 = *reinterpret_cast<const bf16x8*>(vt_ + slo); sr_[i].vs1 = *reinterpret_cast<const bf16x8*>(vt_ + slo + 32 * D); \
    sr_[i].ks0 = *reinterpret_cast<const bf16x8*>(kt_ + slo); sr_[i].ks1 = *reinterpret_cast<const bf16x8*>(kt_ + slo + 32 * D); } while (0)
#define SWRITE(b, i) do { *(LAS bf16x8*)(V_lds + (b) * SHM_V + vst0) = sr_[i].vs0;          \
    *(LAS bf16x8*)(V_lds + (b) * SHM_V + vst1) = sr_[i].vs1; int kc = sc * 2;               \
    *(LAS bf16x8*)(K_lds + (b) * SHM_K + KSWZ(sr, kc)) = sr_[i].ks0;                       \
    *(LAS bf16x8*)(K_lds + (b) * SHM_K + KSWZ(32 + sr, kc)) = sr_[i].ks1; } while (0)
#define SWAIT() asm volatile("s_waitcnt vmcnt(4)" ::: "memory")
#define RESC(al) do { if (!FIX && __any((al) < 1.f)) { if (hi == 0) al_l[r32] = (al); asm volatile("s_waitcnt lgkmcnt(0)" ::: "memory"); \
    _Pragma("unroll") for (int d = 0; d < 4; ++d) _Pragma("unroll") for (int r = 0; r < 16; ++r) o[d][r] *= al_l[crow(r, hi)]; } } while (0)
  f32x16 pA0, pA1, pB0, pB1; float mnA, mnB, alA, alB; bf16x8 pa0, pa1, pa2, pa3; const int NT = a.NT;
  const float qinit = FIX ? -a.m_init : 0.f;
  f32x16 lsum = {}; const bf16x8 ones = (bf16x8){(short)0x3F80, (short)0x3F80, (short)0x3F80, (short)0x3F80, (short)0x3F80, (short)0x3F80, (short)0x3F80, (short)0x3F80};
#define LSUM() do { if (ATT_LSUM && FIX) { lsum = __builtin_amdgcn_mfma_f32_32x32x16_bf16(pa0, ones, lsum, 0, 0, 0); lsum = __builtin_amdgcn_mfma_f32_32x32x16_bf16(pa1, ones, lsum, 0, 0, 0); \
    lsum = __builtin_amdgcn_mfma_f32_32x32x16_bf16(pa2, ones, lsum, 0, 0, 0); lsum = __builtin_amdgcn_mfma_f32_32x32x16_bf16(pa3, ones, lsum, 0, 0, 0); } } while (0)
  constexpr int SE = 0, SO = 1;
#define R1_PIPE() do { if (FIX && ATT_PIPE) { if (ATT_PREK) __builtin_amdgcn_sched_group_barrier(0x100, 2, 0);                        \
    _Pragma("unroll") for (int s_ = 0; s_ < 8; ++s_) { __builtin_amdgcn_sched_group_barrier(0x100, 2, 0);               \
      __builtin_amdgcn_sched_group_barrier(0x008, 1, 0); __builtin_amdgcn_sched_group_barrier(0x402, ATT_PIPE, 0);      \
      __builtin_amdgcn_sched_group_barrier(0x008, 1, 0); __builtin_amdgcn_sched_group_barrier(0x402, ATT_PIPE, 0); } } } while (0)
  SLOAD(SE, 0); asm volatile("s_waitcnt vmcnt(0)" ::: "memory"); SWRITE(0, SE); __syncthreads();
  qkt(pA0, pA1, K_lds, qr, r32, hi, qinit); partialSM<MASK, FIX>(pA0, pA1, m_reg, mnA, alA, DQ(0), hi);
  SLOAD(SO, 1); if (2 < NT) SLOAD(SE, 2);
  SWAIT(); SWRITE(1, SO); __syncthreads();
  for (int j = 1; j + 1 < NT; j += 2) {
    LANE_CONSTS();
    SBAR(); qkt(pB0, pB1, K_lds + SHM_K, qr, r32, hi, qinit);
    finishSM<FIX>(pA0, pA1, alA, l_reg, pa0, pa1, pa2, pa3); R1_PIPE(); SBAR();
    SLOAD(SO, j + 2); SBAR();
    pv_d0<FIX>(o, vb0, pa0, pa1, pa2, pa3, pB0); LSUM(); partialSM<MASK, FIX, true>(pB0, pB1, m_reg, mnB, alB, DQ(j), hi);
    __syncthreads(); SWAIT(); SWRITE(0, SE);
    RESC(alB); __syncthreads();
    SBAR(); qkt(pA0, pA1, K_lds, qr, r32, hi, qinit);
    finishSM<FIX>(pB0, pB1, alB, l_reg, pa0, pa1, pa2, pa3); R1_PIPE(); SBAR();
    if (j + 3 < NT) SLOAD(SE, j + 3); SBAR();
    pv_d0<FIX>(o, vb0 + (int)SHM_V, pa0, pa1, pa2, pa3, pA0); LSUM(); partialSM<MASK, FIX, true>(pA0, pA1, m_reg, mnA, alA, DQ(j + 1), hi);
    __syncthreads(); SWAIT(); SWRITE(1, SO);
    RESC(alA); __syncthreads();
  }
  SBAR(); qkt(pB0, pB1, K_lds + SHM_K, qr, r32, hi, qinit);
  finishSM<FIX>(pA0, pA1, alA, l_reg, pa0, pa1, pa2, pa3); SBAR();
  pv_d0<FIX>(o, vb0, pa0, pa1, pa2, pa3, pB0); LSUM(); partialSM<MASK, FIX, true>(pB0, pB1, m_reg, mnB, alB, DQ(NT - 1), hi);
  __syncthreads(); RESC(alB);
  finishSM<FIX>(pB0, pB1, alB, l_reg, pa0, pa1, pa2, pa3); SBAR();
  pv_d0<false>(o, vb0 + (int)SHM_V, pa0, pa1, pa2, pa3, pB0); LSUM();
  if (hi == 0) li_l[r32] = l_reg; asm volatile("s_waitcnt lgkmcnt(0)" ::: "memory");
  float rli[16];
#pragma unroll
  for (int r = 0; r < 16; ++r) rli[r] = __builtin_amdgcn_rcpf((ATT_LSUM && FIX) ? lsum[r] : li_l[crow(r, hi)]);
  bf16_t* Ow = a.O + (long)(wid * QBLK) * a.ldo;
#pragma unroll
  for (int r = 0; r < 16; ++r) { int orow = crow(r, hi);
#pragma unroll
    for (int d0 = 0; d0 < 4; ++d0) { const float v = o[d0][r] * rli[r]; Ow[(long)orow * a.ldo + d0 * 32 + r32] = (bf16_t)(cvt_pk_bf16(v, v) & 0xffffu); } }
  __syncthreads();
#undef LANE_CONSTS
#undef R1_PIPE
#undef LSUM
#undef KROW
#undef DQ
#undef SLOAD
#undef SWRITE
#undef SWAIT
#undef RESC
}

__device__ __forceinline__ void attn_body_dma(const Args a, LAS char* lds, int wave) {
  constexpr bool FIX = true;
  const int tid = tid_of(wave), wid = wave, lane = tid & 63, r32 = lane & 31, hi = lane >> 5;
  LAS float* li_l = (LAS float*)(lds + 131072) + wid * 32;
  float l_reg = a.l_init; f32x16 o[4] = {}; bf16x8 qr[8];
  const bf16_t* Qw = a.Q + (long)(wid * QBLK + r32) * D + hi * 8;
#pragma unroll
  for (int d0 = 0; d0 < 8; ++d0) qr[d0] = *reinterpret_cast<const bf16x8*>(Qw + d0 * 16);
  unsigned kof0, kof1, vof0, vof1;
  { const int g0 = wid * 64 + lane, g1 = g0 + 512;
    { const int row = g0 >> 4, sw = g0 & 15; kof0 = (unsigned)(row * 256 + ((sw ^ (row & 7)) << 4)); }
    { const int row = g1 >> 4, sw = g1 & 15; kof1 = (unsigned)(row * 256 + ((sw ^ (row & 7)) << 4)); }
    { const int st = g0 >> 5, gi = g0 & 31, kk = ((st >> 2) << 3) | (gi >> 2), k = (kk & ~0xC) | ((kk & 4) << 1) | ((kk & 8) >> 1), c = (st & 3) * 32 + (gi & 3) * 8; vof0 = (unsigned)((k * D + c) * 2); }
    { const int st = g1 >> 5, gi = g1 & 31, kk = ((st >> 2) << 3) | (gi >> 2), k = (kk & ~0xC) | ((kk & 4) << 1) | ((kk & 8) >> 1), c = (st & 3) * 32 + (gi & 3) * 8; vof1 = (unsigned)((k * D + c) * 2); } }
  const int vbl = (int)(unsigned)(uintptr_t)lds + 16384 + v_rd_base(lane);
  const int NT = a.NT; const float qinit = -a.m_init;
#define KROW(j) (((j) < a.n0) ? (a.base0 + 64 * (j)) : (a.base1 + 64 * ((j) - a.n0)))
#define ADMA(t_) do { const int tc_ = (t_) < NT ? (t_) : NT - 1; const long k0_ = KROW(tc_);     \
    const char* kt_ = (const char*)(a.K + k0_ * D); const char* vt_ = (const char*)(a.V + k0_ * D);                     \
    LAS unsigned char* sb_ = (LAS unsigned char*)lds + ((t_) & 3) * 32768 + wid * 1024;                                                                                   \
    __builtin_amdgcn_global_load_lds((const unsigned*)(kt_ + kof0), (LAS unsigned*)(sb_), 16, 0, 0);                                                                      \
    __builtin_amdgcn_global_load_lds((const unsigned*)(kt_ + kof1), (LAS unsigned*)(sb_ + 8192), 16, 0, 0);                                                               \
    __builtin_amdgcn_global_load_lds((const unsigned*)(vt_ + vof0), (LAS unsigned*)(sb_ + 16384), 16, 0, 0);                                                              \
    __builtin_amdgcn_global_load_lds((const unsigned*)(vt_ + vof1), (LAS unsigned*)(sb_ + 16384 + 8192), 16, 0, 0); } while (0)
#define KS(t_) (lds + ((t_) & 3) * 32768)
#define VB(t_) (vbl + ((t_) & 3) * 32768)
#define TILE_SYNC(more) do { SBAR(); asm volatile("s_waitcnt vmcnt(4)" ::: "memory"); __builtin_amdgcn_s_barrier(); SBAR(); } while (0)
#define R1_PIPE() do { if (ATT_PIPE) { if (ATT_PREK) __builtin_amdgcn_sched_group_barrier(0x100, 2, 0);                                                                 \
    _Pragma("unroll") for (int s_ = 0; s_ < 8; ++s_) { __builtin_amdgcn_sched_group_barrier(0x100, 2, 0);                                                                 \
      __builtin_amdgcn_sched_group_barrier(0x008, 1, 0); __builtin_amdgcn_sched_group_barrier(0x402, ATT_PIPE, 0);                                                        \
      __builtin_amdgcn_sched_group_barrier(0x008, 1, 0); __builtin_amdgcn_sched_group_barrier(0x402, ATT_PIPE, 0); } } } while (0)
#if ATT_PREK
#define QKT qkt_pf
#else
#define QKT qkt
#endif
  f32x16 pA0, pA1, pB0, pB1; bf16x8 pa0, pa1, pa2, pa3; float m_reg = a.m_init, mnA, alA;
  ADMA(0); ADMA(1);
  TILE_SYNC(true);
  qkt(pA0, pA1, KS(0), qr, r32, hi, qinit); partialSM<false, FIX>(pA0, pA1, m_reg, mnA, alA, 0, hi);
  ADMA(2);
  TILE_SYNC(2 < NT);
  for (int t = 1; t + 1 < NT; t += 2) {
    ADMA(t + 2);
    SBAR(); QKT(pB0, pB1, KS(t), qr, r32, hi, qinit);
    finishSM<FIX>(pA0, pA1, 1.f, l_reg, pa0, pa1, pa2, pa3); R1_PIPE(); SBAR();
    pv_d0<true>(o, VB(t - 1), pa0, pa1, pa2, pa3, pB0);
    TILE_SYNC(t + 2 < NT);
    ADMA(t + 3);
    SBAR(); QKT(pA0, pA1, KS(t + 1), qr, r32, hi, qinit);
    finishSM<FIX>(pB0, pB1, 1.f, l_reg, pa0, pa1, pa2, pa3); R1_PIPE(); SBAR();
    pv_d0<true>(o, VB(t), pa0, pa1, pa2, pa3, pA0);
    TILE_SYNC(t + 3 < NT);
  }
  SBAR(); qkt(pB0, pB1, KS(NT - 1), qr, r32, hi, qinit);
  finishSM<FIX>(pA0, pA1, 1.f, l_reg, pa0, pa1, pa2, pa3); SBAR();
  pv_d0<true>(o, VB(NT - 2), pa0, pa1, pa2, pa3, pB0);
  finishSM<FIX>(pB0, pB1, 1.f, l_reg, pa0, pa1, pa2, pa3); SBAR();
  pv_d0<false>(o, VB(NT - 1), pa0, pa1, pa2, pa3, pB0);
  if (hi == 0) li_l[r32] = l_reg; asm volatile("s_waitcnt lgkmcnt(0)" ::: "memory");
  float rli[16];
#pragma unroll
  for (int r = 0; r < 16; ++r) rli[r] = __builtin_amdgcn_rcpf(li_l[crow(r, hi)]);
  bf16_t* Ow = a.O + (long)(wid * QBLK) * a.ldo;
#pragma unroll
  for (int r = 0; r < 16; ++r) { int orow = crow(r, hi);
#pragma unroll
    for (int d0 = 0; d0 < 4; ++d0) { const float v = o[d0][r] * rli[r]; Ow[(long)orow * a.ldo + d0 * 32 + r32] = (bf16_t)(cvt_pk_bf16(v, v) & 0xffffu); } }
  __syncthreads();
#undef KROW
#undef ADMA
#undef KS
#undef VB
#undef TILE_SYNC
#undef QKT
#undef R1_PIPE
}
}
namespace ml {
using namespace att;
struct Args { const bf16_t* Q; const bf16_t* K; const bf16_t* V; const float* GI; const float* GF; float* HM; int dir, ctx_out; };
constexpr int G_A = 0, G_M = 512, G_EBM = 1024, G_WINT = 1536, G_WK = 2048, G_STRIDE = 2560;
constexpr int SM_N = 5120, SM_RDEN = 5632, SM_SCAL = 6656, SM_NACC = 6720;

__device__ __forceinline__ void chunk_map(int c, int dir, int& P0, int& sgn) {
  const int cc = c < 2 ? c : c - 2, pbase = c < 2 ? SEQ : 0, nseg = c < 2 ? CTXL : SEQ;
  if (dir == 0) { P0 = pbase + cc * 128; sgn = 1; } else { P0 = pbase + nseg - 1 - cc * 128; sgn = -1; }
}
__device__ __forceinline__ float scan_add(float x, int lane) {
#pragma unroll
  for (int o = 1; o < 64; o <<= 1) { const float t = __int_as_float(__builtin_amdgcn_ds_bpermute((lane - o) << 2, __float_as_int(x))); if (lane >= o) x += t; }
  return x;
}
__device__ __forceinline__ float scan_max(float x, int lane) {
#pragma unroll
  for (int o = 1; o < 64; o <<= 1) { const float t = __int_as_float(__builtin_amdgcn_ds_bpermute((lane - o) << 2, __float_as_int(x))); if (lane >= o) x = fmaxf(x, t); }
  return x;
}
__device__ __forceinline__ void gate_tables(LAS char* gt, LAS float* scal, float ig0, float ig1, float lf0, float lf1, float m_prev, int lane) {
  float b0 = scan_add(lf0, lane); const float t0 = __int_as_float(__builtin_amdgcn_readlane(__float_as_int(b0), 63)); float b1 = scan_add(lf1, lane) + t0;
  const float a0 = ig0 - b0, a1 = ig1 - b1;
  float A0 = scan_max(a0, lane); const float tA = __int_as_float(__builtin_amdgcn_readlane(__float_as_int(A0), 63)); float A1 = fmaxf(scan_max(a1, lane), tA);
  const float M0 = fmaxf(m_prev, A0), M1 = fmaxf(m_prev, A1), Ml = __int_as_float(__builtin_amdgcn_readlane(__float_as_int(M1), 63)), bl = __int_as_float(__builtin_amdgcn_readlane(__float_as_int(b1), 63));
  LAS float* fa = (LAS float*)(gt + G_A); LAS float* fM = (LAS float*)(gt + G_M); LAS float* fe = (LAS float*)(gt + G_EBM); LAS float* fw = (LAS float*)(gt + G_WINT); LAS float* fk = (LAS float*)(gt + G_WK);
  fa[lane] = a0; fa[64 + lane] = a1; fM[lane] = M0; fM[64 + lane] = M1;
  fe[lane] = __expf(-(b0 + M0)); fe[64 + lane] = __expf(-(b1 + M1));
  fw[lane] = __expf(m_prev - M0); fw[64 + lane] = __expf(m_prev - M1);
  fk[lane] = __expf(a0 - Ml); fk[64 + lane] = __expf(a1 - Ml);
  if (lane == 0) { scal[0] = __expf(m_prev - Ml); scal[1] = bl + Ml; }
}

struct ScanArgs { const bf16_t* K; const bf16_t* V; const float* GI; const float* GF; unsigned char* CIMG; float* NST; float* GT; unsigned* prog; int dir; };
struct OutArgs { const bf16_t* Q; const bf16_t* K; const bf16_t* V; const unsigned char* CIMG; const float* NST; const float* GT; float* HM; unsigned* prog; int dir, c; };
__device__ __forceinline__ void st_sc1_u64(void* p, unsigned long long v) { __hip_atomic_store((unsigned long long*)p, v, __ATOMIC_RELAXED, __HIP_MEMORY_SCOPE_AGENT); }
__device__ __forceinline__ void st_sc1_f32(float* p, float v) { __hip_atomic_store((unsigned*)p, __float_as_uint(v), __ATOMIC_RELAXED, __HIP_MEMORY_SCOPE_AGENT); }

__device__ __forceinline__ void mlstm_scan(const ScanArgs a, LAS char* lds, int wave) {
  int tid = tid_of(wave); const int wid = wave, jb = wid & 3, eh = wid >> 2;
  int lane = tid & 63, r32 = lane & 31, hi = lane >> 5;
  LAS char* V_lds = lds; LAS char* KW_lds = lds + 32768; LAS char* CS_lds = lds + 65536; LAS float* WK = (LAS float*)(lds + 98304);
  LAS float* sm = (LAS float*)(lds + ML_SM); LAS float* AL = sm; LAS float* BL = sm + 64; LAS float* MC = sm + 128; LAS float* DEC = sm + 192;
  float ga0[5], ga1[5], gb0[5], gb1[5], gA0[5], gA1[5];
#pragma unroll
  for (int i = 0; i < 5; ++i) { const int c = wid + 8 * i;
    if (c < 34) { int P0, sg; chunk_map(c, a.dir, P0, sg);
      const float i0 = a.GI[P0 + sg * lane], i1 = a.GI[P0 + sg * (64 + lane)], f0 = a.GF[P0 + sg * lane], f1 = a.GF[P0 + sg * (64 + lane)];
      float b0 = scan_add(f0, lane); const float t0 = __int_as_float(__builtin_amdgcn_readlane(__float_as_int(b0), 63)); float b1 = scan_add(f1, lane) + t0;
      const float a0 = i0 - b0, a1 = i1 - b1;
      float A0 = scan_max(a0, lane); const float tA = __int_as_float(__builtin_amdgcn_readlane(__float_as_int(A0), 63)); float A1 = fmaxf(scan_max(a1, lane), tA);
      ga0[i] = a0; ga1[i] = a1; gb0[i] = b0; gb1[i] = b1; gA0[i] = A0; gA1[i] = A1;
      if (lane == 63) { AL[c] = A1; BL[c] = b1; } } }
  if (tid < 128) st_sc1_f32(a.NST + tid, 0.f);
#pragma unroll
  for (int i = 0; i < 8; ++i) st_sc1_u64(a.CIMG + (size_t)tid * 64 + i * 8, 0ull);
  __syncthreads();
  if (tid == 0) { float mm = -1e30f; for (int c = 0; c < 34; ++c) { const float Ml = fmaxf(mm, AL[c]); MC[c] = mm; DEC[c] = __expf(mm - Ml); mm = BL[c] + Ml; } }
  __syncthreads();
#pragma unroll
  for (int i = 0; i < 5; ++i) { const int c = wid + 8 * i;
    if (c < 34) { const float mm = MC[c], Ml = fmaxf(mm, AL[c]); float* d = a.GT + (size_t)c * 512;
      const float M0 = fmaxf(mm, gA0[i]), M1 = fmaxf(mm, gA1[i]);
      st_sc1_f32(d + lane, ga0[i]); st_sc1_f32(d + 64 + lane, ga1[i]); st_sc1_f32(d + 128 + lane, M0); st_sc1_f32(d + 192 + lane, M1);
      st_sc1_f32(d + 256 + lane, __expf(-(gb0[i] + M0))); st_sc1_f32(d + 320 + lane, __expf(-(gb1[i] + M1)));
      st_sc1_f32(d + 384 + lane, __expf(mm - M0)); st_sc1_f32(d + 448 + lane, __expf(mm - M1));
      WK[c * 128 + lane] = __expf(ga0[i] - Ml); WK[c * 128 + 64 + lane] = __expf(ga1[i] - Ml); } }
  f32x16 cst[2] = {}, nst = {};
  int sr = tid >> 4, sc = (tid & 15) * 8;
  int vbV = (int)(unsigned)(uintptr_t)V_lds + v_rd_base(lane) + eh * 1024;
  int vbKW = (int)(unsigned)(uintptr_t)KW_lds + v_rd_base(lane) + jb * 512;
  bf16x8 stK[4], stV[4];
#define ML_LOADKV(c) do { int P0_, sg_; chunk_map((c), a.dir, P0_, sg_); _Pragma("unroll") for (int i = 0; i < 4; ++i) { const long pos = P0_ + sg_ * (sr + 32 * i); \
    stK[i] = *reinterpret_cast<const bf16x8*>(a.K + pos * 128 + sc); stV[i] = *reinterpret_cast<const bf16x8*>(a.V + pos * 128 + sc); } } while (0)
#define ML_WRITEKV(c) do { const LAS float* fk_ = WK + (c) * 128; _Pragma("unroll") for (int i = 0; i < 4; ++i) { const int s = sr + 32 * i, tl = s >> 6, rr = s & 63; \
    *(LAS bf16x8*)(V_lds + tl * 16384 + v_st(rr, sc)) = stV[i]; \
    const float w_ = fk_[s]; const u32x4 kk = *reinterpret_cast<const u32x4*>(&stK[i]); u32x4 o_; \
    o_.x = cvt_pk_bf16(bflo(kk.x) * w_, bfhi(kk.x) * w_); o_.y = cvt_pk_bf16(bflo(kk.y) * w_, bfhi(kk.y) * w_); o_.z = cvt_pk_bf16(bflo(kk.z) * w_, bfhi(kk.z) * w_); o_.w = cvt_pk_bf16(bflo(kk.w) * w_, bfhi(kk.w) * w_); \
    *(LAS u32x4*)(KW_lds + tl * 16384 + v_st(rr, sc)) = o_; } } while (0)
  ML_LOADKV(0);
  __syncthreads();
  const bf16x8 ones = (bf16x8){(short)0x3F80, (short)0x3F80, (short)0x3F80, (short)0x3F80, (short)0x3F80, (short)0x3F80, (short)0x3F80, (short)0x3F80};
  for (int c = 0; c < 33; ++c) {
    asm volatile("" : "+v"(tid)); lane = tid & 63; r32 = lane & 31; hi = lane >> 5; sr = tid >> 4; sc = (tid & 15) * 8;
    vbV = (int)(unsigned)(uintptr_t)V_lds + v_rd_base(lane) + eh * 1024; vbKW = (int)(unsigned)(uintptr_t)KW_lds + v_rd_base(lane) + jb * 512;
    ML_WRITEKV(c);
    if (c < 32) ML_LOADKV(c + 1);
    const float decay = DEC[c];
    __syncthreads();
#pragma unroll
    for (int r = 0; r < 16; ++r) { cst[0][r] *= decay; cst[1][r] *= decay; nst[r] *= decay; }
#pragma unroll
    for (int t = 0; t < 2; ++t) {
#define ML_UPD(KS) do { const s16x4 kl = tr_read<v_rd_off(0, KS, 0)>(vbKW + t * 16384), kh = tr_read<v_rd_off(0, KS, 1)>(vbKW + t * 16384); \
      const s16x4 v0l = tr_read<v_rd_off(0, KS, 0)>(vbV + t * 16384), v0h = tr_read<v_rd_off(0, KS, 1)>(vbV + t * 16384); \
      const s16x4 v1l = tr_read<v_rd_off(1, KS, 0)>(vbV + t * 16384), v1h = tr_read<v_rd_off(1, KS, 1)>(vbV + t * 16384); \
      asm volatile("s_waitcnt lgkmcnt(0)" ::: "memory"); SBAR(); \
      const bf16x8 ka = PKV(kl, kh); \
      cst[0] = __builtin_amdgcn_mfma_f32_32x32x16_bf16(ka, PKV(v0l, v0h), cst[0], 0, 0, 0); \
      cst[1] = __builtin_amdgcn_mfma_f32_32x32x16_bf16(ka, PKV(v1l, v1h), cst[1], 0, 0, 0); \
      nst = __builtin_amdgcn_mfma_f32_32x32x16_bf16(ka, ones, nst, 0, 0, 0); } while (0)
      ML_UPD(0); ML_UPD(1); ML_UPD(2); ML_UPD(3);
#undef ML_UPD
    }
#pragma unroll
    for (int i = 0; i < 2; ++i)
#pragma unroll
      for (int r = 0; r < 16; ++r) { const int dk = jb * 32 + crow(r, hi), e = (2 * eh + i) * 32 + r32;
        *(LAS bf16_t*)(CS_lds + (dk >> 6) * 16384 + v_st(dk & 63, e)) = (bf16_t)(cvt_pk_bf16(cst[i][r], cst[i][r]) & 0xffffu); }
    if (eh == 0 && r32 == 0) {
#pragma unroll
      for (int r = 0; r < 16; ++r) st_sc1_f32(a.NST + (size_t)(c + 1) * 128 + jb * 32 + crow(r, hi), nst[r]); }
    __syncthreads();
    { unsigned char* dst = a.CIMG + (size_t)(c + 1) * 32768 + (size_t)tid * 64; const LAS unsigned long long* src = (const LAS unsigned long long*)(CS_lds + tid * 64);
#pragma unroll
      for (int i = 0; i < 8; ++i) st_sc1_u64(dst + i * 8, src[i]); }
#ifdef SCAN_PUB_EACH
    VM_WAIT(); __syncthreads();
#endif
  }
#undef ML_LOADKV
#undef ML_WRITEKV
  VM_WAIT(); __syncthreads();
  if (tid == 0) __hip_atomic_store(a.prog, 34u, __ATOMIC_RELAXED, __HIP_MEMORY_SCOPE_AGENT);
  __syncthreads();
}

__device__ __forceinline__ void mlstm_out(const OutArgs a, LAS char* lds, int wave) {
  const int tid = tid_of(wave), wid = wave, jb = wid & 3, eh = wid >> 2, lane = tid & 63, r32 = lane & 31, hi = lane >> 5;
  LAS char* K_lds = lds; LAS char* V_lds = lds + 32768; LAS char* C_lds = lds + 65536; LAS char* sm = lds + ML_SM;
  LAS float* n_lds = (LAS float*)(sm + SM_N); LAS float* rden = (LAS float*)(sm + SM_RDEN) + wid * 32;
  if (wid == 0) { unsigned sp = 0; while (__hip_atomic_load(a.prog, __ATOMIC_RELAXED, __HIP_MEMORY_SCOPE_AGENT) < (unsigned)(a.c + 1)) { __builtin_amdgcn_s_sleep(4); if (++sp > (1u << 22)) break; }
    __builtin_amdgcn_fence(__ATOMIC_ACQUIRE, "agent"); VM_WAIT(); }
  __syncthreads();
  const int sr = tid >> 4, sc = (tid & 15) * 8;
  int P0, sgn; chunk_map(a.c, a.dir, P0, sgn);
  bf16x8 qr[8];
  { bf16x8 stK[4], stV[4]; u32x4 ci[4];
#pragma unroll
    for (int i = 0; i < 4; ++i) { const long pos = P0 + sgn * (sr + 32 * i); stK[i] = *reinterpret_cast<const bf16x8*>(a.K + pos * 128 + sc); stV[i] = *reinterpret_cast<const bf16x8*>(a.V + pos * 128 + sc); }
#pragma unroll
    for (int i = 0; i < 4; ++i) ci[i] = *(const u32x4*)(a.CIMG + (size_t)tid * 64 + i * 16);
    { const long pos = P0 + sgn * (jb * 32 + r32);
#pragma unroll
      for (int d0 = 0; d0 < 8; ++d0) qr[d0] = *reinterpret_cast<const bf16x8*>(a.Q + pos * 128 + d0 * 16 + hi * 8); }
    if (tid < 128) { LAS float* g = (LAS float*)sm;
#pragma unroll
      for (int q = 0; q < 4; ++q) g[q * 128 + tid] = a.GT[q * 128 + tid];
      n_lds[tid] = a.NST[tid]; }
#pragma unroll
    for (int i = 0; i < 4; ++i) { const int s = sr + 32 * i, tl = s >> 6, rr = s & 63;
      *(LAS bf16x8*)(K_lds + tl * 16384 + KSWZ(rr, sc * 2)) = stK[i]; *(LAS bf16x8*)(V_lds + tl * 16384 + v_st(rr, sc)) = stV[i]; }
#pragma unroll
    for (int i = 0; i < 4; ++i) *(LAS u32x4*)(C_lds + tid * 64 + i * 16) = ci[i];
  }
  __syncthreads();
  const int vbV = (int)(unsigned)(uintptr_t)V_lds + v_rd_base(lane) + eh * 1024, vbC = (int)(unsigned)(uintptr_t)C_lds + v_rd_base(lane) + eh * 1024;
  const LAS float* fa = (const LAS float*)(sm + G_A); const LAS float* fM = (const LAS float*)(sm + G_M); const LAS float* fe = (const LAS float*)(sm + G_EBM); const LAS float* fw = (const LAS float*)(sm + G_WINT);
  const int j = jb * 32 + r32; const float Mj = fM[j], wintj = fw[j];
  f32x16 o[2] = {};
  pv_one<0>(o[0], vbC, qr[0], qr[1], qr[2], qr[3]); pv_one<1>(o[1], vbC, qr[0], qr[1], qr[2], qr[3]);
  pv_one<0>(o[0], vbC + 16384, qr[4], qr[5], qr[6], qr[7]); pv_one<1>(o[1], vbC + 16384, qr[4], qr[5], qr[6], qr[7]);
#pragma unroll
  for (int r = 0; r < 16; ++r) { const float w = fw[jb * 32 + crow(r, hi)]; o[0][r] *= w; o[1][r] *= w; }
  float qn = 0.f;
#pragma unroll
  for (int d0 = 0; d0 < 8; ++d0) { const u32x4 qq = *reinterpret_cast<const u32x4*>(&qr[d0]); const f32x4 n0 = *(const LAS f32x4*)(n_lds + d0 * 16 + hi * 8), n1 = *(const LAS f32x4*)(n_lds + d0 * 16 + hi * 8 + 4);
    qn += bflo(qq.x) * n0[0] + bfhi(qq.x) * n0[1] + bflo(qq.y) * n0[2] + bfhi(qq.y) * n0[3] + bflo(qq.z) * n1[0] + bfhi(qq.z) * n1[1] + bflo(qq.w) * n1[2] + bfhi(qq.w) * n1[3]; }
  { auto rr = __builtin_amdgcn_permlane32_swap(__float_as_uint(qn), __float_as_uint(qn), false, false); qn = __uint_as_float(rr[0]) + __uint_as_float(rr[1]); }
  float den = wintj * qn;
#pragma unroll
  for (int t = 0; t < 2; ++t) {
    if (t * 64 <= jb * 32 + 31) {
      f32x16 p0, p1; qkt(p0, p1, K_lds + t * 16384, qr, r32, hi);
      float ps = 0.f;
#pragma unroll
      for (int r = 0; r < 16; ++r) { const int s0 = t * 64 + crow(r, hi), s1 = s0 + 32;
        const float e0 = __expf(fa[s0] - Mj), e1 = __expf(fa[s1] - Mj);
        p0[r] = (s0 <= j) ? p0[r] * e0 : 0.f; p1[r] = (s1 <= j) ? p1[r] * e1 : 0.f; ps += p0[r] + p1[r]; }
      { auto rr = __builtin_amdgcn_permlane32_swap(__float_as_uint(ps), __float_as_uint(ps), false, false); ps = __uint_as_float(rr[0]) + __uint_as_float(rr[1]); }
      den += ps;
      bf16x8 pa0, pa1, pa2, pa3; PK4(p0, 0, pa0); PK4(p0, 8, pa1); PK4(p1, 0, pa2); PK4(p1, 8, pa3);
      pv_one<0>(o[0], vbV + t * 16384, pa0, pa1, pa2, pa3); pv_one<1>(o[1], vbV + t * 16384, pa0, pa1, pa2, pa3);
    }
  }
  const float rd = __builtin_amdgcn_rcpf(fmaxf(fabsf(den), fe[j]));
  if (hi == 0) rden[r32] = rd;
  asm volatile("s_waitcnt lgkmcnt(0)" ::: "memory");
  float* hp = a.HM + ((size_t)a.c * 128 + jb * 32 + 4 * hi) * 128 + eh * 64 + r32;
#pragma unroll
  for (int r = 0; r < 16; ++r) { const int jr = (r & 3) + 8 * (r >> 2); const float rv = rden[jr + 4 * hi];
    hp[jr * 128] = o[0][r] * rv; hp[jr * 128 + 32] = o[1][r] * rv; }
  __syncthreads();
}
}
struct Frame {
    char* lds; LAS unsigned char* lds3; volatile LAS unsigned* LC; unsigned* ctl; unsigned char* ws;
    int tid, lane, wave, G, bid;
    const float* const __attribute__((address_space(4)))* karg;
};
__device__ __forceinline__ const float* inp(const Frame& F, int k) { auto p = F.karg; asm volatile("" : "+s"(p)); return p[k]; }
__device__ __forceinline__ unsigned char* wsp_(const Frame& F) { auto p = F.karg; asm volatile("" : "+s"(p)); return (unsigned char*)p[29]; }
__device__ __forceinline__ float* outp(const Frame& F) { auto p = F.karg; asm volatile("" : "+s"(p)); return (float*)p[28]; }
#define WSP(T, off) ((T*)(F.ws + (off)))

__device__ __forceinline__ void p_mod_partial(Frame& F) {
    float* sv = (float*)F.lds;
    float* MODP = WSP(float, WS_P1);
    for (int it = F.bid; it < 2 * 32 * 6; it += F.G) {
        const int l = it / 192, ks = (it % 192) / 6, cc = it % 6, k0 = ks * 64, n = cc * 2048 + F.tid * 4;
        __syncthreads();
        for (int i = F.tid; i < 320; i += NTHR) { const int r = i >> 6, k = i & 63; const float c = (r < 4) ? inp(F, 1)[r * DM + k0 + k] : inp(F, 3)[k0 + k]; sv[i] = siluf_(c); }
        __syncthreads();
        const float* w = inp(F, 6) + (size_t)l * DM * 12288 + (size_t)k0 * 12288 + n;
        f32x4 a0 = {0.f, 0.f, 0.f, 0.f}, a1 = a0, a2 = a0, a3 = a0, a4 = a0;
#pragma unroll 16
        for (int k = 0; k < 64; ++k) { const f32x4 wv = *(const f32x4*)(w + (size_t)k * 12288); a0 += sv[k] * wv; a1 += sv[64 + k] * wv; a2 += sv[128 + k] * wv; a3 += sv[192 + k] * wv; a4 += sv[256 + k] * wv; }
        float* o = MODP + ((size_t)(l * 32 + ks) * 5) * 12288 + n;
        *(f32x4*)(o) = a0; *(f32x4*)(o + 12288) = a1; *(f32x4*)(o + 2 * 12288) = a2; *(f32x4*)(o + 3 * 12288) = a3; *(f32x4*)(o + 4 * 12288) = a4;
    }
    __syncthreads();
}
__device__ __forceinline__ void p_rope_tables(Frame& F) {
    float* ct = WSP(float, WS_ROPE); float* st = ct + SEQ * 64;
    for (int i = F.bid * NTHR + F.tid; i < SEQ * 64; i += F.G * NTHR) {
        const int t = i >> 6, j = i & 63, ax = j >> 5, f = j & 31;
        const float inv = powf(10000.0f, -(float)(2 * f) / 64.0f);
        const float ang = (float)(ax == 0 ? (t >> 6) : (t & 63)) * inv;
        ct[i] = __cosf(ang); st[i] = __sinf(ang);
    }
    float* WRT = (float*)(F.ws + WS_ROUTE + RT_WRT);
    for (int i = F.bid * NTHR + F.tid; i < 2 * 5 * 2048; i += F.G * NTHR) {
        const int k = i & 2047, pl = (i >> 11) % 5, l = i / (5 * 2048);
        const int j = k >> 8, lane = (k >> 2) & 63, ii = k & 3, ji = j * 4 + ii;
        const float* src = pl == 0 ? inp(F, 20) + ((size_t)l * DM + k) * 4 : inp(F, 22) + ((size_t)l * DM + k) * 16 + (pl - 1) * 4;
        *(f32x4*)(WRT + ((size_t)((l * 5 + pl) * 32 + ji) * 64 + lane) * 4) = *(const f32x4*)src;
    }
}
__device__ __forceinline__ void p_mod_reduce(Frame& F) {
    const float* MODP = WSP(float, WS_P1); float* MOD = WSP(float, WS_MOD);
    for (int i = F.bid * NTHR + F.tid; i < 2 * 5 * 12288; i += F.G * NTHR) {
        const int l = i / 61440, r = (i % 61440) / 12288, n = i % 12288;
        float s = inp(F, 7)[l * 12288 + n];
#pragma unroll
        for (int ks = 0; ks < 32; ++ks) s += MODP[((size_t)(l * 32 + ks) * 5 + r) * 12288 + n];
        MOD[i] = s;
    }
}
struct TrItem { const float* src; size_t lds_; int k0, ns0, nvalid; bf16_t* dst; size_t ldd; int kd0, mode, rowbase; const unsigned* wmax; };
struct TrRegs { f32x4 ld[8]; };
__device__ __forceinline__ void tr_load(const TrItem& d, TrRegs& r, int lane) {
    const int c4 = (lane & 7) * 4, r0 = lane >> 3;
#pragma unroll
    for (int i = 0; i < 8; ++i) r.ld[i] = (c4 < d.nvalid) ? *(const f32x4*)(d.src + (size_t)(d.k0 + i * 8 + r0) * d.lds_ + d.ns0 + c4) : (f32x4){0.f, 0.f, 0.f, 0.f};
}
__device__ __forceinline__ void tr_store(const TrItem& d, const TrRegs& r, float* scr, int lane) {
    const int c4 = (lane & 7) * 4, r0 = lane >> 3;
#pragma unroll
    for (int i = 0; i < 8; ++i) { float* p = scr + (i * 8 + r0) * 33 + c4; p[0] = r.ld[i][0]; p[1] = r.ld[i][1]; p[2] = r.ld[i][2]; p[3] = r.ld[i][3]; }
    LDS_WAIT(); asm volatile("" ::: "memory");
    const int c = lane & 7;
    if (d.mode & 2) {
#pragma unroll
        for (int j = 0; j < 4; ++j) { const int n = (lane >> 3) + 8 * j; const float* s = scr + (8 * c) * 33 + n;
            const int drow = (d.mode & 1) ? d.rowbase + 8 * (n >> 2) + (n & 3) : d.rowbase + n;
            const float mx = __uint_as_float(d.wmax[drow]); const float sc = mx > 0.f ? 127.0f / mx : 0.f; unsigned q[8];
#pragma unroll
            for (int i = 0; i < 8; ++i) q[i] = (unsigned)((int)rintf(s[i * 33] * sc) & 0xff);
            u32x2 o; o.x = q[0] | (q[1] << 8) | (q[2] << 16) | (q[3] << 24); o.y = q[4] | (q[5] << 8) | (q[6] << 16) | (q[7] << 24);
            *(u32x2*)((unsigned char*)(d.dst + (size_t)drow * d.ldd) + d.kd0 + 8 * c) = o; }
        LDS_WAIT(); asm volatile("" ::: "memory");
        return;
    }
#pragma unroll
    for (int j = 0; j < 4; ++j) { const int n = (lane >> 3) + 8 * j; const float* s = scr + (8 * c) * 33 + n;
        u32x4 o; o.x = cvt_pk_bf16(s[0 * 33], s[1 * 33]); o.y = cvt_pk_bf16(s[2 * 33], s[3 * 33]); o.z = cvt_pk_bf16(s[4 * 33], s[5 * 33]); o.w = cvt_pk_bf16(s[6 * 33], s[7 * 33]);
        const int drow = (d.mode & 1) ? d.rowbase + 8 * (n >> 2) + (n & 3) : d.rowbase + n;
        *(u32x4*)(d.dst + (size_t)drow * d.ldd + d.kd0 + 8 * c) = o; }
    LDS_WAIT(); asm volatile("" ::: "memory");
}
struct CvtCtx { bf16_t *WIN, *WBR, *WOUT, *WGU, *WD; const float *w_in, *w_a, *w_m, *w_c, *w_o, *w_g, *w_u, *w_d; const unsigned* wmax; const unsigned* wmax2; };
__device__ __forceinline__ TrItem tr_decode(const CvtCtx& C, int it) {
    constexpr int I_IN = 344 * 32, I_A = 16 * 64, I_M = 8 * 64, I_O = 32 * 64, I_G = NEXP * 32 * 16;
    int r = it;
    if (r < I_IN) { const int nb = r >> 5, kb = r & 31;
        int ns0, nv; if (nb < 112) { ns0 = nb * 32; nv = 32; } else if (nb < 336) { ns0 = nb * 32 + 16; nv = 32; } else if (nb == 336) { ns0 = 3584; nv = 16; } else { ns0 = 0; nv = 0; }
        if (nb < 144) return TrItem{C.w_in, (size_t)PIN, kb * 64, ns0, nv, C.WIN + (size_t)4608 * DM, (size_t)1024, kb * 64, 2, 6144 + nb * 32, C.wmax};
        if (nb >= 144 && nb < 336) return TrItem{C.w_in, (size_t)PIN, kb * 64, ns0, nv, C.WIN + (size_t)4608 * DM, (size_t)1024, kb * 64, 2, (nb - 144) * 32, C.wmax};
        return TrItem{C.w_in, (size_t)PIN, kb * 64, ns0, nv, C.WIN, (size_t)DM, kb * 64, 0, nb * 32, nullptr}; } r -= I_IN;
    if (r < I_A) { const int kb = r >> 6, nb = r & 63; return TrItem{C.w_a, (size_t)DM, kb * 64, nb * 32, 32, C.WBR, (size_t)DM, kb * 64, 0, nb * 32, nullptr}; } r -= I_A;
    if (r < I_M) { const int kb = r >> 6, nb = r & 63; return TrItem{C.w_m, (size_t)DM, kb * 64, nb * 32, 32, C.WBR, (size_t)DM, 1024 + kb * 64, 0, nb * 32, nullptr}; } r -= I_M;
    if (r < I_M) { const int kb = r >> 6, nb = r & 63; return TrItem{C.w_c, (size_t)DM, kb * 64, nb * 32, 32, C.WBR, (size_t)DM, 1536 + kb * 64, 0, nb * 32, nullptr}; } r -= I_M;
    if (r < I_O) { const int kb = r >> 6, nb = r & 63; return TrItem{C.w_o, (size_t)DM, kb * 64, nb * 32, 32, C.WOUT, (size_t)DM, kb * 64, 0, nb * 32, nullptr}; } r -= I_O;
    if (r < I_G) { const int e = r >> 9, kb = (r >> 4) & 31, fb = r & 15; return TrItem{C.w_g + (size_t)e * DM * DFF, (size_t)DFF, kb * 64, fb * 32, 32, C.WGU, (size_t)1024, kb * 64, 3, e * 1024 + fb * 64, C.wmax2}; } r -= I_G;
    if (r < I_G) { const int e = r >> 9, kb = (r >> 4) & 31, fb = r & 15; return TrItem{C.w_u + (size_t)e * DM * DFF, (size_t)DFF, kb * 64, fb * 32, 32, C.WGU, (size_t)1024, kb * 64, 3, e * 1024 + fb * 64 + 4, C.wmax2}; } r -= I_G;
    { const int e = r >> 9, kb = (r >> 6) & 7, nb = r & 63; return TrItem{C.w_d + (size_t)e * DFF * DM, (size_t)DM, kb * 64, nb * 32, 32, C.WD, (size_t)DFF, kb * 64, 0, e * 2048 + nb * 32, nullptr}; }
}
__device__ __forceinline__ void p_convert_weights(Frame& F, int l, int part) {
    float* scr = (float*)(F.lds + F.wave * 16384);
    const int gw = opaque_s(F.bid * NWAVES + F.wave), NGW = F.G * NWAVES;
    CvtCtx C; C.WIN = WSP(bf16_t, WS_WIN); C.WBR = WSP(bf16_t, WS_WBR); C.WOUT = WSP(bf16_t, WS_WOUT); C.WGU = WSP(bf16_t, WS_WGU); C.WD = WSP(bf16_t, WS_WD);
    C.w_in = inp(F, 8) + (size_t)l * DM * PIN;
    C.w_a = inp(F, 16) + (size_t)l * 1024 * DM; C.w_m = inp(F, 17) + (size_t)l * 512 * DM; C.w_c = inp(F, 18) + (size_t)l * 512 * DM;
    C.w_o = inp(F, 19) + (size_t)l * DM * DM;
    C.wmax = F.ctl + CW_WMAX + l * 10752; C.wmax2 = F.ctl + CW_WMAX2 + l * 16384;
    C.w_g = inp(F, 24) + (size_t)l * NEXP * DM * DFF; C.w_u = inp(F, 25) + (size_t)l * NEXP * DM * DFF; C.w_d = inp(F, 26) + (size_t)l * NEXP * DFF * DM;
    constexpr int NIT = 344 * 32 + 16 * 64 + 2 * 8 * 64 + 32 * 64 + 2 * NEXP * 32 * 16 + NEXP * 8 * 64;
    {
        int it = gw; TrItem cur{}; TrRegs rc; bool have = false;
        for (; it < NIT; it += NGW) { cur = tr_decode(C, it); if (part == 2 || (part == 1) == ((cur.mode & 2) != 0)) { have = true; break; } }
        if (have) tr_load(cur, rc, F.lane);
        while (have) {
            TrItem nxt{}; TrRegs rn = rc; bool hn = false; int jt = it + NGW;
            for (; jt < NIT; jt += NGW) { nxt = tr_decode(C, jt); if (part == 2 || (part == 1) == ((nxt.mode & 2) != 0)) { hn = true; break; } }
            if (hn) tr_load(nxt, rn, F.lane);
            tr_store(cur, rc, scr, F.lane);
            cur = nxt; rc = rn; have = hn; it = jt;
        }
    }
    if (part != 0) { float* ws8 = WSP(float, WS_WS8) + l * 10752;
        const int i = F.bid * NTHR + F.tid; if (i < 10752) ws8[i] = __uint_as_float(C.wmax[i]) * (1.0f / 127.0f);
        float* wgs = (float*)(F.ws + WS_ROUTE + RT_WGS) + l * 16384; if (i < 16384) wgs[i] = __uint_as_float(C.wmax2[i]) * (1.0f / 127.0f); }
}

__device__ __forceinline__ TrItem i8_strip_item(const CvtCtx& C, int s, int kb) {
    if (s < 337) { const int nb = s, ns0 = nb < 112 ? nb * 32 : (nb < 336 ? nb * 32 + 16 : 3584), rowbase = nb < 144 ? 6144 + nb * 32 : (nb < 336 ? (nb - 144) * 32 : 10752);
        return TrItem{C.w_in, (size_t)PIN, kb * 64, ns0, nb == 336 ? 16 : 32, C.WIN + (size_t)4608 * DM, (size_t)1024, kb * 64, 2, rowbase, nullptr}; }
    const int r = s - 337, e = r >> 5, mat = (r >> 4) & 1, fb = r & 15;
    return TrItem{(mat ? C.w_u : C.w_g) + (size_t)e * DM * DFF, (size_t)DFF, kb * 64, fb * 32, 32, C.WGU, (size_t)1024, kb * 64, 3, e * 1024 + fb * 64 + mat * 4, nullptr};
}
__device__ __forceinline__ void tr_store_i8(const TrItem& d, const TrRegs& r, float* scr, int lane, const float (&cmv)[4]) {
    const int c4 = (lane & 7) * 4, r0 = lane >> 3;
#pragma unroll
    for (int i = 0; i < 8; ++i) { float* p = scr + (i * 8 + r0) * 33 + c4; p[0] = r.ld[i][0]; p[1] = r.ld[i][1]; p[2] = r.ld[i][2]; p[3] = r.ld[i][3]; }
    LDS_WAIT(); asm volatile("" ::: "memory");
    const int c = lane & 7;
#pragma unroll
    for (int j = 0; j < 4; ++j) { const int n = (lane >> 3) + 8 * j; const float* s = scr + (8 * c) * 33 + n;
        const int drow = (d.mode & 1) ? d.rowbase + 8 * (n >> 2) + (n & 3) : d.rowbase + n;
        const float mx = cmv[j]; const float sc = mx > 0.f ? 127.0f / mx : 0.f; unsigned q[8];
#pragma unroll
        for (int i = 0; i < 8; ++i) q[i] = (unsigned)((int)rintf(s[i * 33] * sc) & 0xff);
        u32x2 o; o.x = q[0] | (q[1] << 8) | (q[2] << 16) | (q[3] << 24); o.y = q[4] | (q[5] << 8) | (q[6] << 16) | (q[7] << 24);
        *(u32x2*)((unsigned char*)(d.dst + (size_t)drow * d.ldd) + d.kd0 + 8 * c) = o; }
    LDS_WAIT(); asm volatile("" ::: "memory");
}
__device__ __forceinline__ void p_convert_i8(Frame& F, int l) {
    float* scr = (float*)(F.lds + F.wave * 16384);
    float* mb = (float*)(F.lds + 131072);
    CvtCtx C; C.WIN = WSP(bf16_t, WS_WIN); C.WGU = WSP(bf16_t, WS_WGU);
    C.w_in = inp(F, 8) + (size_t)l * DM * PIN; C.w_g = inp(F, 24) + (size_t)l * NEXP * DM * DFF; C.w_u = inp(F, 25) + (size_t)l * NEXP * DM * DFF;
    float* ws8 = WSP(float, WS_WS8) + l * 11008; float* wgs = (float*)(F.ws + WS_ROUTE + RT_WGS) + l * 16384;
    const int kb0 = F.wave * 4;
    constexpr int NSTRIP = 337 + 512;
#define I8_ACC(R) do { _Pragma("unroll") for (int i_ = 0; i_ < 8; ++i_) _Pragma("unroll") for (int c_ = 0; c_ < 4; ++c_) m[c_] = fmaxf(m[c_], fabsf(R.ld[i_][c_])); } while (0)
    for (int s = F.bid; s < NSTRIP; s += F.G) {
        TrRegs r0, r1, r2, r3;
        tr_load(i8_strip_item(C, s, kb0), r0, F.lane); tr_load(i8_strip_item(C, s, kb0 + 1), r1, F.lane); tr_load(i8_strip_item(C, s, kb0 + 2), r2, F.lane); tr_load(i8_strip_item(C, s, kb0 + 3), r3, F.lane);
        float m[4] = {0.f, 0.f, 0.f, 0.f};
        I8_ACC(r0); I8_ACC(r1); I8_ACC(r2); I8_ACC(r3);
#pragma unroll
        for (int c = 0; c < 4; ++c) { m[c] = fmaxf(m[c], xshfl<8>(m[c])); m[c] = fmaxf(m[c], xshfl<16>(m[c])); m[c] = fmaxf(m[c], xshfl<32>(m[c])); }
        if (F.lane < 8) { float* p = mb + F.wave * 32 + F.lane * 4; p[0] = m[0]; p[1] = m[1]; p[2] = m[2]; p[3] = m[3]; }
        __syncthreads();
        float cmv[4];
#pragma unroll
        for (int j = 0; j < 4; ++j) { const int n = (F.lane >> 3) + 8 * j; const float* p = mb + n;
            cmv[j] = fmaxf(fmaxf(fmaxf(p[0], p[32]), fmaxf(p[64], p[96])), fmaxf(fmaxf(p[128], p[160]), fmaxf(p[192], p[224]))); }
        if (F.wave == 0 && F.lane < 32) { const int n = F.lane; const float* p = mb + n;
            const float cm = fmaxf(fmaxf(fmaxf(p[0], p[32]), fmaxf(p[64], p[96])), fmaxf(fmaxf(p[128], p[160]), fmaxf(p[192], p[224])));
            const TrItem d = i8_strip_item(C, s, 0); const int drow = (d.mode & 1) ? d.rowbase + 8 * (n >> 2) + (n & 3) : d.rowbase + n;
            (s < 337 ? ws8 : wgs)[drow] = cm * (1.0f / 127.0f); }
        tr_store_i8(i8_strip_item(C, s, kb0), r0, scr, F.lane, cmv); tr_store_i8(i8_strip_item(C, s, kb0 + 1), r1, scr, F.lane, cmv);
        tr_store_i8(i8_strip_item(C, s, kb0 + 2), r2, scr, F.lane, cmv); tr_store_i8(i8_strip_item(C, s, kb0 + 3), r3, scr, F.lane, cmv);
        __syncthreads();
    }
#undef I8_ACC
}

struct RowVec { f32x4 v[8]; };
__device__ __forceinline__ void row_load(RowVec& x, const float* p, int lane) {
#pragma unroll
    for (int j = 0; j < 8; ++j) x.v[j] = *(const f32x4*)(p + (j * 64 + lane) * 4);
}
__device__ __forceinline__ void row_load_bf16(RowVec& x, const bf16_t* p, int lane) {
#pragma unroll
    for (int j = 0; j < 8; ++j) { const u32x2 a = *(const u32x2*)(p + (j * 64 + lane) * 4); x.v[j] = (f32x4){bflo(a.x), bfhi(a.x), bflo(a.y), bfhi(a.y)}; }
}
__device__ __forceinline__ float row_rms(const RowVec& x) {
    float s = 0.f;
#pragma unroll
    for (int j = 0; j < 8; ++j) s += (x.v[j][0] * x.v[j][0] + x.v[j][1] * x.v[j][1]) + (x.v[j][2] * x.v[j][2] + x.v[j][3] * x.v[j][3]);
    return rsqrtf(wave_sum(s) * (1.0f / DM) + EPS);
}
__device__ __forceinline__ void row_add_moe(RowVec& x, const bf16_t* MOEOUT, int d0, int d1, const float* g2, int lane) {
#pragma unroll
    for (int j = 0; j < 8; ++j) { const int c = (j * 64 + lane) * 4;
        const u32x2 a = *(const u32x2*)(MOEOUT + (size_t)d0 * DM + c), b = *(const u32x2*)(MOEOUT + (size_t)d1 * DM + c); const f32x4 g = *(const f32x4*)(g2 + c);
        x.v[j][0] += g[0] * (bflo(a.x) + bflo(b.x)); x.v[j][1] += g[1] * (bfhi(a.x) + bfhi(b.x)); x.v[j][2] += g[2] * (bflo(a.y) + bflo(b.y)); x.v[j][3] += g[3] * (bfhi(a.y) + bfhi(b.y)); }
}
__device__ __forceinline__ void row_modulate(RowVec& x, float rms, const float* ng, const float* sh, const float* sc, int lane) {
#pragma unroll
    for (int j = 0; j < 8; ++j) { const int c = (j * 64 + lane) * 4; const f32x4 g = *(const f32x4*)(ng + c), s = *(const f32x4*)(sc + c), h = *(const f32x4*)(sh + c);
        x.v[j] = (x.v[j] * rms * g) * (s + 1.0f) + h; }
}
__device__ __forceinline__ void row_store_bf16(const RowVec& x, bf16_t* p, int lane) {
#pragma unroll
    for (int j = 0; j < 8; ++j) { u32x2 o; o.x = cvt_pk_bf16(x.v[j][0], x.v[j][1]); o.y = cvt_pk_bf16(x.v[j][2], x.v[j][3]); *(u32x2*)(p + (j * 64 + lane) * 4) = o; }
}
__device__ __forceinline__ void row_store_i8(const RowVec& x, unsigned char* p, float* hs, int lane) {
    float am = 0.f;
#pragma unroll
    for (int j = 0; j < 8; ++j) am = fmaxf(am, fmaxf(fmaxf(fabsf(x.v[j][0]), fabsf(x.v[j][1])), fmaxf(fabsf(x.v[j][2]), fabsf(x.v[j][3]))));
    am = fmaxf(wave_max(am), 1e-20f); const float s = 127.0f / am;
#pragma unroll
    for (int j = 0; j < 8; ++j) { const int q0 = (int)rintf(x.v[j][0] * s), q1 = (int)rintf(x.v[j][1] * s), q2 = (int)rintf(x.v[j][2] * s), q3 = (int)rintf(x.v[j][3] * s);
        *(unsigned*)(p + (j * 64 + lane) * 4) = (unsigned)(q0 & 0xff) | ((unsigned)(q1 & 0xff) << 8) | ((unsigned)(q2 & 0xff) << 16) | ((unsigned)(q3 & 0xff) << 24); }
    if (lane == 0) *hs = am * (1.0f / 127.0f);
}
__device__ __forceinline__ void row_store_f32(const RowVec& x, float* p, int lane) {
#pragma unroll
    for (int j = 0; j < 8; ++j) *(f32x4*)(p + (j * 64 + lane) * 4) = x.v[j];
}
__device__ __forceinline__ void p_norm1(Frame& F, int l) {
    const int gw = opaque_s(F.bid * NWAVES + F.wave), NGW = F.G * NWAVES;
    const float* MOD = WSP(float, WS_MOD); bf16_t* H = WSP(bf16_t, WS_H); bf16_t* XL = WSP(bf16_t, WS_XL); bf16_t* XC = WSP(bf16_t, WS_XC);
    const bf16_t* MOEOUT = WSP(bf16_t, WS_MOEOUT); const int* SLOTD = (const int*)(F.ws + WS_ROUTE + RT_SLOTD);
    const float* ng = inp(F, 4) + l * DM;
    int nd0 = 0, nd1 = 0, nd2 = 0, nd3 = 0;
    if (l > 0 && gw * 2 < NROW) { nd0 = SLOTD[gw * 4]; nd1 = SLOTD[gw * 4 + 1]; nd2 = SLOTD[gw * 4 + 2]; nd3 = SLOTD[gw * 4 + 3]; }
    for (int r0 = gw * 2; r0 < NROW; r0 += NGW * 2) {
        const bool lat = r0 < NLAT; const int mr = lat ? (r0 >> 12) : 4;
        RowVec xa, xb;
        if (l == 0) { const float* p = lat ? inp(F, 0) + (size_t)r0 * DM : inp(F, 2) + (size_t)(r0 - NLAT) * DM; row_load(xa, p, F.lane); row_load(xb, p + DM, F.lane); }
        else { bf16_t* xp = lat ? XL + (size_t)r0 * DM : XC + (size_t)(r0 - NLAT) * DM;
            const int d0 = nd0, d1 = nd1, d2 = nd2, d3 = nd3;
            { const int rn = r0 + NGW * 2; if (rn < NROW) { nd0 = SLOTD[rn * 2]; nd1 = SLOTD[rn * 2 + 1]; nd2 = SLOTD[rn * 2 + 2]; nd3 = SLOTD[rn * 2 + 3]; } }
            row_load_bf16(xa, xp, F.lane); row_load_bf16(xb, xp + DM, F.lane);
            const float* g2 = MOD + (size_t)((l - 1) * 5 + mr) * 12288 + 10240;
            row_add_moe(xa, MOEOUT, d0, d1, g2, F.lane); row_add_moe(xb, MOEOUT, d2, d3, g2, F.lane);
            row_store_bf16(xa, xp, F.lane); row_store_bf16(xb, xp + DM, F.lane); }
        const float ra = row_rms(xa), rb = row_rms(xb); const float* m = MOD + (size_t)(l * 5 + mr) * 12288;
        row_modulate(xa, ra, ng, m, m + 2048, F.lane); row_modulate(xb, rb, ng, m, m + 2048, F.lane);
        row_store_i8(xa, F.ws + WS_H8 + (size_t)r0 * 2048, WSP(float, WS_HS) + r0, F.lane); row_store_i8(xb, F.ws + WS_H8 + (size_t)(r0 + 1) * 2048, WSP(float, WS_HS) + r0 + 1, F.lane);
    }
}
__device__ __forceinline__ void p_final(Frame& F) {
    const int gw = opaque_s(F.bid * NWAVES + F.wave), NGW = F.G * NWAVES;
    const float* MOD = WSP(float, WS_MOD); const bf16_t* XL = WSP(bf16_t, WS_XL);
    const bf16_t* MOEOUT = WSP(bf16_t, WS_MOEOUT); const int* SLOTD = (const int*)(F.ws + WS_ROUTE + RT_SLOTD);
    int nd0 = 0, nd1 = 0, nd2 = 0, nd3 = 0;
    if (gw * 2 < NLAT) { nd0 = SLOTD[gw * 4]; nd1 = SLOTD[gw * 4 + 1]; nd2 = SLOTD[gw * 4 + 2]; nd3 = SLOTD[gw * 4 + 3]; }
    for (int r0 = gw * 2; r0 < NLAT; r0 += NGW * 2) {
        float* out_ = outp(F); const float* fg_ = inp(F, 27);
        const int d0 = nd0, d1 = nd1, d2 = nd2, d3 = nd3;
        { const int rn = r0 + NGW * 2; if (rn < NLAT) { nd0 = SLOTD[rn * 2]; nd1 = SLOTD[rn * 2 + 1]; nd2 = SLOTD[rn * 2 + 2]; nd3 = SLOTD[rn * 2 + 3]; } }
        RowVec xa, xb; row_load_bf16(xa, XL + (size_t)r0 * DM, F.lane); row_load_bf16(xb, XL + (size_t)(r0 + 1) * DM, F.lane);
        const float* g2 = MOD + (size_t)(5 + (r0 >> 12)) * 12288 + 10240;
        row_add_moe(xa, MOEOUT, d0, d1, g2, F.lane); row_add_moe(xb, MOEOUT, d2, d3, g2, F.lane);
        const float ra = row_rms(xa), rb = row_rms(xb);
#pragma unroll
        for (int j = 0; j < 8; ++j) { const int c = (j * 64 + F.lane) * 4; const f32x4 g = *(const f32x4*)(fg_ + c);
            *(f32x4*)(out_ + (size_t)r0 * DM + c) = xa.v[j] * ra * g; *(f32x4*)(out_ + (size_t)(r0 + 1) * DM + c) = xb.v[j] * rb * g; }
    }
}
__device__ __forceinline__ void p_norm2_route(Frame& F, int l, int nrows, bool dry = false) {
    const int gw = opaque_s(F.bid * NWAVES + F.wave), NGW = F.G * NWAVES;
    const float* MOD = WSP(float, WS_MOD); bf16_t* H = WSP(bf16_t, WS_H); const bf16_t* XL = WSP(bf16_t, WS_XL); const bf16_t* XC = WSP(bf16_t, WS_XC);
    const float* ng = inp(F, 5) + l * DM; const float* w_rg = inp(F, 20) + (size_t)l * DM * 4; const float* w_re = inp(F, 22) + (size_t)l * DM * 16;
    const float* b_rg = inp(F, 21) + l * 4; const float* b_re = inp(F, 23) + l * 16;
    const float* WRT = (const float*)(F.ws + WS_ROUTE + RT_WRT) + (size_t)l * 5 * 8192;
    int* lc = (int*)F.lds;
    if (F.tid < 64) lc[F.tid] = 0;
    __syncthreads();
    for (int row = gw; row < nrows; row += 2 * NGW) {
        const int rowb = row + NGW; const bool hb = rowb < nrows; const int rb = hb ? rowb : row;
        const bool lat = row < NLAT, latb = rb < NLAT; const int mr = lat ? (row >> 12) : 4, mrb = latb ? (rb >> 12) : 4;
        RowVec x, y; row_load_bf16(x, lat ? XL + (size_t)row * DM : XC + (size_t)(row - NLAT) * DM, F.lane); row_load_bf16(y, latb ? XL + (size_t)rb * DM : XC + (size_t)(rb - NLAT) * DM, F.lane);
        { const float rms = row_rms(x); const float* m = MOD + (size_t)(l * 5 + mr) * 12288; row_modulate(x, rms, ng, m + 6144, m + 8192, F.lane); }
        { const float rms = row_rms(y); const float* m = MOD + (size_t)(l * 5 + mrb) * 12288; row_modulate(y, rms, ng, m + 6144, m + 8192, F.lane); }
        row_store_i8(x, (unsigned char*)H + (size_t)row * 2048, (float*)(F.ws + WS_ROUTE + RT_HS2) + row, F.lane);
        if (hb) row_store_i8(y, (unsigned char*)H + (size_t)rb * 2048, (float*)(F.ws + WS_ROUTE + RT_HS2) + rb, F.lane);
        float lg[4], lh[4];
#pragma unroll
        for (int i = 0; i < 4; ++i) { lg[i] = 0.f; lh[i] = 0.f; }
        const int lane_o = opaque(F.lane);
#pragma unroll
        for (int j = 0; j < 8; ++j) {
#pragma unroll
            for (int i = 0; i < 4; ++i) { const int k = (j * 64 + lane_o) * 4 + i; const float hv = x.v[j][i], hw = y.v[j][i];
                const f32x4 wg = *(const f32x4*)(WRT + ((size_t)(j * 4 + i) * 64 + lane_o) * 4);
#pragma unroll
                for (int q = 0; q < 4; ++q) { lg[q] += hv * wg[q]; lh[q] += hw * wg[q]; } }
            asm volatile("" ::: "memory"); }
#pragma unroll
        for (int i = 0; i < 4; ++i) { lg[i] = wave_sum(lg[i]) + b_rg[i]; lh[i] = wave_sum(lh[i]) + b_rg[i]; }
        int gsx = 0, gsy = 0;
        { float gm = lg[0]; if (lg[1] > gm) { gm = lg[1]; gsx = 1; } if (lg[2] > gm) { gm = lg[2]; gsx = 2; } if (lg[3] > gm) { gm = lg[3]; gsx = 3; } }
        { float gm = lh[0]; if (lh[1] > gm) { gm = lh[1]; gsy = 1; } if (lh[2] > gm) { gm = lh[2]; gsy = 2; } if (lh[3] > gm) { gm = lh[3]; gsy = 3; } }
        gsx = __builtin_amdgcn_readfirstlane(gsx); gsy = __builtin_amdgcn_readfirstlane(gsy);
        float ex[4], ey[4];
#pragma unroll
        for (int i = 0; i < 4; ++i) { ex[i] = 0.f; ey[i] = 0.f; }
        const float* wex = WRT + (size_t)(1 + gsx) * 8192; const float* wey = WRT + (size_t)(1 + gsy) * 8192;
#pragma unroll
        for (int j = 0; j < 8; ++j) {
#pragma unroll
            for (int i = 0; i < 4; ++i) { const int k = (j * 64 + lane_o) * 4 + i; const float hv = x.v[j][i], hw = y.v[j][i];
                const f32x4 ea = *(const f32x4*)(wex + ((size_t)(j * 4 + i) * 64 + lane_o) * 4), eb = *(const f32x4*)(wey + ((size_t)(j * 4 + i) * 64 + lane_o) * 4);
#pragma unroll
                for (int q = 0; q < 4; ++q) { ex[q] += hv * ea[q]; ey[q] += hw * eb[q]; } }
            asm volatile("" ::: "memory"); }
#pragma unroll
        for (int i = 0; i < 4; ++i) { ex[i] = wave_sum(ex[i]); ey[i] = wave_sum(ey[i]); }
#pragma unroll 1
        for (int rr = 0; rr < 2; ++rr) {
            if (rr == 1) {
                if (!hb) break;
#pragma unroll
                for (int i = 0; i < 4; ++i) { lg[i] = lh[i]; ex[i] = ey[i]; }
                gsx = gsy; }
            const int crow = rr ? rb : row;
            if (F.lane == 0) {
                const int gs = gsx; const float gm = fmaxf(fmaxf(lg[0], lg[1]), fmaxf(lg[2], lg[3]));
                const float pg = 1.0f / (__expf(lg[0] - gm) + __expf(lg[1] - gm) + __expf(lg[2] - gm) + __expf(lg[3] - gm));
                float el[4];
#pragma unroll
                for (int q = 0; q < 4; ++q) el[q] = ex[q] + b_re[gs * 4 + q];
                int i0 = 0; float m0 = el[0];
#pragma unroll
                for (int q = 1; q < 4; ++q) if (el[q] > m0) { m0 = el[q]; i0 = q; }
                int i1 = -1; float m1 = -3.0e38f;
#pragma unroll
                for (int q = 0; q < 4; ++q) if (q != i0 && el[q] > m1) { m1 = el[q]; i1 = q; }
                const float p1 = __expf(m1 - m0);
                const float w0 = pg / (1.0f + p1), w1 = pg * p1 / (1.0f + p1);
                const int e0 = gs * 4 + i0, e1 = gs * 4 + i1;
                if (!dry) {
                    const int n = atomicAdd(&lc[32], 2);
                    const int q0 = atomicAdd(&lc[e0], 1), q1 = atomicAdd(&lc[e1], 1);
                    int* en = lc + 64 + n * 4;
                    en[0] = crow * 2; en[1] = e0; en[2] = q0; ((float*)en)[3] = w0;
                    en[4] = crow * 2 + 1; en[5] = e1; en[6] = q1; ((float*)en)[7] = w1; }
            }
        }
    }
    __syncthreads();
    if (dry) return;
    if (F.tid < 16) lc[16 + F.tid] = (int)atomicAdd(F.ctl + CW_ECNT + (l * 16 + F.tid) * 64, (unsigned)lc[F.tid]);
    __syncthreads();
    int* SLOTE = (int*)(F.ws + WS_ROUTE + RT_SLOTE); int* SLOTP = (int*)(F.ws + WS_ROUTE + RT_SLOTP); float* SLOTW = (float*)(F.ws + WS_ROUTE + RT_SLOTW);
    const int ne = lc[32];
    for (int i = F.tid; i < ne; i += NTHR) { const int* en = lc + 64 + i * 4; const int s = en[0], e = en[1]; SLOTE[s] = e; SLOTP[s] = lc[16 + e] + en[2]; SLOTW[s] = ((const float*)en)[3]; }
    __syncthreads();
}
__device__ __forceinline__ int moe_tables(Frame& F, int l) {
    volatile LAS int* T = (volatile LAS int*)(F.LC + LC_TILE);
    __syncthreads();
    if (F.tid < NEXP) T[184 + F.tid] = (int)__hip_atomic_load(F.ctl + CW_ECNT + (l * 16 + F.tid) * 64, __ATOMIC_RELAXED, __HIP_MEMORY_SCOPE_AGENT);
    __syncthreads();
    if (F.tid < NEXP) {
        int off = 0, nt = 0;
#pragma unroll 1
        for (int e = 0; e < F.tid; ++e) { const int t = (T[184 + e] + 255) >> 8; nt += t; off += t * 256; }
        const int t = (T[184 + F.tid] + 255) >> 8;
        T[160 + F.tid] = off;
#pragma unroll 1
        for (int i = 0; i < t; ++i) T[nt + i] = F.tid;
        if (F.tid == NEXP - 1) { T[176] = off + t * 256; T[180] = nt + t; }
    }
    __syncthreads();
    return T[180];
}
__device__ __forceinline__ void p_gather(Frame& F, int l, int nrows) {
    (void)moe_tables(F, l);
    volatile LAS int* T = (volatile LAS int*)(F.LC + LC_TILE);
    const int gw = opaque_s(F.bid * NWAVES + F.wave), NGW = F.G * NWAVES;
    const int* SLOTE = (const int*)(F.ws + WS_ROUTE + RT_SLOTE); const int* SLOTP = (const int*)(F.ws + WS_ROUTE + RT_SLOTP); const float* SLOTW = (const float*)(F.ws + WS_ROUTE + RT_SLOTW);
    int* SLOTD = (int*)(F.ws + WS_ROUTE + RT_SLOTD); float* WSORT = (float*)(F.ws + WS_ROUTE + RT_WSORT);
    const bf16_t* H = WSP(bf16_t, WS_H); bf16_t* XS = WSP(bf16_t, WS_XS); float* XSS = (float*)(F.ws + WS_ROUTE + RT_XSS); const float* HS2 = (const float*)(F.ws + WS_ROUTE + RT_HS2);
    for (int s0 = gw; s0 < nrows * 2; s0 += 4 * NGW) {
        int e4[4], p4[4]; float w4[4], hs4[4]; u32x4 a4[4], b4[4];
#pragma unroll
        for (int u = 0; u < 4; ++u) { const int s = s0 + u * NGW; const bool ok = s < nrows * 2; e4[u] = ok ? SLOTE[s] : 0; p4[u] = ok ? SLOTP[s] : 0; w4[u] = ok ? SLOTW[s] : 0.f; hs4[u] = ok ? HS2[s >> 1] : 0.f; }
#pragma unroll
        for (int u = 0; u < 4; ++u) { const int s = s0 + u * NGW; if (s < nrows * 2) { const u32x4* src = (const u32x4*)((const unsigned char*)H + (size_t)(s >> 1) * 2048); a4[u] = src[F.lane]; b4[u] = src[64 + F.lane]; } }
#pragma unroll
        for (int u = 0; u < 4; ++u) { const int s = s0 + u * NGW; if (s < nrows * 2) { const int d = T[160 + e4[u]] + p4[u];
            u32x4* dst = (u32x4*)((unsigned char*)XS + (size_t)d * 2048); dst[F.lane] = a4[u]; dst[64 + F.lane] = b4[u];
            if (F.lane == 0) { SLOTD[s] = d; WSORT[d] = w4[u]; XSS[d] = hs4[u]; } } }
    }
    for (int i = F.bid * NTHR + F.tid; i < NEXP * 256; i += F.G * NTHR) { const int e = i >> 8, j = i & 255;
        const int c = T[184 + e]; const int pad = ((c + 255) & ~255) - c;
        if (j < pad) { WSORT[T[160 + e] + c + j] = 0.f; XSS[T[160 + e] + c + j] = 0.f; } }
}

__device__ __forceinline__ void unpack8(const u32x4 w, float* v) { v[0] = bflo(w.x); v[1] = bfhi(w.x); v[2] = bflo(w.y); v[3] = bfhi(w.y); v[4] = bflo(w.z); v[5] = bfhi(w.z); v[6] = bflo(w.w); v[7] = bfhi(w.w); }
__device__ __forceinline__ u32x4 pack8(const float* v) { u32x4 w; w.x = cvt_pk_bf16(v[0], v[1]); w.y = cvt_pk_bf16(v[2], v[3]); w.z = cvt_pk_bf16(v[4], v[5]); w.w = cvt_pk_bf16(v[6], v[7]); return w; }
struct PrepConst { float c0[8], c1[8], c2[8]; };
__device__ __forceinline__ void prep_token(Frame& F, int row, int g, int li, const u32x4 w0, const u32x4 wm, const u32x4 wp, const f32x4 (&tc)[2], const f32x4 (&ts)[2], const PrepConst& K, u32x4& out, bf16_t*& dptr) {
    const bool lat = row < NLAT; const int b = lat ? (row >> 12) : ((row - NLAT) >> 8), t = lat ? (row & 4095) : ((row - NLAT) & 255);
    const int pos = lat ? t : SEQ + t;
    float v[8]; unpack8(w0, v);
    bf16_t* dst;
    if (g < 10 || (g >= 24 && g < 30)) {
        if (g < 10) {
            float s = 0.f;
#pragma unroll
            for (int i = 0; i < 8; ++i) s += v[i] * v[i];
            s += xshfl<1>(s); s += xshfl<2>(s); s += xshfl<4>(s); s += xshfl<8>(s);
            const float r = rsqrtf(s * (1.0f / 128.0f) + EPS);
#pragma unroll
            for (int i = 0; i < 8; ++i) v[i] = v[i] * r * K.c1[i];
        }
        if (lat) {
            const int half = (li >> 2) & 1;
#pragma unroll
            for (int i = 0; i < 8; ++i) { const float o = xshfl<4>(v[i]); const float c = i < 4 ? tc[0][i & 3] : tc[1][i & 3], s = i < 4 ? ts[0][i & 3] : ts[1][i & 3]; v[i] = half ? (v[i] * c + o * s) : (v[i] * c - o * s); }
        }
        if (g < 8) dst = lat ? WSP(bf16_t, WS_QA) + ((size_t)(b * 8 + g) * SEQ + t) * HD : WSP(bf16_t, WS_QAC) + ((size_t)(b * 8 + g) * CTXL + t) * HD;
        else if (g < 10) dst = WSP(bf16_t, WS_KA) + ((size_t)(b * 2 + (g - 8)) * KVL + pos) * HD;
        else if (g < 28) dst = lat ? WSP(bf16_t, WS_QC) + ((size_t)(b * 4 + (g - 24)) * SEQ + t) * HD : WSP(bf16_t, WS_QCC) + ((size_t)(b * 4 + (g - 24)) * CTXL + t) * HD;
        else dst = WSP(bf16_t, WS_KC) + ((size_t)(b * 2 + (g - 28)) * KVL + pos) * HD;
    } else if (g >= 12 && g < 20) {
        const int T = lat ? SEQ : CTXL;
        float vm[8], vp[8]; unpack8(wm, vm); unpack8(wp, vp);
        const float zm = t > 0 ? 1.f : 0.f, zp = t < T - 1 ? 1.f : 0.f;
        const float ksc = (g >= 16) ? 0.088388347648318440f : 1.0f;
#pragma unroll
        for (int i = 0; i < 8; ++i) { const float y = K.c0[i] * vm[i] * zm + K.c1[i] * v[i] + K.c2[i] * vp[i] * zp; v[i] = siluf_(y) * ksc; }
        dst = (g < 16 ? WSP(bf16_t, WS_QM) : WSP(bf16_t, WS_KM)) + ((size_t)(b * 4 + ((g - 12) & 3)) * KVL + pos) * HD;
    } else if (g < 12) dst = WSP(bf16_t, WS_VA) + ((size_t)(b * 2 + (g - 10)) * KVL + pos) * HD;
    else if (g < 24) dst = WSP(bf16_t, WS_VM) + ((size_t)(b * 4 + (g - 20)) * KVL + pos) * HD;
    else dst = WSP(bf16_t, WS_VC) + ((size_t)(b * 2 + (g - 30)) * KVL + pos) * HD;
    out = pack8(v); dptr = dst + li * 8;
}
__device__ __forceinline__ void p_prep(Frame& F, int l) {
    const bf16_t* P1 = WSP(bf16_t, WS_P1);
    const float* ctab = WSP(float, WS_ROPE); const float* stab = ctab + SEQ * 64;
    const int g = F.tid >> 4, li = F.tid & 15, c0 = g * 128 + li * 8;
    const float* qn = inp(F, 9) + l * HD; const float* kn = inp(F, 10) + l * HD; const float* cw = inp(F, 11) + (size_t)l * 3 * 1024;
    const bool conv = (g >= 12 && g < 20), rope = (g < 10) || (g >= 24 && g < 30);
    const bool vgrp = (g == 10 || g == 11 || (g >= 20 && g < 24) || g >= 30);
    PrepConst K;
    const float one_ = __int_as_float(opaque(0x3f800000)), zero_ = __int_as_float(opaque(0));
#pragma unroll
    for (int i = 0; i < 8; ++i) { K.c0[i] = zero_; K.c1[i] = one_; K.c2[i] = zero_; }
    if (g < 10) {
#pragma unroll
        for (int i = 0; i < 8; ++i) K.c1[i] = (g < 8 ? qn : kn)[li * 8 + i] * (g < 8 ? 0.088388347648318440f * 1.4426950408889634f : 1.0f); }
    if (conv) { const int ch = (g - 12) * 128 + li * 8;
#pragma unroll
        for (int i = 0; i < 8; ++i) { K.c0[i] = cw[ch + i]; K.c1[i] = cw[1024 + ch + i]; K.c2[i] = cw[2048 + ch + i]; } }
    const int rax = li >> 3, rf0 = (li & 3) * 8;
    if (!vgrp) for (int r8 = F.bid; r8 < NROW / 8; r8 += F.G) {
        const int row = r8 * 8; const bool lat = row < NLAT; const int t = lat ? (row & 4095) : ((row - NLAT) & 255), T = lat ? SEQ : CTXL;
        const bf16_t* p = P1 + (size_t)row * 4096 + c0;
        u32x4 w[10];
#pragma unroll
        for (int q = 0; q < 8; ++q) w[1 + q] = *(const u32x4*)(p + (size_t)q * 4096);
        w[0] = w[1]; w[9] = w[8];
        if (conv) { if (t > 0) w[0] = *(const u32x4*)(p - 4096); if (t + 8 < T) w[9] = *(const u32x4*)(p + (size_t)8 * 4096); }
        f32x4 tc[4][2], ts[4][2]; u32x4 o4[4]; bf16_t* d4[4];
#define PREP_ROPE(q0) do { _Pragma("unroll") for (int q = 0; q < 4; ++q) { tc[q][0] = tc[q][1] = ts[q][0] = ts[q][1] = (f32x4){0.f, 0.f, 0.f, 0.f}; }                                     \
        if (rope && lat) { _Pragma("unroll") for (int q = 0; q < 4; ++q) { const float* cp = ctab + (size_t)(t + (q0) + q) * 64 + rax * 32 + rf0; const float* sp = stab + (size_t)(t + (q0) + q) * 64 + rax * 32 + rf0; \
            tc[q][0] = *(const f32x4*)cp; tc[q][1] = *(const f32x4*)(cp + 4); ts[q][0] = *(const f32x4*)sp; ts[q][1] = *(const f32x4*)(sp + 4); } } } while (0)
        PREP_ROPE(0);
#pragma unroll
        for (int q = 0; q < 4; ++q) prep_token(F, row + q, g, li, w[1 + q], w[q], w[2 + q], tc[q], ts[q], K, o4[q], d4[q]);
        PREP_ROPE(4);
#pragma unroll
        for (int q = 0; q < 4; ++q) *(u32x4*)d4[q] = o4[q];
#pragma unroll
        for (int q = 0; q < 4; ++q) prep_token(F, row + 4 + q, g, li, w[5 + q], w[4 + q], w[6 + q], tc[q], ts[q], K, o4[q], d4[q]);
#pragma unroll
        for (int q = 0; q < 4; ++q) *(u32x4*)d4[q] = o4[q];
#undef PREP_ROPE
    }
    const float* GRAW = WSP(float, WS_GRAW); float* GI = WSP(float, WS_GATE); float* GF = GI + NB * 2 * 4 * KVL;
    const float* igb = inp(F, 12) + l * 8; const float* fgb = inp(F, 13) + l * 8;
    for (int i = F.bid * NTHR + F.tid; i < NROW * 8; i += F.G * NTHR) {
        const int row = i >> 3, dh = i & 7; const bool lat = row < NLAT; const int b = lat ? (row >> 12) : ((row - NLAT) >> 8), pos = lat ? (row & 4095) : SEQ + ((row - NLAT) & 255);
        const float gi = GRAW[(size_t)row * 16 + dh] + igb[dh]; const float xf = GRAW[(size_t)row * 16 + 8 + dh] + fgb[dh];
        const float lf = fminf(xf, 0.f) - log1pf(__expf(-fabsf(xf)));
        GI[(size_t)(b * 8 + dh) * KVL + pos] = gi; GF[(size_t)(b * 8 + dh) * KVL + pos] = lf;
    }
}
__device__ __forceinline__ void p_omprep(Frame& F, int l, int nrows) {
    const float* HM = WSP(float, WS_HM); const bf16_t* MO = WSP(bf16_t, WS_MO); bf16_t* OALL = WSP(bf16_t, WS_OALL);
    const float* mg = inp(F, 14) + l * 512;
    const int li = F.tid & 15;
    const int it0 = F.bid * 32 + (F.tid >> 4), h = it0 & 3, IS = F.G * 32;
    float mgv[8];
#pragma unroll
    for (int i = 0; i < 8; ++i) mgv[i] = mg[h * 128 + li * 8 + i];
    for (int it = it0; it < nrows * 4; it += 4 * IS) {
        f32x4 a0[4], a1[4], b0[4], b1[4]; u32x4 gw4[4];
#pragma unroll
        for (int u = 0; u < 4; ++u) { const int itu = it + u * IS; if (itu < nrows * 4) {
            const int row = itu >> 2; const size_t o = (size_t)row * 512 + h * 128 + li * 8;
            const bool lat = row < NLAT; const int b = lat ? (row >> 12) : ((row - NLAT) >> 8), t = lat ? (row & 4095) : ((row - NLAT) & 255);
            const int p0 = lat ? CTXL + t : t, p1 = lat ? CTXL + (SEQ - 1 - t) : (CTXL - 1 - t);
            const float* h0 = HM + ((size_t)((0 * 4 + b) * 4 + h) * KVL + p0) * HD + li * 8; const float* h1 = HM + ((size_t)((1 * 4 + b) * 4 + h) * KVL + p1) * HD + li * 8;
            a0[u] = *(const f32x4*)(h0); a1[u] = *(const f32x4*)(h0 + 4); b0[u] = *(const f32x4*)(h1); b1[u] = *(const f32x4*)(h1 + 4); gw4[u] = *(const u32x4*)(MO + o); } }
#pragma unroll
        for (int u = 0; u < 4; ++u) { const int itu = it + u * IS; if (itu < nrows * 4) { const int row = itu >> 2;
            float v[8] = {a0[u][0] + b0[u][0], a0[u][1] + b0[u][1], a0[u][2] + b0[u][2], a0[u][3] + b0[u][3], a1[u][0] + b1[u][0], a1[u][1] + b1[u][1], a1[u][2] + b1[u][2], a1[u][3] + b1[u][3]};
            float s = 0.f;
#pragma unroll
            for (int i = 0; i < 8; ++i) s += v[i] * v[i];
            s += xshfl<1>(s); s += xshfl<2>(s); s += xshfl<4>(s); s += xshfl<8>(s);
            const float r = rsqrtf(s * (1.0f / 128.0f) + EPS);
            float gt[8]; unpack8(gw4[u], gt);
#pragma unroll
            for (int i = 0; i < 8; ++i) v[i] = v[i] * r * mgv[i] * gt[i];
            *(u32x4*)(OALL + (size_t)row * DM + 1024 + h * 128 + li * 8) = pack8(v); } }
    }
}
__device__ __forceinline__ int mixer_pop(Frame& F, int l, int kind, int x, int rep = 0) {
    __syncthreads();
    if (F.tid == 0) F.LC[LC_Q] = atomicAdd(F.ctl + CW_QCTR + ((l * 4 + kind) * 8 + x) * 64 + rep * 32768, 1u);
    __syncthreads();
    return (int)F.LC[LC_Q];
}
constexpr int LC_QS = 48;
__device__ __forceinline__ void mixer_snapshot(Frame& F, int l, int kind, int rep) {
    __syncthreads();
    if (F.tid < 8) F.LC[LC_QS + F.tid] = __hip_atomic_load(F.ctl + CW_QCTR + ((l * 4 + kind) * 8 + F.tid) * 64 + rep * 32768, __ATOMIC_RELAXED, __HIP_MEMORY_SCOPE_AGENT);
    __syncthreads();
}
__device__ __forceinline__ void p_mixers(Frame& F, int l, int rep = 0) {
    const int x0 = (int)(xb_xcc_id() & 7u);
    bf16_t* OALL = WSP(bf16_t, WS_OALL);
    LAS char* lds = (LAS char*)F.lds3;
#ifndef MIX_EN
#define MIX_EN 7
#endif
    mixer_snapshot(F, l, 0, rep);
    if (MIX_EN & 1) for (int dx = 0; dx < 8; ++dx) { const int x = (x0 + dx) & 7, b = x >> 1, kvh = x & 1; if ((int)F.LC[LC_QS + x] >= 4) continue;
        for (;;) { const int u = mixer_pop(F, l, 0, x, rep); if (u >= 4) break;
            const int h = kvh * 2 + (u >> 1), dir = u & 1, seq = (b * 4 + h) * 2 + dir;
            ml::ScanArgs a; const size_t ho = (size_t)(b * 4 + h) * KVL * HD;
            a.K = WSP(bf16_t, WS_KM) + ho; a.V = WSP(bf16_t, WS_VM) + ho;
            a.GI = WSP(float, WS_GATE) + (size_t)((b * 2 + dir) * 4 + h) * KVL; a.GF = a.GI + (size_t)NB * 8 * KVL;
            a.CIMG = F.ws + WS_CIMG + (size_t)seq * 34 * 32768; a.NST = WSP(float, WS_NST) + (size_t)seq * 34 * 128; a.GT = WSP(float, WS_GT) + (size_t)seq * 34 * 512;
            a.prog = F.ctl + CW_PROG + (l * 32 + seq) * 64 + rep * 32768; a.dir = dir;
            ml::mlstm_scan(a, lds, F.wave);
#ifdef REP_SCAN
            ml::mlstm_scan(a, lds, F.wave);
#endif
        }
        mixer_snapshot(F, l, 0, rep); }
    const int nu1 = (l == 0) ? 68 : 64;
    float bnd;
    { const float* gq = inp(F, 9) + l * HD; const float* gk = inp(F, 10) + l * HD; float mq = 0.f, mk = 0.f;
      for (int i = 0; i < HD; ++i) { mq = fmaxf(mq, fabsf(gq[i])); mk = fmaxf(mk, fabsf(gk[i])); }
      bnd = (128.0f * mq * mk * 1.0001f + 1e-3f) * (0.088388347648318440f * 1.4426950408889634f); }
    mixer_snapshot(F, l, 1, rep);
    if (MIX_EN & 2) for (int dx = 0; dx < 8; ++dx) { const int x = (x0 + dx) & 7, b = x >> 1, kvh = x & 1; if ((int)F.LC[LC_QS + x] >= nu1) continue;
        for (;;) { const int u = mixer_pop(F, l, 1, x, rep); if (u >= nu1) break;
            att::Args a; a.ldo = DM; a.base1 = 0; a.qpos0 = 0;
            a.K = WSP(bf16_t, WS_KA) + (size_t)(b * 2 + kvh) * KVL * HD; a.V = WSP(bf16_t, WS_VA) + (size_t)(b * 2 + kvh) * KVL * HD; a.m_init = bnd; a.l_init = 0.f;
            if (u < 64) { const int h = kvh * 4 + (u >> 4), qb = u & 15; a.Q = WSP(bf16_t, WS_QA) + ((size_t)(b * 8 + h) * SEQ + qb * 256) * HD;
                a.O = OALL + (size_t)(b * SEQ + qb * 256) * DM + h * 128; a.n0 = 68; a.base0 = 0; a.NT = 68; }
            else { const int h = kvh * 4 + (u - 64); a.Q = WSP(bf16_t, WS_QAC) + (size_t)(b * 8 + h) * CTXL * HD;
                a.O = OALL + (size_t)(NLAT + b * CTXL) * DM + h * 128; a.n0 = 4; a.base0 = SEQ; a.NT = 4; }
            att::attn_body_dma(a, lds, F.wave);
#ifdef REP_ATT
            att::attn_body_dma(a, lds, F.wave);
#endif
        }
        mixer_snapshot(F, l, 1, rep); }
    const int nu2 = (l == 0) ? 34 : 32;
    mixer_snapshot(F, l, 2, rep);
    if (MIX_EN & 4) for (int dx = 0; dx < 8; ++dx) { const int x = (x0 + dx) & 7, b = x >> 1, kvh = x & 1; if ((int)F.LC[LC_QS + x] >= nu2) continue;
        for (;;) { const int u = mixer_pop(F, l, 2, x, rep); if (u >= nu2) break;
            att::Args a; a.ldo = DM; a.base1 = SEQ;
            a.K = WSP(bf16_t, WS_KC) + (size_t)(b * 2 + kvh) * KVL * HD; a.V = WSP(bf16_t, WS_VC) + (size_t)(b * 2 + kvh) * KVL * HD;
            if (u < 32) { const int h = kvh * 2 + (u >> 4), qb = u & 15;
                const int w0 = qb == 0 ? 0 : qb * 256 - 128, w1 = qb == 15 ? SEQ : qb * 256 + 384;
                a.Q = WSP(bf16_t, WS_QC) + ((size_t)(b * 4 + h) * SEQ + qb * 256) * HD;
                a.O = OALL + (size_t)(b * SEQ + qb * 256) * DM + 1536 + h * 128; a.n0 = (w1 - w0) >> 6; a.base0 = w0; a.NT = a.n0 + 4; a.qpos0 = qb * 256;
                a.m_init = inp(F, 15)[l * 4 + h] * (1.0f / att::SCALE); }
            else { const int h = kvh * 2 + (u - 32); a.Q = WSP(bf16_t, WS_QCC) + (size_t)(b * 4 + h) * CTXL * HD;
                a.O = OALL + (size_t)(NLAT + b * CTXL) * DM + 1536 + h * 128; a.n0 = 0; a.base0 = 0; a.NT = 4; a.qpos0 = 0;
                a.m_init = inp(F, 15)[l * 4 + h] * (1.0f / att::SCALE); }
            a.l_init = 1.f;
            att::attn_body<true, false>(a, lds, F.wave);
#ifdef REP_ATC
            att::attn_body<true, false>(a, lds, F.wave);
#endif
        }
        mixer_snapshot(F, l, 2, rep); }
    const int nco = (l == 0) ? 34 : 32;
    mixer_snapshot(F, l, 3, rep);
    if (MIX_EN & 1) for (int dx = 0; dx < 8; ++dx) { const int x = (x0 + dx) & 7, b = x >> 1, kvh = x & 1; if ((int)F.LC[LC_QS + x] >= 4 * nco) continue;
        for (;;) { const int u = mixer_pop(F, l, 3, x, rep); if (u >= 4 * nco) break;
            const int sl = u / nco, c = (34 - nco) + u % nco, h = kvh * 2 + (sl >> 1), dir = sl & 1, seq = (b * 4 + h) * 2 + dir;
            ml::OutArgs a; const size_t ho = (size_t)(b * 4 + h) * KVL * HD;
            a.Q = WSP(bf16_t, WS_QM) + ho; a.K = WSP(bf16_t, WS_KM) + ho; a.V = WSP(bf16_t, WS_VM) + ho;
            a.CIMG = F.ws + WS_CIMG + ((size_t)seq * 34 + c) * 32768; a.NST = WSP(float, WS_NST) + ((size_t)seq * 34 + c) * 128; a.GT = WSP(float, WS_GT) + ((size_t)seq * 34 + c) * 512;
            a.HM = WSP(float, WS_HM) + (size_t)((dir * 4 + b) * 4 + h) * KVL * HD; a.prog = F.ctl + CW_PROG + (l * 32 + seq) * 64 + rep * 32768; a.dir = dir; a.c = c;
            ml::mlstm_out(a, lds, F.wave);
#ifdef REP_MOUT
            ml::mlstm_out(a, lds, F.wave);
#endif
        }
        mixer_snapshot(F, l, 3, rep); }
}

__device__ __forceinline__ bool ph_in(int lo, int hi, int k) { asm volatile("" : "+s"(lo), "+s"(hi)); return lo <= k && k < hi; }
constexpr int PH_PRE = 0, PH_MODR = 1, PH_L0 = 2, PH_PER_LAYER = 11, PH_FINAL = PH_L0 + 2 * PH_PER_LAYER, N_PHASES = PH_FINAL + 1;
struct Params { const float* in[28]; float* out; unsigned char* ws; int ph_lo, ph_hi; };
__global__ void __launch_bounds__(NTHR, 2) fwd(Params p) {
    extern __shared__ __attribute__((aligned(16))) unsigned char lds[];
    Frame F;
    F.lds = (char*)lds; F.lds3 = (LAS unsigned char*)lds; F.LC = (volatile LAS unsigned*)((LAS unsigned char*)lds + LDSCTL_OFF);
    F.wave = __builtin_amdgcn_readfirstlane((int)threadIdx.x >> 6); F.tid = tid_of(F.wave); F.lane = F.tid & 63; F.G = gridDim.x; F.bid = blockIdx.x;
    F.karg = (const float* const __attribute__((address_space(4)))*)__builtin_amdgcn_kernarg_segment_ptr();
    F.ws = wsp_(F); F.ctl = (unsigned*)(F.ws + WS_CTL);
    for (int u = F.tid; u < (LDS_BYTES - LDSCTL_OFF) / 4; u += NTHR) F.LC[u] = 0u;
    __syncthreads();
    const int lo = p.ph_lo, hi = p.ph_hi;
    XcdBarrier bar; bar.bar = F.ctl + CW_BAR; bar.x = 0; bar.st = nullptr;
    if (hi - lo > 1) bar = xcd_barrier_post(F.ctl + CW_BAR, F.LC + LC_BAR, F.tid);
#ifndef PH_ENABLE
#define PH_ENABLE 0xFFFF
#endif
#define EN(kind) ((PH_ENABLE >> (kind)) & 1)
#define IN(k) ph_in(lo, hi, (k))
#ifndef PROBE_A
#define PROBE_A 0
#endif
#ifndef PROBE_B
#define PROBE_B 0
#endif
#define PROBE ((PROBE_A) | (PROBE_B))
#define TS(kind) do { if (PROBE && F.bid == 0 && F.tid == 0) { const unsigned t_ = (unsigned)__builtin_amdgcn_s_memrealtime(); F.LC[32 + (kind)] += t_ - F.LC[31]; F.LC[31] = t_; } } while (0)
#define PB() do { F.tid = tid_of(F.wave); F.lane = F.tid & 63; F.ws = wsp_(F); } while (0)
#ifdef REP_SEAM
#define SEAM(k) do { if (IN(k) && IN((k) + 1)) { xcd_barrier(bar, tid_of(F.wave)); xcd_barrier(bar, tid_of(F.wave)); xcd_barrier(bar, tid_of(F.wave)); } } while (0)
#else
#define SEAM(k) do { if (IN(k) && IN((k) + 1)) xcd_barrier(bar, tid_of(F.wave)); } while (0)
#endif
    LAS unsigned char* ring = (LAS unsigned char*)lds;
    if (PROBE && F.bid == 0 && F.tid == 0) F.LC[31] = (unsigned)__builtin_amdgcn_s_memrealtime();

    if (EN(0) && IN(PH_PRE)) { PB(); p_mod_partial(F); p_rope_tables(F); p_convert_weights(F, 0, 0); p_convert_i8(F, 0);
#ifdef POISON_ML
        for (size_t i = (size_t)F.bid * NTHR + F.tid; i < (WS_END - WS_CIMG) / 16; i += (size_t)F.G * NTHR) ((u32x4*)(F.ws + WS_CIMG))[i] = (u32x4){0xFFFFFFFFu, 0xFFFFFFFFu, 0xFFFFFFFFu, 0xFFFFFFFFu};
#endif
#ifdef REP_PRE
        p_mod_partial(F); p_rope_tables(F); p_convert_weights(F, 0, 0);
#endif
#ifdef REP_I8
        p_convert_i8(F, 0);
#endif
    } SEAM(PH_PRE); TS(0);
    if (EN(1) && IN(PH_MODR)) { PB(); p_mod_reduce(F); } SEAM(PH_MODR); TS(1);
#pragma unroll 1
    for (int l = 0; l < 2; ++l) {
        const int P = PH_L0 + l * PH_PER_LAYER;
        const int mrows = (l == 0) ? NROW : NLAT;
        if (EN(2) && IN(P + 0)) { PB(); if (l > 0) { p_convert_weights(F, l, 0); p_convert_i8(F, l); }
            p_norm1(F, l);
#ifdef REP_N1
            if (l == 0) p_norm1(F, l);
#endif
        } SEAM(P + 0); TS(2);
        if (EN(3) && IN(P + 1)) { PB();
            int n_i8 = 0;
            {
                pg8::Gemm g{WSP(bf16_t, WS_H8), WSP(bf16_t, WS_WIN) + (size_t)4608 * DM, 0, 0, DM / 2}; pg8::GateOrder S; S.init(l, F.G, F.bid); n_i8 = S.count();
                pg8::EpiGateI8 E{F.ws + WS_G, WSP(float, WS_HS), WSP(float, WS_WS8) + l * 11008, WSP(bf16_t, WS_P1), WSP(bf16_t, WS_MO), F.ws};
                pg8::gemm_phase<pg8::EpiGateI8, pg8::GateOrder>(ring, g, S, E, F.wave);
#ifdef REP_GATE
                if (l == 0) { S.fold = REP_GATE; pg8::gemm_phase<pg8::EpiGateI8, pg8::GateOrder>(ring, g, S, E, F.wave); }
#endif
            }
        } SEAM(P + 1); TS(3);
        if (EN(4) && IN(P + 2)) { PB(); p_prep(F, l);
#ifdef REP_PREP
            p_prep(F, l);
#endif
        } SEAM(P + 2); TS(4);
        if (EN(5) && IN(P + 3)) { PB(); p_mixers(F, l);
#ifdef REP_MIX
            xcd_barrier(bar, tid_of(F.wave)); p_mixers(F, l, 1);
#endif
        } SEAM(P + 3); TS(5);
        if (EN(6) && IN(P + 4)) { PB(); p_omprep(F, l, mrows);
#ifdef REP_OMP
            p_omprep(F, l, mrows);
#endif
        } SEAM(P + 4); TS(6);
        if (EN(7) && IN(P + 5)) { PB(); pg8::Gemm g{WSP(bf16_t, WS_OALL), WSP(bf16_t, WS_WBR), mrows, DM, DM}; pg8::HalfOrder S; S.init(l == 0 ? 64 : 0, F.G, F.bid);
            pg8::EpiBranch E{F.ws + WS_G, WSP(bf16_t, WS_Y)};
            pg8::gemm_phase<pg8::EpiBranch, pg8::HalfOrder>(ring, g, S, E, F.wave);
#ifdef REP_BR
            if (l == 0) pg8::gemm_phase<pg8::EpiBranch, pg8::HalfOrder>(ring, g, S, E, F.wave);
#endif
        } SEAM(P + 5); TS(7);
        if (EN(8) && IN(P + 6)) { PB(); pg8::Gemm g{WSP(bf16_t, WS_Y), WSP(bf16_t, WS_WOUT), mrows, DM, DM}; pg8::HalfOrder S; S.init(l == 0 ? 64 : 0, F.G, F.bid);
            pg8::EpiOut E{F.karg, WSP(float, WS_MOD) + (size_t)l * 5 * 12288, l == 0 ? 1 : 0};
            pg8::gemm_phase<pg8::EpiOut, pg8::HalfOrder>(ring, g, S, E, F.wave);
#ifdef REP_OUT
            if (l == 0) pg8::gemm_phase<pg8::EpiOut, pg8::HalfOrder>(ring, g, S, E, F.wave);
#endif
        } SEAM(P + 6); TS(8);
        if (EN(9) && IN(P + 7)) { PB();
#ifdef REP_N2
            p_norm2_route(F, l, mrows, true);
#endif
            p_norm2_route(F, l, mrows); } SEAM(P + 7); TS(9);
        if (EN(10) && IN(P + 8)) { PB(); p_gather(F, l, mrows);
#ifdef REP_GATHER
            p_gather(F, l, mrows);
#endif
        } SEAM(P + 8); TS(10);
        if (EN(11) && IN(P + 9)) { PB(); const int ntl = moe_tables(F, l);
            pg8::Gemm g{WSP(bf16_t, WS_XS), WSP(bf16_t, WS_WGU), 0, 0, DM / 2}; pg8::MoeOrder S{ntl, 4, F.G, F.bid, (const LAS int*)(F.LC + LC_TILE)};
            pg8::EpiMoe1I8 E{WSP(bf16_t, WS_MID), (const float*)(F.ws + WS_ROUTE + RT_WSORT), (const float*)(F.ws + WS_ROUTE + RT_XSS), (const float*)(F.ws + WS_ROUTE + RT_WGS) + l * 16384};
            pg8::gemm_phase<pg8::EpiMoe1I8, pg8::MoeOrder>(ring, g, S, E, F.wave);
#ifdef REP_G1
            if (l == 0) pg8::gemm_phase<pg8::EpiMoe1I8, pg8::MoeOrder>(ring, g, S, E, F.wave);
#endif
        } SEAM(P + 9); TS(11);
        if (EN(12) && IN(P + 10)) { PB(); const int ntl = moe_tables(F, l);
            pg8::Gemm g{WSP(bf16_t, WS_MID), WSP(bf16_t, WS_WD), 0, 0, DFF}; pg8::MoeOrder S{ntl, 8, F.G, F.bid, (const LAS int*)(F.LC + LC_TILE)};
            pg8::EpiMoe2 E{WSP(bf16_t, WS_MOEOUT)};
            pg8::gemm_phase<pg8::EpiMoe2, pg8::MoeOrder>(ring, g, S, E, F.wave);
#ifdef REP_G2
            if (l == 0) pg8::gemm_phase<pg8::EpiMoe2, pg8::MoeOrder>(ring, g, S, E, F.wave);
#endif
        } SEAM(P + 10); TS(12);
    }
    if (PROBE) {
        if (F.bid == 0 && F.tid == 0) { unsigned a = 0, b = 0;
            for (int k = 0; k < 14; ++k) { if ((PROBE_A >> k) & 1) a += F.LC[32 + k]; if ((PROBE_B >> k) & 1) b += F.LC[32 + k]; }
            __hip_atomic_store(F.ctl + 64, a, __ATOMIC_RELAXED, __HIP_MEMORY_SCOPE_AGENT); __hip_atomic_store(F.ctl + 65, b, __ATOMIC_RELAXED, __HIP_MEMORY_SCOPE_AGENT); }
        xcd_barrier(bar, tid_of(F.wave));
        const float ta = (float)__hip_atomic_load(F.ctl + 64, __ATOMIC_RELAXED, __HIP_MEMORY_SCOPE_AGENT) * 0.01f, tb = (float)__hip_atomic_load(F.ctl + 65, __ATOMIC_RELAXED, __HIP_MEMORY_SCOPE_AGENT) * 0.01f;
        float* o_ = outp(F); const float V = 1000.f, W = 1000.f + (ta + tb) * 100.f;
        for (size_t i = (size_t)F.bid * NTHR + F.tid; i < (size_t)NLAT * DM; i += (size_t)F.G * NTHR) o_[i] = (i == 0) ? W : V;
    } else if (EN(13) && IN(PH_FINAL)) { PB(); p_final(F);
#ifdef REP_FINAL
        p_final(F);
#endif
    }
#undef IN
#undef SEAM
}

extern "C" void kernel_launch(void* const* d_in, const int* in_sizes, int n_in, void* d_out, int out_size, void* d_ws, size_t ws_size, hipStream_t stream) {
    static int grid = 0;
    if (grid == 0) {
        if (n_in != 28 || out_size != NLAT * DM || ws_size < WS_END) { fprintf(stderr, "kernel_launch: unexpected shapes (n_in %d, out %d, ws %zu < %zu)\n", n_in, out_size, ws_size, (size_t)WS_END); grid = -1; return; }
        int dev = 0, cus = 0, per_cu = 0;
        if (hipGetDevice(&dev) != hipSuccess || hipDeviceGetAttribute(&cus, hipDeviceAttributeMultiprocessorCount, dev) != hipSuccess) { grid = -1; return; }
        if (hipFuncSetAttribute((const void*)fwd, hipFuncAttributeMaxDynamicSharedMemorySize, LDS_BYTES) != hipSuccess) { fprintf(stderr, "kernel_launch: hipFuncSetAttribute failed\n"); grid = -1; return; }
        if (hipOccupancyMaxActiveBlocksPerMultiprocessor(&per_cu, (const void*)fwd, NTHR, LDS_BYTES) != hipSuccess || per_cu < 1) { fprintf(stderr, "kernel_launch: occupancy query says %d\n", per_cu); (void)hipGetLastError(); grid = -1; return; }
        grid = cus;
    }
    if (grid < 0) return;
    (void)hipMemsetAsync((char*)d_ws + WS_CTL, 0, CTL_ZERO_BYTES, stream);
    Params p{};
    for (int i = 0; i < 28; ++i) p.in[i] = (const float*)d_in[i];
    p.out = (float*)d_out; p.ws = (unsigned char*)d_ws;
#if MK_PER_PHASE
    for (int k = 0; k < N_PHASES; ++k) { p.ph_lo = k; p.ph_hi = k + 1; hipLaunchKernelGGL(fwd, dim3(grid), dim3(NTHR), LDS_BYTES, stream, p); }
#else
    p.ph_lo = 0; p.ph_hi = N_PHASES; hipLaunchKernelGGL(fwd, dim3(grid), dim3(NTHR), LDS_BYTES, stream, p);
#endif
}
```

```cpp
#include <hip/hip_runtime.h>
#include <cstdio>
#include <cstdint>

#ifndef MK_PER_PHASE
#define MK_PER_PHASE 0
#endif

#define GAS __attribute__((address_space(1)))
#define LAS __attribute__((address_space(3)))
typedef unsigned short bf16_t;
typedef short bf16x8 __attribute__((ext_vector_type(8)));
typedef short s16x4 __attribute__((ext_vector_type(4)));
typedef float f32x2 __attribute__((ext_vector_type(2)));
typedef float f32x4 __attribute__((ext_vector_type(4)));
typedef float f32x8 __attribute__((ext_vector_type(8)));
typedef float f32x16 __attribute__((ext_vector_type(16)));
typedef unsigned u32x2 __attribute__((ext_vector_type(2)));
typedef unsigned u32x4 __attribute__((ext_vector_type(4)));

constexpr int DM = 2048, NB = 4, SEQ = 4096, CTXL = 256, HD = 128;
constexpr int NLAT = NB * SEQ, NCTX = NB * CTXL, NROW = NLAT + NCTX;
constexpr int KVL = SEQ + CTXL;
constexpr int PIN = 10768, NPIN = 11008;
constexpr int NEXP = 16, DFF = 512;
constexpr int MOE_TILES_MAX = 152, MOE_ROWS_MAX = MOE_TILES_MAX * 256;
constexpr float EPS = 1e-6f;
constexpr int NWAVES = 8, NTHR = 512;

constexpr size_t MiB = 1u << 20;
constexpr size_t WS_CTL = 0, CTL_ZERO_BYTES = 1 * MiB;
constexpr size_t WS_MOD = 1 * MiB;
constexpr size_t WS_ROPE = 2 * MiB;
constexpr size_t WS_MODP = 4 * MiB;
constexpr size_t WS_ROUTE = 12 * MiB;
constexpr size_t WS_GRAW = 14 * MiB;
constexpr size_t WS_GATE = 16 * MiB;
constexpr size_t WS_WIN = 20 * MiB;
constexpr size_t WS_WBR = 63 * MiB;
constexpr size_t WS_WOUT = 71 * MiB;
constexpr size_t WS_WGU = 79 * MiB;
constexpr size_t WS_WD = 143 * MiB;
constexpr size_t WS_XL = 175 * MiB;
constexpr size_t WS_XC = 303 * MiB;
constexpr size_t WS_H = 311 * MiB;
constexpr size_t WS_MO = 379 * MiB;
constexpr size_t WS_P1 = 396 * MiB;
constexpr size_t WS_G = 532 * MiB;
constexpr size_t WS_OALL = 396 * MiB;
constexpr size_t WS_HM = 464 * MiB;
constexpr size_t WS_XS = 396 * MiB;
constexpr size_t WS_MID = 548 * MiB;
constexpr size_t WS_MOEOUT = 586 * MiB;
constexpr size_t WS_QA = 738 * MiB;
constexpr size_t WS_QAC = 770 * MiB;
constexpr size_t WS_KA = 772 * MiB;
constexpr size_t WS_VA = 781 * MiB;
constexpr size_t WS_QC = 790 * MiB;
constexpr size_t WS_QCC = 806 * MiB;
constexpr size_t WS_KC = 807 * MiB;
constexpr size_t WS_VC = 816 * MiB;
constexpr size_t WS_QM = 825 * MiB;
constexpr size_t WS_KM = 842 * MiB;
constexpr size_t WS_VM = 859 * MiB;
constexpr size_t WS_Y = 738 * MiB;
constexpr size_t WS_H8 = 876 * MiB;
constexpr size_t WS_HS = 16 * MiB + 1280 * 1024;
constexpr size_t WS_WS8 = 16 * MiB + 1408 * 1024;
constexpr size_t WS_CIMG = 876 * MiB;
constexpr size_t WS_NST = 912 * MiB;
constexpr size_t WS_GT = 913 * MiB;
constexpr size_t WS_END = 916 * MiB;

constexpr int CW_BAR = 4096;
constexpr int CW_QCTR = 8192;
constexpr int CW_ECNT = 12288;
constexpr int CW_WMAX = 65536;
constexpr int CW_WMAX2 = 98304;
constexpr int CW_PROG = 16384;
constexpr size_t RT_SLOTE = 0;
constexpr size_t RT_SLOTP = 160 * 1024;
constexpr size_t RT_SLOTW = 320 * 1024;
constexpr size_t RT_SLOTD = 480 * 1024;
constexpr size_t RT_WSORT = 640 * 1024;
constexpr size_t RT_XSS = 800 * 1024;
constexpr size_t RT_HS2 = 960 * 1024;
constexpr size_t RT_WRT = 1280 * 1024;
constexpr size_t RT_WGS = 1040 * 1024;

constexpr int RING_BYTES = 131072;
constexpr int ML_SM = 131072;
constexpr int LDSCTL_OFF = 143360;
constexpr int LDS_BYTES = 147456;
constexpr int LC_BAR = 8;
constexpr int LC_Q = 16;
constexpr int LC_TILE = 64;

__device__ __forceinline__ float bflo(unsigned w) { return __uint_as_float(w << 16); }
__device__ __forceinline__ float bfhi(unsigned w) { return __uint_as_float(w & 0xffff0000u); }
typedef __bf16 bf16x2_t __attribute__((ext_vector_type(2)));
__device__ __forceinline__ unsigned cvt_pk_bf16(float lo, float hi) { const f32x2 v = {lo, hi}; return __builtin_bit_cast(unsigned, __builtin_convertvector(v, bf16x2_t)); }
template <int O> __device__ __forceinline__ float xshfl(float v) {
    if constexpr (O < 32) return __int_as_float(__builtin_amdgcn_ds_swizzle(__float_as_int(v), (O << 10) | 0x1f));
    else { auto rr = __builtin_amdgcn_permlane32_swap(__float_as_uint(v), __float_as_uint(v), false, false); return __uint_as_float(rr[0]) == v ? __uint_as_float(rr[1]) : __uint_as_float(rr[0]); }
}
__device__ __forceinline__ float wave_sum(float v) {
    v += xshfl<1>(v); v += xshfl<2>(v); v += xshfl<4>(v); v += xshfl<8>(v); v += xshfl<16>(v);
    { auto rr = __builtin_amdgcn_permlane32_swap(__float_as_uint(v), __float_as_uint(v), false, false); v = __uint_as_float(rr[0]) + __uint_as_float(rr[1]); }
    return v;
}
__device__ __forceinline__ float wave_max(float v) {
    v = fmaxf(v, xshfl<1>(v)); v = fmaxf(v, xshfl<2>(v)); v = fmaxf(v, xshfl<4>(v)); v = fmaxf(v, xshfl<8>(v)); v = fmaxf(v, xshfl<16>(v));
    { auto rr = __builtin_amdgcn_permlane32_swap(__float_as_uint(v), __float_as_uint(v), false, false); v = fmaxf(__uint_as_float(rr[0]), __uint_as_float(rr[1])); }
    return v;
}
__device__ __forceinline__ float sigmoidf_(float x) { return __builtin_amdgcn_rcpf(1.0f + __expf(-x)); }
__device__ __forceinline__ float siluf_(float x) { return x * sigmoidf_(x); }
__device__ __forceinline__ int opaque_s(int x) { asm volatile("" : "+s"(x)); return x; }
__device__ __forceinline__ int opaque(int x) { asm volatile("" : "+v"(x)); return x; }
__device__ __forceinline__ int tid_of(int wave) { int l; asm volatile("v_mbcnt_lo_u32_b32 %0, -1, 0\n\tv_mbcnt_hi_u32_b32 %0, -1, %0" : "=v"(l)); return wave * 64 + l; }
#define LDS_WAIT() asm volatile("s_waitcnt lgkmcnt(0)" ::: "memory")
#define VM_WAIT() asm volatile("s_waitcnt vmcnt(0)" ::: "memory")

#define XB_TMO      128
#define XB_XCNT(j)  (256  + 64 * (j))
#define XB_XSUB(j)  (1280 + 64 * (j))
#define XB_XGEN(j)  (2304 + 64 * (j))
#define XB_TOP      3328
#define XB_TOPGEN   3392
#define XCD_BAR_WORDS 3456
#define XB_SPIN_CAP (1u << 18)
__device__ __forceinline__ unsigned xb_ld(unsigned* p)              { return __hip_atomic_load(p, __ATOMIC_RELAXED, __HIP_MEMORY_SCOPE_AGENT); }
__device__ __forceinline__ unsigned xb_add(unsigned* p, unsigned v) { return __hip_atomic_fetch_add(p, v, __ATOMIC_RELAXED, __HIP_MEMORY_SCOPE_AGENT); }
__device__ __forceinline__ unsigned xb_xcc_id() { return (unsigned)__builtin_amdgcn_s_getreg((3 << 11) | 20) & 0xFu; }
#define XB_SPIN(cond, bar) do { unsigned _sp = 0; while (cond) { __builtin_amdgcn_s_sleep(1); \
    if ((++_sp & 255u) == 0u) { if (xb_ld(&(bar)[XB_TMO])) break; if (_sp > XB_SPIN_CAP) { atomicAdd(&(bar)[XB_TMO], 1u); break; } } } } while (0)
struct XcdBarrier { unsigned* bar; unsigned x; volatile LAS unsigned* st; };
__device__ __forceinline__ XcdBarrier xcd_barrier_post(unsigned* bar, volatile LAS unsigned* st, int tid) {
    XcdBarrier b; b.bar = bar; b.x = xb_xcc_id(); b.st = st;
    if (tid == 0) (void)xb_add(&bar[XB_XCNT(b.x)], 1u);
    return b;
}
__device__ __forceinline__ void xcd_barrier_complete(unsigned* bar, unsigned x, unsigned& nloc, unsigned& nx) {
    const unsigned G = gridDim.x * gridDim.y * gridDim.z;
    unsigned sum, cnt, mine, sp = 0u;
    for (;;) {
        sum = 0u; cnt = 0u; mine = 0u;
#pragma unroll
        for (unsigned j = 0; j < 16; ++j) { const unsigned c = xb_ld(&bar[XB_XCNT(j)]); sum += c; cnt += (c > 0u) ? 1u : 0u; mine = (j == x) ? c : mine; }
        if (sum == G) break;
        __builtin_amdgcn_s_sleep(1);
        if ((++sp & 255u) == 0u) { if (xb_ld(&bar[XB_TMO])) break; if (sp > XB_SPIN_CAP) { atomicAdd(&bar[XB_TMO], 1u); break; } }
    }
    nloc = mine > 0u ? mine : 1u; nx = cnt > 0u ? cnt : 1u;
}
__device__ __forceinline__ void xcd_barrier(const XcdBarrier& b, int tid) {
    asm volatile("s_waitcnt vmcnt(0)" ::: "memory");
    __syncthreads();
    if (tid == 0) {
        unsigned* bar = b.bar;
        __builtin_amdgcn_s_waitcnt(0);
        unsigned nloc = b.st[0], nx = b.st[1];
        if (nloc == 0u) { xcd_barrier_complete(bar, b.x, nloc, nx); b.st[0] = nloc; b.st[1] = nx; }
        const unsigned old = xb_add(&bar[XB_XSUB(b.x)], 1u);
        const unsigned gen = old / nloc;
        if (old + 1u == (gen + 1u) * nloc) {
            __builtin_amdgcn_fence(__ATOMIC_RELEASE, "agent");
            asm volatile("s_waitcnt vmcnt(0)" ::: "memory");
            const unsigned og = xb_add(&bar[XB_TOP], 1u);
            const unsigned tg = og / nx;
            if (og + 1u == (tg + 1u) * nx) xb_add(&bar[XB_TOPGEN], 1u);
            else XB_SPIN(xb_ld(&bar[XB_TOPGEN]) == tg, bar);
            __builtin_amdgcn_fence(__ATOMIC_ACQUIRE, "agent");
            xb_add(&bar[XB_XGEN(b.x)], 1u);
            asm volatile("s_waitcnt vmcnt(0)" ::: "memory");
        } else {
            XB_SPIN(xb_ld(&bar[XB_XGEN(b.x)]) == gen, bar);
            __builtin_amdgcn_fence(__ATOMIC_ACQUIRE, "agent");
            asm volatile("s_waitcnt vmcnt(0)" ::: "memory");
        }
    }
    __syncthreads();
}
namespace pg8 {
constexpr int BM = 256, BK = 64, HALF = 128, HTB = HALF * BK * 2, STAGE_BYTES = 8 * HTB, NXCD = 8, WGM = 4;
__host__ __device__ __forceinline__ int lds_byte(int r, int c) { const int st = (r >> 4) * 2 + (c >> 5), rr = r & 15, cc = c & 31, ob = rr * 64 + cc * 2; return st * 1024 + (ob ^ (((ob >> 9) & 1) << 5)); }
__host__ __device__ __forceinline__ void stage_rc(int b, int& R, int& C) { const int st = b / 1024, sb = b % 1024, swz = sb ^ (((sb >> 9) & 1) << 5); R = (st >> 1) * 16 + swz / 64; C = (st & 1) * 32 + (swz % 64) / 2; }
__host__ __device__ __forceinline__ int perm32(int rho) { const int n = rho >> 4, i = rho & 15; return 8 * (i >> 2) + 4 * n + (i & 3); }

struct Unit { int pm, pn; int sub = 0; };
struct Gemm { const bf16_t* A; const bf16_t* Bt; int M, N, K; };

struct StaticOrder {
    static constexpr bool HALFM = false, HALFN = false;
    int nM, nN, nwg, G, c, wgm;
    __host__ __device__ void init(int M, int N, int G_, int c_, int wgm_ = WGM) { nM = M / BM; nN = N / BM; nwg = nM * nN; G = G_; c = c_; wgm = wgm_; }
    __host__ __device__ bool next(int i, Unit& u) const {
        const long L = (long)i * G + c; if (L >= nwg) return false;
        int wgid = (int)L; { const int q = nwg / NXCD, r = nwg % NXCD, xcd = wgid % NXCD, off = wgid / NXCD; wgid = (xcd < r ? xcd * (q + 1) : r * (q + 1) + (xcd - r) * q) + off; }
        const int nig = wgm * nN, gid = wgid / nig, fm = gid * wgm, gsz = (nM - fm) < wgm ? (nM - fm) : wgm;
        u.pm = fm + ((wgid % nig) % gsz); u.pn = (wgid % nig) / gsz; return true;
    }
    __device__ __forceinline__ void a_ready(const Unit&) const {}
    __device__ __forceinline__ void done(const Unit&) const {}
};
#ifndef HALF_WGM
#define HALF_WGM 4
#endif
struct HalfOrder {
    static constexpr bool HALFM = true, HALFN = false;
    StaticOrder so; int nhalf, G, c;
    __device__ void init(int nhalf_, int G_, int c_) { nhalf = nhalf_; G = G_; c = c_; so.init(NLAT, DM, G_, c_, HALF_WGM); }
    __device__ __forceinline__ bool next(int i, Unit& u) const {
        if (so.next(i, u)) { u.sub = 0; return true; }
        const long L = (long)i * G + c - so.nwg; if (L < 0 || L >= nhalf) return false;
        const int v = (int)(L >> 3); u.pn = (int)(L & 7); u.pm = 64 + (v >> 1); u.sub = 1 + (v & 1); return true;
    }
    __device__ __forceinline__ void a_ready(const Unit&) const {}
    __device__ __forceinline__ void done(const Unit&) const {}
};
#ifndef GATE_WGM
#define GATE_WGM 4
#endif
struct GateOrder {
    static constexpr bool HALFM = false, HALFN = false;
    StaticOrder so; int skipctx, G, c; int fold = 0;
    __device__ void init(int skip, int G_, int c_) { skipctx = skip; G = G_; c = c_; so.init(skip ? NLAT : NROW, 43 * BM, G_, c_, GATE_WGM); }
    __device__ __forceinline__ int count() const { return so.nwg + (skipctx ? 36 : 0); }
    __device__ __forceinline__ bool next(int i, Unit& u) const {
        if (so.next(i, u)) { if (fold == 1) u.pn %= 24; if (fold == 2) u.pn = 24 + u.pn % 18; return true; }
        if (!skipctx) return false;
        const long L = (long)i * G + c - so.nwg; if (L < 0 || L >= 36) return false;
        const int q = (int)(L % 9); u.pm = 64 + (int)(L / 9); u.pn = 24 + (q < 2 ? 4 + q : (q < 6 ? 6 + q : (q < 8 ? 10 + q : 18))); return true;
    }
    __device__ __forceinline__ void a_ready(const Unit&) const {}
    __device__ __forceinline__ void done(const Unit&) const {}
};
__device__ __forceinline__ int rest_tile(int) { return 42; }
struct RestOrder {
    static constexpr bool HALFM = false, HALFN = true;
    StaticOrder so; int skipctx, off, G;
    __device__ void init(int skip, int G_, int c_, int n1) { skipctx = skip; G = G_; off = ((c_ - n1 % G_) % G_ + G_) % G_; so.init(skip ? NLAT : NROW, 1 * BM, G_, 0); }
    __device__ __forceinline__ bool next(int i, Unit& u) const {
        const long j = (long)i * G + off;
        if (j < so.nwg) { StaticOrder t = so; t.c = (int)(j % G); (void)t.next((int)(j / G), u); u.pn = rest_tile(u.pn); return true; }
        if (!skipctx) return false;
        const long L = j - so.nwg; if (L >= 4) return false;
        u.pm = 64 + (int)L; u.pn = 42; return true;
    }
    __device__ __forceinline__ void a_ready(const Unit&) const {}
    __device__ __forceinline__ void done(const Unit&) const {}
};
struct FakeOrder { static constexpr bool HALFM = false, HALFN = false; RestOrder r;
    __device__ __forceinline__ bool next(int i, Unit& u) const { const bool ok = r.next(i, u); u.pm = 0; u.pn = 0; return ok; }
    __device__ __forceinline__ void a_ready(const Unit&) const {}
    __device__ __forceinline__ void done(const Unit&) const {}
};
struct MoeOrder {
    static constexpr bool HALFM = true, HALFN = false;
    int ntiles, nN, G, c; const LAS int* tile_e;
    __device__ __forceinline__ bool next(int i, Unit& u) const {
        const long nun = (long)ntiles * nN, nfull = (nun / G) * G, tail = nun - nfull; const bool split = tail > 0 && tail * 2 <= G;
        const long L = (long)i * G + c; long un; int sub = 0;
        if (L < nfull || !split) { if (L >= nun) return false; un = L; }
        else { const long Lt = L - nfull; if (Lt >= 2 * tail) return false; un = nfull + (Lt >> 1); sub = 1 + (int)(Lt & 1); }
        const int rt = (int)(un / nN), ct = (int)(un % nN); u.pm = rt; u.pn = tile_e[rt] * nN + ct; u.sub = sub; return true;
    }
    __device__ __forceinline__ void a_ready(const Unit&) const {}
    __device__ __forceinline__ void done(const Unit&) const {}
};

typedef f32x4 Acc[2][2][4][2];
typedef int i32x4 __attribute__((ext_vector_type(4)));

struct EpiInProj {
    static constexpr bool PERM = true, AFTER_DRAIN = false, HAS_MID = false, I8 = false; static constexpr int MID0 = -1, MID1 = -1;
    bf16_t* P1; bf16_t* MO; float* GRAW;
    __device__ __forceinline__ void mid(Acc&, const Unit&, int, int, int, int, int) const {}
    __device__ __forceinline__ void operator()(const Acc& acc, const Unit& u, int wr, int wc, int fr, int fq) const {
        const int row0 = u.pm * BM + wr * 64 + fr, pn = u.pn;
        if (pn == 42) {
            if (wc == 0 && fq < 2) {
#pragma unroll
                for (int ai = 0; ai < 2; ++ai)
#pragma unroll
                    for (int m = 0; m < 4; ++m) { float* rowp = GRAW + (size_t)(row0 + ai * HALF + m * 16) * 16 + 8 * fq;
                        *(f32x4*)(rowp) = acc[ai][0][m][0]; *(f32x4*)(rowp + 4) = acc[ai][0][m][1]; }
            }
            return;
        }
        bf16_t* base; int ldc, colt; bool sig;
        if (pn < 12) { base = P1; ldc = 4096; colt = pn * BM; sig = false; }
        else if (pn < 14) { base = MO; ldc = 512; colt = (pn - 12) * BM; sig = true; }
        else { base = P1; ldc = 4096; colt = 3072 + (pn - 14) * BM; sig = false; }
        const int col0 = colt + wc * 32 + 8 * fq;
#pragma unroll
        for (int ai = 0; ai < 2; ++ai)
#pragma unroll
            for (int m = 0; m < 4; ++m) { bf16_t* rowp = base + (size_t)(row0 + ai * HALF + m * 16) * ldc + col0;
#pragma unroll
                for (int bj = 0; bj < 2; ++bj) { f32x4 v0 = acc[ai][bj][m][0], v1 = acc[ai][bj][m][1];
                    if (sig) {
#pragma unroll
                        for (int j = 0; j < 4; ++j) { v0[j] = fmaxf(sigmoidf_(v0[j]), 1e-6f); v1[j] = fmaxf(sigmoidf_(v1[j]), 1e-6f); } }
                    u32x4 w; w.x = cvt_pk_bf16(v0[0], v0[1]); w.y = cvt_pk_bf16(v0[2], v0[3]); w.z = cvt_pk_bf16(v1[0], v1[1]); w.w = cvt_pk_bf16(v1[2], v1[3]);
                    *(u32x4*)(rowp + bj * HALF) = w; } }
    }
};
__device__ __forceinline__ size_t gate_tile(int pm, int gb, int pn, int wave) { return ((size_t)((pm * 3 + gb) * 8 + pn) << 16) + (size_t)wave * 8192; }
__device__ __forceinline__ unsigned gate_in(int lane, int ai, int m, int bj) { return (unsigned)(lane * 8 + ((ai * 4 + m) * 2 + bj) * 512); }
__device__ __forceinline__ int i8_tile(int idx) { return idx; }
struct EpiGateI8 {
    static constexpr bool PERM = true, AFTER_DRAIN = false, HAS_MID = false, I8 = true; static constexpr int MID0 = -1, MID1 = -1;
    unsigned char* G; const float* HS; const float* WS8; bf16_t* P1; bf16_t* MO; unsigned char* wsb;
    __device__ __forceinline__ void mid(Acc&, const Unit&, int, int, int, int, int) const {}
    __device__ __forceinline__ void gates(const Acc& acc, const float (&hv)[2][4], const Unit& u, int wave, int lane, int col0) const {
        unsigned char* Gt = G + gate_tile(u.pm, u.pn >> 3, u.pn & 7, wave);
#pragma unroll
        for (int bj = 0; bj < 2; ++bj) { f32x4 w0 = *(const f32x4*)(WS8 + col0 + bj * HALF), w1 = *(const f32x4*)(WS8 + col0 + bj * HALF + 4);
#pragma unroll
            for (int j = 0; j < 4; ++j) { w0[j] *= -1.4426950408889634f; w1[j] *= -1.4426950408889634f; }
#pragma unroll
            for (int ai = 0; ai < 2; ++ai)
#pragma unroll
                for (int m = 0; m < 4; ++m) { const float hs = hv[ai][m];
                    const i32x4 i0 = __builtin_bit_cast(i32x4, acc[ai][bj][m][0]), i1 = __builtin_bit_cast(i32x4, acc[ai][bj][m][1]); u32x2 w = {0u, 0u};
#pragma unroll
                    for (int j = 0; j < 4; ++j) { constexpr float c = 1.0f / 255.0f;
                        const float e0 = __builtin_amdgcn_exp2f((float)i0[j] * hs * w0[j]), e1 = __builtin_amdgcn_exp2f((float)i1[j] * hs * w1[j]);
                        const float q0 = fmaxf(__builtin_rintf(__builtin_amdgcn_rcpf(fmaf(e0, c, c))), 1.0f), q1 = fmaxf(__builtin_rintf(__builtin_amdgcn_rcpf(fmaf(e1, c, c))), 1.0f);
                        w.x = __builtin_amdgcn_cvt_pk_u8_f32(q0, j, w.x); w.y = __builtin_amdgcn_cvt_pk_u8_f32(q1, j, w.y); }
                    *(u32x2*)(Gt + gate_in(lane, ai, m, bj)) = w; } }
    }
    template <bool SIG>
    __device__ __forceinline__ void values(const Acc& acc, const float (&hv)[2][4], int row0, int col0, bf16_t* base, int ldc, int c0) const {
#pragma unroll
        for (int bj = 0; bj < 2; ++bj) { const f32x4 w0 = *(const f32x4*)(WS8 + col0 + bj * HALF), w1 = *(const f32x4*)(WS8 + col0 + bj * HALF + 4);
#pragma unroll
            for (int ai = 0; ai < 2; ++ai)
#pragma unroll
                for (int m = 0; m < 4; ++m) { const int row = row0 + ai * HALF + m * 16; const float hs = hv[ai][m];
                    const i32x4 i0 = __builtin_bit_cast(i32x4, acc[ai][bj][m][0]), i1 = __builtin_bit_cast(i32x4, acc[ai][bj][m][1]); f32x4 v0, v1;
#pragma unroll
                    for (int j = 0; j < 4; ++j) { v0[j] = (float)i0[j] * hs * w0[j]; v1[j] = (float)i1[j] * hs * w1[j]; }
                    if (SIG) {
#pragma unroll
                        for (int j = 0; j < 4; ++j) { v0[j] = fmaxf(sigmoidf_(v0[j]), 1e-6f); v1[j] = fmaxf(sigmoidf_(v1[j]), 1e-6f); } }
                    u32x4 w; w.x = cvt_pk_bf16(v0[0], v0[1]); w.y = cvt_pk_bf16(v0[2], v0[3]); w.z = cvt_pk_bf16(v1[0], v1[1]); w.w = cvt_pk_bf16(v1[2], v1[3]);
                    *(u32x4*)(base + (size_t)row * ldc + c0 + bj * HALF) = w; } }
    }
    __device__ __forceinline__ void values_v(const Acc& acc, const float (&hv)[2][4], const Unit& u, int wr, int wc, int fr, int fq, int col0, int t) const {
        const bool lat = u.pm < 64; const int b = lat ? (u.pm >> 4) : (u.pm - 64), pos0 = lat ? (u.pm & 15) * BM : SEQ;
        const int nh = (t == 10 || t == 11) ? 4 : 2, h0 = (t == 11) ? 2 : 0;
        bf16_t* base = (bf16_t*)(wsb + (t == 5 ? WS_VA : (t == 17 ? WS_VC : WS_VM))) + ((size_t)(b * nh + h0) * KVL + pos0 + wr * 64 + fr) * HD + wc * 32 + 8 * fq;
#pragma unroll
        for (int bj = 0; bj < 2; ++bj) { const f32x4 w0 = *(const f32x4*)(WS8 + col0 + bj * HALF), w1 = *(const f32x4*)(WS8 + col0 + bj * HALF + 4);
#pragma unroll
            for (int ai = 0; ai < 2; ++ai)
#pragma unroll
                for (int m = 0; m < 4; ++m) { const float hs = hv[ai][m];
                    const i32x4 i0 = __builtin_bit_cast(i32x4, acc[ai][bj][m][0]), i1 = __builtin_bit_cast(i32x4, acc[ai][bj][m][1]); f32x4 v0, v1;
#pragma unroll
                    for (int j = 0; j < 4; ++j) { v0[j] = (float)i0[j] * hs * w0[j]; v1[j] = (float)i1[j] * hs * w1[j]; }
                    u32x4 w; w.x = cvt_pk_bf16(v0[0], v0[1]); w.y = cvt_pk_bf16(v0[2], v0[3]); w.z = cvt_pk_bf16(v1[0], v1[1]); w.w = cvt_pk_bf16(v1[2], v1[3]);
                    *(u32x4*)(base + (size_t)bj * KVL * HD + (size_t)(ai * HALF + m * 16) * HD) = w; } }
    }
    __device__ __forceinline__ void graw(const Acc& acc, const float (&hv)[2][4], int row0, int col0, int wc, int fq) const {
        if (wc != 0 || fq >= 2) return;
        float* GR = (float*)(wsb + WS_GRAW);
        const f32x4 w0 = *(const f32x4*)(WS8 + col0), w1 = *(const f32x4*)(WS8 + col0 + 4);
#pragma unroll
        for (int ai = 0; ai < 2; ++ai)
#pragma unroll
            for (int m = 0; m < 4; ++m) { const float hs = hv[ai][m]; float* rowp = GR + (size_t)(row0 + ai * HALF + m * 16) * 16 + 8 * fq;
                const i32x4 i0 = __builtin_bit_cast(i32x4, acc[ai][0][m][0]), i1 = __builtin_bit_cast(i32x4, acc[ai][0][m][1]); f32x4 v0, v1;
#pragma unroll
                for (int j = 0; j < 4; ++j) { v0[j] = (float)i0[j] * hs * w0[j]; v1[j] = (float)i1[j] * hs * w1[j]; }
                *(f32x4*)(rowp) = v0; *(f32x4*)(rowp + 4) = v1; }
    }
    __device__ __forceinline__ void operator()(const Acc& acc, const Unit& u, int wr, int wc, int fr, int fq) const {
        const int row0 = u.pm * BM + wr * 64 + fr, col0 = u.pn * BM + wc * 32 + 8 * fq;
        float hv[2][4];
#pragma unroll
        for (int ai = 0; ai < 2; ++ai)
#pragma unroll
            for (int m = 0; m < 4; ++m) hv[ai][m] = HS[row0 + ai * HALF + m * 16];
        if (u.pn < 24) { gates(acc, hv, u, wr * 4 + wc, fq * 16 + fr, col0); return; }
        const int t = i8_tile(u.pn - 24);
        if (t == 18) { graw(acc, hv, row0, col0, wc, fq); return; }
        if (t == 5 || t == 10 || t == 11 || t == 17) { values_v(acc, hv, u, wr, wc, fr, fq, col0, t); return; }
        if (t == 12 || t == 13) values<true>(acc, hv, row0, col0, MO, 512, (t - 12) * BM + wc * 32 + 8 * fq);
        else values<false>(acc, hv, row0, col0, P1, 4096, (t < 14 ? t * BM : 3072 + (t - 14) * BM) + wc * 32 + 8 * fq);
    }
};
struct EpiBranch {
    static constexpr bool PERM = true, AFTER_DRAIN = false, HAS_MID = true, I8 = false; static constexpr int MID0 = 16, MID1 = 24;
    const unsigned char* G; bf16_t* Y;
    __device__ __forceinline__ void mid(Acc& acc, const Unit& u, int t, int wr, int wc, int fr_, int fq_) const {
        const int fr = opaque(fr_), fq = opaque(fq_);
        const int row0 = u.pm * BM + wr * 64 + fr, col0 = u.pn * BM + wc * 32 + 8 * fq;
        const int gn = (t == 16) ? 0 : 1;
        const int lane = fq * 16 + fr; const unsigned char* Ga = G + gate_tile(u.pm, gn, u.pn, wr * 4 + wc) + (u.sub == 2 ? 4096 : 0); const unsigned char* Gb = Ga + ((size_t)8 << 16);
        const int nai = u.sub ? 1 : 2;
        u32x2 ga[2][4][2], gb[2][4][2];
#pragma unroll
        for (int ai = 0; ai < 2; ++ai) if (ai < nai)
#pragma unroll
            for (int m = 0; m < 4; ++m)
#pragma unroll
                for (int bj = 0; bj < 2; ++bj) { ga[ai][m][bj] = __builtin_nontemporal_load((const u32x2*)(Ga + gate_in(lane, ai, m, bj))); gb[ai][m][bj] = __builtin_nontemporal_load((const u32x2*)(Gb + gate_in(lane, ai, m, bj))); }
#pragma unroll
        for (int ai = 0; ai < 2; ++ai) if (ai < nai)
#pragma unroll
            for (int m = 0; m < 4; ++m)
#pragma unroll
                for (int bj = 0; bj < 2; ++bj) { const u32x2 a = ga[ai][m][bj], b = gb[ai][m][bj]; f32x4 r0, r1;
#pragma unroll
                    for (int j = 0; j < 4; ++j) { r0[j] = (float)((a.x >> (8 * j)) & 0xffu) * __builtin_amdgcn_rcpf((float)((b.x >> (8 * j)) & 0xffu)); r1[j] = (float)((a.y >> (8 * j)) & 0xffu) * __builtin_amdgcn_rcpf((float)((b.y >> (8 * j)) & 0xffu)); }
                    acc[ai][bj][m][0] *= r0; acc[ai][bj][m][1] *= r1; }
    }
    __device__ __forceinline__ void operator()(const Acc& acc, const Unit& u, int wr, int wc, int fr, int fq) const {
        const int row0 = u.pm * BM + wr * 64 + fr, col0 = u.pn * BM + wc * 32 + 8 * fq;
        const int lane_ = opaque(fq * 16 + fr); const unsigned char* Gc = G + gate_tile(u.pm, 2, u.pn, wr * 4 + wc) + (u.sub == 2 ? 4096 : 0);
        const int nai = u.sub ? 1 : 2; const size_t rsub = u.sub == 2 ? HALF : 0;
        u32x2 gc[2][4][2];
#pragma unroll
        for (int ai = 0; ai < 2; ++ai) if (ai < nai)
#pragma unroll
            for (int m = 0; m < 4; ++m)
#pragma unroll
                for (int bj = 0; bj < 2; ++bj) gc[ai][m][bj] = __builtin_nontemporal_load((const u32x2*)(Gc + gate_in(lane_, ai, m, bj)));
#pragma unroll
        for (int ai = 0; ai < 2; ++ai) if (ai < nai)
#pragma unroll
            for (int m = 0; m < 4; ++m) { const size_t r = (size_t)(row0 + ai * HALF + m * 16) + rsub;
#pragma unroll
                for (int bj = 0; bj < 2; ++bj) { const u32x2 g = gc[ai][m][bj];
                    f32x4 v0 = acc[ai][bj][m][0], v1 = acc[ai][bj][m][1];
#pragma unroll
                    for (int j = 0; j < 4; ++j) { v0[j] *= (float)((g.x >> (8 * j)) & 0xffu) * (1.0f / 255.0f); v1[j] *= (float)((g.y >> (8 * j)) & 0xffu) * (1.0f / 255.0f); }
                    u32x4 w; w.x = cvt_pk_bf16(v0[0], v0[1]); w.y = cvt_pk_bf16(v0[2], v0[3]); w.z = cvt_pk_bf16(v1[0], v1[1]); w.w = cvt_pk_bf16(v1[2], v1[3]);
                    *(u32x4*)(Y + r * 2048 + col0 + bj * HALF) = w; } }
    }
};
struct EpiOut {
    static constexpr bool PERM = true, AFTER_DRAIN = false, HAS_MID = false, I8 = false; static constexpr int MID0 = -1, MID1 = -1;
    const float* const __attribute__((address_space(4)))* karg; const float* modl; int first;
    __device__ __forceinline__ void mid(Acc&, const Unit&, int, int, int, int, int) const {}
    __device__ __forceinline__ void operator()(const Acc& acc, const Unit& u, int wr, int wc, int fr, int fq) const {
        const bool lat = u.pm < 64; const int rbase = lat ? u.pm * BM : (u.pm - 64) * BM;
        auto kp = karg; asm volatile("" : "+s"(kp));
        unsigned char* wsb = (unsigned char*)kp[29]; bf16_t* xres = (bf16_t*)(wsb + (lat ? WS_XL : WS_XC)); bf16_t* out = xres;
        const float* gv = modl + (size_t)(lat ? (u.pm >> 4) : 4) * 12288 + 4096;
        const int row0 = rbase + wr * 64 + fr + (u.sub == 2 ? HALF : 0), col0 = u.pn * BM + wc * 32 + 8 * fq; const int nai = u.sub ? 1 : 2;
        f32x4 g[2][2];
#pragma unroll
        for (int bj = 0; bj < 2; ++bj)
#pragma unroll
            for (int n = 0; n < 2; ++n) g[bj][n] = *(const f32x4*)(gv + col0 + bj * HALF + n * 4);
#pragma unroll
        for (int ai = 0; ai < 2; ++ai) if (ai < nai) {
#pragma unroll
            for (int mh = 0; mh < 2; ++mh) { f32x4 r[2][2][2];
                if (first) { const float* res = lat ? kp[0] : kp[2];
#pragma unroll
                    for (int m = 0; m < 2; ++m) { const size_t off = (size_t)(row0 + ai * HALF + (mh * 2 + m) * 16) * DM + col0;
#pragma unroll
                        for (int bj = 0; bj < 2; ++bj)
#pragma unroll
                            for (int n = 0; n < 2; ++n) r[m][bj][n] = *(const f32x4*)(res + off + bj * HALF + n * 4); } }
                else { const bf16_t* res = xres;
#pragma unroll
                    for (int m = 0; m < 2; ++m) { const size_t off = (size_t)(row0 + ai * HALF + (mh * 2 + m) * 16) * DM + col0;
#pragma unroll
                        for (int bj = 0; bj < 2; ++bj) { const u32x4 w = *(const u32x4*)(res + off + bj * HALF);
                            r[m][bj][0] = (f32x4){bflo(w.x), bfhi(w.x), bflo(w.y), bfhi(w.y)}; r[m][bj][1] = (f32x4){bflo(w.z), bfhi(w.z), bflo(w.w), bfhi(w.w)}; } } }
#pragma unroll
                for (int m = 0; m < 2; ++m) { const size_t off = (size_t)(row0 + ai * HALF + (mh * 2 + m) * 16) * DM + col0;
#pragma unroll
                    for (int bj = 0; bj < 2; ++bj) { const f32x4 v0 = r[m][bj][0] + g[bj][0] * acc[ai][bj][mh * 2 + m][0], v1 = r[m][bj][1] + g[bj][1] * acc[ai][bj][mh * 2 + m][1];
                        u32x4 w; w.x = cvt_pk_bf16(v0[0], v0[1]); w.y = cvt_pk_bf16(v0[2], v0[3]); w.z = cvt_pk_bf16(v1[0], v1[1]); w.w = cvt_pk_bf16(v1[2], v1[3]);
                        *(u32x4*)(out + off + bj * HALF) = w; } }
                asm volatile("" ::: "memory"); } }
    }
};
struct EpiMoe1 {
    static constexpr bool PERM = true, AFTER_DRAIN = false, HAS_MID = false, I8 = false; static constexpr int MID0 = -1, MID1 = -1;
    bf16_t* MID; const float* wsort;
    __device__ __forceinline__ void mid(Acc&, const Unit&, int, int, int, int, int) const {}
    __device__ __forceinline__ void operator()(const Acc& acc, const Unit& u, int wr, int wc, int fr, int fq) const {
        const int row0 = u.pm * BM + wr * 64 + fr, ct = u.pn & 3, col0 = ct * 128 + wc * 16 + 4 * fq;
        float wv[2][4];
#pragma unroll
        for (int ai = 0; ai < 2; ++ai)
#pragma unroll
            for (int m = 0; m < 4; ++m) wv[ai][m] = wsort[row0 + ai * HALF + m * 16];
#pragma unroll
        for (int ai = 0; ai < 2; ++ai)
#pragma unroll
            for (int m = 0; m < 4; ++m) { const size_t r = (size_t)(row0 + ai * HALF + m * 16); const float w = wv[ai][m];
#pragma unroll
                for (int bj = 0; bj < 2; ++bj) { const f32x4 a = acc[ai][bj][m][0], up = acc[ai][bj][m][1];
                    u32x2 o; o.x = cvt_pk_bf16(siluf_(a[0]) * up[0] * w, siluf_(a[1]) * up[1] * w); o.y = cvt_pk_bf16(siluf_(a[2]) * up[2] * w, siluf_(a[3]) * up[3] * w);
                    *(u32x2*)(MID + r * DFF + col0 + bj * 64) = o; } }
    }
};
struct EpiMoe1I8 {
    static constexpr bool PERM = true, AFTER_DRAIN = false, HAS_MID = false, I8 = true; static constexpr int MID0 = -1, MID1 = -1;
    bf16_t* MID; const float* wsort; const float* xss; const float* wgs;
    __device__ __forceinline__ void mid(Acc&, const Unit&, int, int, int, int, int) const {}
    __device__ __forceinline__ void operator()(const Acc& acc, const Unit& u, int wr, int wc, int fr, int fq) const {
        const int row0 = u.pm * BM + wr * 64 + fr + (u.sub == 2 ? HALF : 0), ct = u.pn & 3, col0 = ct * 128 + wc * 16 + 4 * fq, scol0 = u.pn * BM + wc * 32 + 8 * fq; const int nai = u.sub ? 1 : 2;
        float wv[2][4], rs[2][4];
#pragma unroll
        for (int ai = 0; ai < 2; ++ai)
#pragma unroll
            for (int m = 0; m < 4; ++m) { wv[ai][m] = (ai < nai) ? wsort[row0 + ai * HALF + m * 16] : 0.f; rs[ai][m] = (ai < nai) ? xss[row0 + ai * HALF + m * 16] : 0.f; }
#pragma unroll
        for (int bj = 0; bj < 2; ++bj) { const f32x4 cg = *(const f32x4*)(wgs + scol0 + bj * HALF), cu = *(const f32x4*)(wgs + scol0 + bj * HALF + 4);
#pragma unroll
            for (int ai = 0; ai < 2; ++ai) if (ai < nai)
#pragma unroll
                for (int m = 0; m < 4; ++m) { const size_t r = (size_t)(row0 + ai * HALF + m * 16); const float w = wv[ai][m], s = rs[ai][m];
                    const i32x4 ia = __builtin_bit_cast(i32x4, acc[ai][bj][m][0]), iu = __builtin_bit_cast(i32x4, acc[ai][bj][m][1]); float o[4];
#pragma unroll
                    for (int j = 0; j < 4; ++j) { const float a = (float)ia[j] * s * cg[j], up = (float)iu[j] * s * cu[j]; o[j] = siluf_(a) * up * w; }
                    u32x2 ov; ov.x = cvt_pk_bf16(o[0], o[1]); ov.y = cvt_pk_bf16(o[2], o[3]);
                    *(u32x2*)(MID + r * DFF + col0 + bj * 64) = ov; } }
    }
};
struct EpiMoe2 {
    static constexpr bool PERM = true, AFTER_DRAIN = false, HAS_MID = false, I8 = false; static constexpr int MID0 = -1, MID1 = -1;
    bf16_t* O;
    __device__ __forceinline__ void mid(Acc&, const Unit&, int, int, int, int, int) const {}
    __device__ __forceinline__ void operator()(const Acc& acc, const Unit& u, int wr, int wc, int fr, int fq) const {
        const int row0 = u.pm * BM + wr * 64 + fr + (u.sub == 2 ? HALF : 0), col0 = (u.pn & 7) * BM + wc * 32 + 8 * fq; const int nai = u.sub ? 1 : 2;
#pragma unroll
        for (int ai = 0; ai < 2; ++ai) if (ai < nai)
#pragma unroll
            for (int m = 0; m < 4; ++m) { bf16_t* rowp = O + (size_t)(row0 + ai * HALF + m * 16) * DM + col0;
#pragma unroll
                for (int bj = 0; bj < 2; ++bj) { const f32x4 v0 = acc[ai][bj][m][0], v1 = acc[ai][bj][m][1];
                    u32x4 w; w.x = cvt_pk_bf16(v0[0], v0[1]); w.y = cvt_pk_bf16(v0[2], v0[3]); w.z = cvt_pk_bf16(v1[0], v1[1]); w.w = cvt_pk_bf16(v1[2], v1[3]);
                    *(u32x4*)(rowp + bj * HALF) = w; } }
    }
};

template <class Epi, class Sched>
__device__ __forceinline__ void gemm_phase(LAS unsigned char* lds, const Gemm g, const Sched& S, const Epi& E, int wave) {
    const int tid = tid_of(wave), wid = wave, lane = tid & 63, wr = wid >> 2, wc = wid & 3, fr = lane & 15, fq = lane >> 4;
    const int K = g.K, nt = K / BK;
    unsigned voffA[2], voffB[2];
#pragma unroll
    for (int i = 0; i < 2; ++i) { int R, C; stage_rc(tid * 16 + i * 8192, R, C); const int Rb = Epi::PERM ? ((R & ~31) + perm32(R & 31)) : R;
        voffA[i] = (unsigned)(R * K + C) * 2u; voffB[i] = (unsigned)(Rb * K + C) * 2u; }
    const size_t kstep = (size_t)(BK * 2);
    const size_t hstep = (size_t)HALF * K * 2;
    const size_t tstep = 2 * hstep;
    const unsigned ldsw = (unsigned)wid * 1024u;
    const int aoff = lds_byte(wr * 64 + fr, fq * 8), boff = lds_byte(wc * 32 + fr, fq * 8);
#define PG8_SA(b, h) (((b) * 2 + (h)) * HTB)
#define PG8_SB(b, h) ((4 + (b) * 2 + (h)) * HTB)
#define PG8_STAGE(bufoff, gbase, voff) do { _Pragma("unroll") for (int _i = 0; _i < 2; ++_i) \
        __builtin_amdgcn_global_load_lds((const unsigned*)((const char*)(gbase) + (voff)[_i]), (LAS unsigned*)(lds + (bufoff) + ldsw + _i * 8192), 16, 0, 0); } while (0)
#define PG8_LDA(dst, b, h) do { _Pragma("unroll") for (int m = 0; m < 4; ++m) _Pragma("unroll") for (int k = 0; k < 2; ++k) dst[m][k] = *(const LAS bf16x8*)(lds + PG8_SA(b, h) + aoff + m * 2048 + k * 1024); } while (0)
#define PG8_LDB(dst, b, h) do { _Pragma("unroll") for (int n = 0; n < 2; ++n) _Pragma("unroll") for (int k = 0; k < 2; ++k) dst[n][k] = *(const LAS bf16x8*)(lds + PG8_SB(b, h) + boff + n * 2048 + k * 1024); } while (0)
#define PG8_MMA(ai, bj, At, Bt) do { __builtin_amdgcn_s_setprio(1); _Pragma("unroll") for (int m = 0; m < 4; ++m) _Pragma("unroll") for (int n = 0; n < 2; ++n) _Pragma("unroll") for (int k = 0; k < 2; ++k) { \
        if (Epi::I8) asm volatile("v_mfma_i32_16x16x64_i8 %0, %1, %2, %0" : "+v"(acc[ai][bj][m][n]) : "v"(Bt[n][k]), "v"(At[m][k])); \
        else acc[ai][bj][m][n] = __builtin_amdgcn_mfma_f32_16x16x32_bf16(Bt[n][k], At[m][k], acc[ai][bj][m][n], 0, 0, 0); } __builtin_amdgcn_s_setprio(0); } while (0)
#define PG8_WAIT_V(n) asm volatile("s_waitcnt vmcnt(" #n ")" ::: "memory")
#define PG8_WAIT_L(n) asm volatile("s_waitcnt lgkmcnt(" #n ")" ::: "memory")
#define PG8_BAR __builtin_amdgcn_s_barrier()
#define PG8_SCHED __builtin_amdgcn_sched_barrier(0)
    Unit cur, nxt; int ui = 0;
    if (!S.next(0, cur)) return;
    f32x4 acc[2][2][4][2];
#pragma unroll
    for (int a = 0; a < 2; ++a)
#pragma unroll
        for (int b = 0; b < 2; ++b)
#pragma unroll
            for (int m = 0; m < 4; ++m)
#pragma unroll
                for (int n = 0; n < 2; ++n) acc[a][b][m][n] = (f32x4){0.f, 0.f, 0.f, 0.f};
    bf16x8 At[4][2], B0[2][2], B1[2][2];
    const char* cA = (const char*)g.A + (size_t)cur.pm * tstep + ((Sched::HALFM && cur.sub == 2) ? hstep : 0); const char* cB = (const char*)g.Bt + (size_t)cur.pn * tstep;
    S.a_ready(cur);
    PG8_STAGE(PG8_SB(0, 0), cB, voffB); PG8_STAGE(PG8_SB(0, 1), cB + hstep, voffB); PG8_STAGE(PG8_SA(0, 0), cA, voffA); PG8_STAGE(PG8_SA(0, 1), cA + hstep, voffA);
    if (wr == 1) PG8_BAR;
    PG8_WAIT_V(2); PG8_BAR;
    PG8_STAGE(PG8_SB(1, 0), cB + kstep, voffB); PG8_STAGE(PG8_SA(1, 0), cA + kstep, voffA); PG8_STAGE(PG8_SB(1, 1), cB + hstep + kstep, voffB);
    PG8_WAIT_V(6); PG8_BAR;
    for (;;) {
        const bool has_next = S.next(ui + 1, nxt);
        const char* nA = has_next ? (const char*)g.A + (size_t)nxt.pm * tstep + ((Sched::HALFM && nxt.sub == 2) ? hstep : 0) : cA;
        const char* nB = has_next ? (const char*)g.Bt + (size_t)nxt.pn * tstep : cB;
        const bool whole = !Sched::HALFM || cur.sub == 0;
        for (int t = 0; t < nt; t += 2) {
            const bool last = (t == nt - 2);
            const char* a1 = cA + (size_t)(t + 1) * kstep;
            const char* a2 = last ? nA : cA + (size_t)(t + 2) * kstep; const char* b2 = last ? nB : cB + (size_t)(t + 2) * kstep;
            const char* a3 = a2 + kstep; const char* b3 = b2 + kstep;
            if (last && has_next) S.a_ready(nxt);
            if constexpr (Epi::HAS_MID) { if (t == Epi::MID0 || t == Epi::MID1) { E.mid(acc, cur, t, wr, wc, fr, fq); PG8_SCHED; } }
            PG8_LDB(B0, 0, 0); PG8_LDB(B1, 0, 1); PG8_SCHED; PG8_LDA(At, 0, 0); PG8_STAGE(PG8_SA(1, 1), a1 + hstep, voffA);
            PG8_WAIT_V(8); PG8_WAIT_L(0); PG8_BAR; PG8_MMA(0, 0, At, B0); if constexpr (!Sched::HALFN) PG8_MMA(0, 1, At, B1); PG8_BAR; PG8_SCHED;
            PG8_LDA(At, 0, 1); PG8_STAGE(PG8_SB(0, 0), b2, voffB); PG8_STAGE(PG8_SB(0, 1), b2 + hstep, voffB); PG8_STAGE(PG8_SA(0, 0), a2, voffA);
            PG8_WAIT_V(8); PG8_WAIT_L(0); PG8_BAR; if (whole) { PG8_MMA(1, 0, At, B0); if constexpr (!Sched::HALFN) PG8_MMA(1, 1, At, B1); } PG8_BAR; PG8_SCHED;
            PG8_LDB(B0, 1, 0); PG8_LDB(B1, 1, 1); PG8_SCHED; PG8_LDA(At, 1, 0); PG8_STAGE(PG8_SA(0, 1), a2 + hstep, voffA);
            PG8_WAIT_V(8); PG8_WAIT_L(0); PG8_BAR; PG8_MMA(0, 0, At, B0); if constexpr (!Sched::HALFN) PG8_MMA(0, 1, At, B1); PG8_BAR; PG8_SCHED;
            PG8_LDA(At, 1, 1); PG8_STAGE(PG8_SB(1, 0), b3, voffB); PG8_STAGE(PG8_SB(1, 1), b3 + hstep, voffB); PG8_STAGE(PG8_SA(1, 0), a3, voffA);
            PG8_WAIT_V(8); PG8_WAIT_L(0); PG8_BAR; if (whole) { PG8_MMA(1, 0, At, B0); if constexpr (!Sched::HALFN) PG8_MMA(1, 1, At, B1); } PG8_BAR; PG8_SCHED;
        }
        if (wr == 0) PG8_BAR;
        E(acc, cur, wr, wc, fr, fq); S.done(cur);
        if (!has_next) break;
#pragma unroll
        for (int a = 0; a < 2; ++a)
#pragma unroll
            for (int b = 0; b < 2; ++b)
#pragma unroll
                for (int m = 0; m < 4; ++m)
#pragma unroll
                    for (int n = 0; n < 2; ++n) acc[a][b][m][n] = (f32x4){0.f, 0.f, 0.f, 0.f};
        cur = nxt; cA = nA; cB = nB; ++ui;
        if (wr == 1) PG8_BAR;
    }
    PG8_WAIT_V(0);
    PG8_BAR;
#undef PG8_SA
#undef PG8_SB
#undef PG8_STAGE
#undef PG8_LDA
#undef PG8_LDB
#undef PG8_MMA
#undef PG8_WAIT_V
#undef PG8_WAIT_L
#undef PG8_BAR
#undef PG8_SCHED
}
}
#ifndef ATT_PREK
#define ATT_PREK 1
#endif
#ifndef ATT_PIPE
#define ATT_PIPE 0
#endif
#ifndef ATT_LSUM
#define ATT_LSUM 0
#endif
namespace att {
constexpr int D = 128, QBLK = 32, KVBLK = 64;
constexpr float SCALE = 0.088388347648318440f;
constexpr float THR = 8.f;
constexpr size_t SHM_V = KVBLK * D * 2, SHM_K = KVBLK * D * 2;
#define KSWZ(row, colB) ((row) * 256 + ((colB) ^ (((row) & 7) << 4)))
#define SBAR() __builtin_amdgcn_sched_barrier(0)
__device__ __forceinline__ int crow(int r, int hi) { return (r & 3) + 8 * (r >> 2) + 4 * hi; }

template <bool MASK, bool FIX, bool INPV = false>
__device__ __forceinline__ void partialSM(f32x16& p0, f32x16& p1, float& m_reg, float& mn, float& alpha, int dq, int hi) {
  constexpr float C = SCALE * 1.4426950408889634f;
  if (FIX) {
    mn = m_reg; alpha = 1.f;
    if (INPV) return;
#pragma unroll
    for (int r = 0; r < 16; ++r) p0[r] = __builtin_amdgcn_exp2f(p0[r]);
    return;
  }
  if (MASK) { if (dq < 100000) { const int dl = dq - 4 * hi - 128, dh = dq - 4 * hi + 128;
#pragma unroll
      for (int r = 0; r < 16; ++r) { const int k0 = (r & 3) + 8 * (r >> 2), k1 = k0 + 32;
        p0[r] = (k0 >= dl && k0 <= dh) ? p0[r] : -1e30f; p1[r] = (k1 >= dl && k1 <= dh) ? p1[r] : -1e30f; } } }
  float pmax = p0[0];
#pragma unroll
  for (int r = 1; r < 16; ++r) pmax = fmaxf(pmax, p0[r]);
#pragma unroll
  for (int r = 0; r < 16; ++r) pmax = fmaxf(pmax, p1[r]);
  { auto rr = __builtin_amdgcn_permlane32_swap(__float_as_uint(pmax), __float_as_uint(pmax), false, false);
    pmax = fmaxf(__uint_as_float(rr[0]), __uint_as_float(rr[1])); }
  if (__builtin_expect(__all(pmax - m_reg <= THR / SCALE), 1)) { mn = m_reg; alpha = 1.f; }
  else { mn = fmaxf(m_reg, pmax); alpha = __builtin_amdgcn_exp2f((m_reg - mn) * C); m_reg = mn; }
  float mnC = -mn * C;
#pragma unroll
  for (int r = 0; r < 16; ++r) p0[r] = fmaf(p0[r], C, mnC);
#pragma unroll
  for (int r = 0; r < 16; ++r) p1[r] = fmaf(p1[r], C, mnC);
#pragma unroll
  for (int r = 0; r < 16; ++r) p0[r] = __builtin_amdgcn_exp2f(p0[r]);
}
#define PK4(P, BASE, OUT) do { unsigned a0 = cvt_pk_bf16(P[BASE + 0], P[BASE + 1]), a1 = cvt_pk_bf16(P[BASE + 2], P[BASE + 3]);   \
    unsigned b0 = cvt_pk_bf16(P[BASE + 4], P[BASE + 5]), b1 = cvt_pk_bf16(P[BASE + 6], P[BASE + 7]);                              \
    auto r0 = __builtin_amdgcn_permlane32_swap(a0, b0, false, false); auto r1 = __builtin_amdgcn_permlane32_swap(a1, b1, false, false); \
    u32x4 w = {r0[0], r1[0], r0[1], r1[1]}; OUT = *reinterpret_cast<bf16x8*>(&w); } while (0)
template <bool FIX>
__device__ __forceinline__ void finishSM(f32x16& p0, f32x16& p1, float alpha, float& l_reg, bf16x8& pa0, bf16x8& pa1, bf16x8& pa2, bf16x8& pa3) {
#pragma unroll
  for (int r = 0; r < 16; ++r) p1[r] = __builtin_amdgcn_exp2f(p1[r]);
#if ATT_LSUM
  if (FIX) { PK4(p0, 0, pa0); PK4(p0, 8, pa1); PK4(p1, 0, pa2); PK4(p1, 8, pa3); return; }
#endif
  float ps = 0;
#pragma unroll
  for (int r = 0; r < 16; ++r) ps += p0[r];
#pragma unroll
  for (int r = 0; r < 16; ++r) ps += p1[r];
  { auto rr = __builtin_amdgcn_permlane32_swap(__float_as_uint(ps), __float_as_uint(ps), false, false);
    ps = __uint_as_float(rr[0]) + __uint_as_float(rr[1]); }
  l_reg = l_reg * alpha + ps;
  PK4(p0, 0, pa0); PK4(p0, 8, pa1); PK4(p1, 0, pa2); PK4(p1, 8, pa3);
}
__device__ __forceinline__ void qkt(f32x16& p0, f32x16& p1, const LAS char* Ks, const bf16x8* qr, int r32, int hi, float init = 0.f) {
#pragma unroll
  for (int r = 0; r < 16; ++r) { p0[r] = init; p1[r] = init; }
#pragma unroll
  for (int d0 = 0; d0 < 8; ++d0) { int cb = (d0 * 16 + hi * 8) * 2;
    bf16x8 b0 = *reinterpret_cast<const LAS bf16x8*>(Ks + KSWZ(r32, cb));
    bf16x8 b1 = *reinterpret_cast<const LAS bf16x8*>(Ks + KSWZ(32 + r32, cb));
    p0 = __builtin_amdgcn_mfma_f32_32x32x16_bf16(b0, qr[d0], p0, 0, 0, 0);
    p1 = __builtin_amdgcn_mfma_f32_32x32x16_bf16(b1, qr[d0], p1, 0, 0, 0); }
}
__device__ __forceinline__ void qkt_pf(f32x16& p0, f32x16& p1, const LAS char* Ks, const bf16x8* qr, int r32, int hi, float init = 0.f) {
#pragma unroll
  for (int r = 0; r < 16; ++r) { p0[r] = init; p1[r] = init; }
  bf16x8 b0 = *reinterpret_cast<const LAS bf16x8*>(Ks + KSWZ(r32, (hi * 8) * 2)), b1 = *reinterpret_cast<const LAS bf16x8*>(Ks + KSWZ(32 + r32, (hi * 8) * 2));
#pragma unroll
  for (int d0 = 0; d0 < 8; ++d0) { const int cb = (((d0 + 1) & 7) * 16 + hi * 8) * 2;
    const bf16x8 n0 = *reinterpret_cast<const LAS bf16x8*>(Ks + KSWZ(r32, cb)), n1 = *reinterpret_cast<const LAS bf16x8*>(Ks + KSWZ(32 + r32, cb));
    p0 = __builtin_amdgcn_mfma_f32_32x32x16_bf16(b0, qr[d0], p0, 0, 0, 0);
    p1 = __builtin_amdgcn_mfma_f32_32x32x16_bf16(b1, qr[d0], p1, 0, 0, 0);
    b0 = n0; b1 = n1; }
}
__device__ __forceinline__ int v_st(int k, int c) { const int kk = (k & ~0xC) | ((k & 4) << 1) | ((k & 8) >> 1); return ((kk >> 3) * 4 + (c >> 5)) * 512 + ((kk & 7) * 32 + (c & 31)) * 2; }
__device__ __forceinline__ int v_rd_base(int lane) { return ((lane & 3) << 3) | (((lane >> 2) & 3) << 6) | (((lane >> 4) & 1) << 5) | (((lane >> 5) & 1) << 8); }
constexpr int v_rd_off(int d0, int ks, int half) { return d0 * 512 + ks * 4096 + half * 2048; }
template <int OFF> __device__ __forceinline__ s16x4 tr_read(int vb) {
  s16x4 r; asm volatile("ds_read_b64_tr_b16 %0, %1 offset:%2" : "=&v"(r) : "v"(vb), "i"(OFF) : "memory"); return r;
}
#define PKV(L, H) (bf16x8){L[0], L[1], L[2], L[3], H[0], H[1], H[2], H[3]}
template <int D0, bool EX> __device__ __forceinline__ void pv_one(f32x16& od, int vb, bf16x8 pa0, bf16x8 pa1, bf16x8 pa2, bf16x8 pa3, f32x16& px) {
  const s16x4 l0 = tr_read<v_rd_off(D0, 0, 0)>(vb), h0 = tr_read<v_rd_off(D0, 0, 1)>(vb), l1 = tr_read<v_rd_off(D0, 1, 0)>(vb), h1 = tr_read<v_rd_off(D0, 1, 1)>(vb);
  const s16x4 l2 = tr_read<v_rd_off(D0, 2, 0)>(vb), h2 = tr_read<v_rd_off(D0, 2, 1)>(vb), l3 = tr_read<v_rd_off(D0, 3, 0)>(vb), h3 = tr_read<v_rd_off(D0, 3, 1)>(vb);
  asm volatile("s_waitcnt lgkmcnt(0)" ::: "memory"); SBAR();
  od = __builtin_amdgcn_mfma_f32_32x32x16_bf16(pa0, PKV(l0, h0), od, 0, 0, 0);
  if (EX) px[4 * D0 + 0] = __builtin_amdgcn_exp2f(px[4 * D0 + 0]);
  od = __builtin_amdgcn_mfma_f32_32x32x16_bf16(pa1, PKV(l1, h1), od, 0, 0, 0);
  if (EX) px[4 * D0 + 1] = __builtin_amdgcn_exp2f(px[4 * D0 + 1]);
  od = __builtin_amdgcn_mfma_f32_32x32x16_bf16(pa2, PKV(l2, h2), od, 0, 0, 0);
  if (EX) px[4 * D0 + 2] = __builtin_amdgcn_exp2f(px[4 * D0 + 2]);
  od = __builtin_amdgcn_mfma_f32_32x32x16_bf16(pa3, PKV(l3, h3), od, 0, 0, 0);
  if (EX) px[4 * D0 + 3] = __builtin_amdgcn_exp2f(px[4 * D0 + 3]);
}
template <int D0> __device__ __forceinline__ void pv_one(f32x16& od, int vb, bf16x8 pa0, bf16x8 pa1, bf16x8 pa2, bf16x8 pa3) { f32x16 dummy; pv_one<D0, false>(od, vb, pa0, pa1, pa2, pa3, dummy); }
template <bool EX> __device__ __forceinline__ void pv_d0(f32x16* o, int vb, bf16x8 pa0, bf16x8 pa1, bf16x8 pa2, bf16x8 pa3, f32x16& px) {
  pv_one<0, EX>(o[0], vb, pa0, pa1, pa2, pa3, px); pv_one<1, EX>(o[1], vb, pa0, pa1, pa2, pa3, px); pv_one<2, EX>(o[2], vb, pa0, pa1, pa2, pa3, px); pv_one<3, EX>(o[3], vb, pa0, pa1, pa2, pa3, px);
}

struct Args { const bf16_t* Q; const bf16_t* K; const bf16_t* V; bf16_t* O; int ldo, n0, base0, base1, NT, qpos0; float m_init, l_init; };
template <bool MASK, bool FIX>
__device__ __forceinline__ void attn_body(const Args a, LAS char* lds, int wave) {
  const int tid = tid_of(wave), wid = wave, lane = tid & 63, r32 = lane & 31, hi = lane >> 5;
  LAS char* V_lds = lds; LAS char* K_lds = lds + 2 * SHM_V;
  LAS float* ws = (LAS float*)(lds + 2 * SHM_V + 2 * SHM_K) + wid * 64; LAS float* li_l = ws; LAS float* al_l = ws + 32;
  float m_reg = a.m_init, l_reg = a.l_init; f32x16 o[4] = {}; bf16x8 qr[8];
  const bf16_t* Qw = a.Q + (long)(wid * QBLK + r32) * D + hi * 8;
#pragma unroll
  for (int d0 = 0; d0 < 8; ++d0) qr[d0] = __builtin_nontemporal_load(reinterpret_cast<const bf16x8*>(Qw + d0 * 16));
  int tidv = tid; int sr = tidv >> 4, sc = (tidv & 15) * 8, vst0 = v_st(sr, sc), vst1 = v_st(32 + sr, sc), slo = sr * D + sc;
  int vb0 = (int)(unsigned)(uintptr_t)V_lds + v_rd_base(lane);
#define LANE_CONSTS() do { asm volatile("" : "+v"(tidv)); sr = tidv >> 4; sc = (tidv & 15) * 8; vst0 = v_st(sr, sc); vst1 = v_st(32 + sr, sc); slo = sr * D + sc; vb0 = (int)(unsigned)(uintptr_t)V_lds + v_rd_base(tidv & 63); } while (0)
  const int qpos = a.qpos0 + wid * QBLK + r32;
  struct { bf16x8 vs0, vs1, ks0, ks1; } sr_[2];
#define KROW(j) (((j) < a.n0) ? (a.base0 + 64 * (j)) : (a.base1 + 64 * ((j) - a.n0)))
#define DQ(j) (((j) < a.n0) ? (qpos - (a.base0 + 64 * (j))) : 1000000)
#define SLOAD(i, j) do { const long k0_ = KROW(j); const bf16_t* vt_ = a.V + k0_ * D; const bf16_t* kt_ = a.K + k0_ * D;     \
    sr_[i].vs0 = *reinterpret_cast<const bf16x8*>(vt_ + slo); sr_[i].vs1 = *reinterpret_cast<const bf16x8*>(vt_ + slo + 32 * D); \
    sr_[i].ks0 = *reinterpret_cast<const bf16x8*>(kt_ + slo); sr_[i].ks1 = *reinterpret_cast<const bf16x8*>(kt_ + slo + 32 * D); } while (0)
#define SWRITE(b, i) do { *(LAS bf16x8*)(V_lds + (b) * SHM_V + vst0) = sr_[i].vs0;          \
    *(LAS bf16x8*)(V_lds + (b) * SHM_V + vst1) = sr_[i].vs1; int kc = sc * 2;               \
    *(LAS bf16x8*)(K_lds + (b) * SHM_K + KSWZ(sr, kc)) = sr_[i].ks0;                       \
    *(LAS bf16x8*)(K_lds + (b) * SHM_K + KSWZ(32 + sr, kc)) = sr_[i].ks1; } while (0)
#define SWAIT() asm volatile("s_waitcnt vmcnt(4)" ::: "memory")
#define RESC(al) do { if (!FIX && __any((al) < 1.f)) { if (hi == 0) al_l[r32] = (al); asm volatile("s_waitcnt lgkmcnt(0)" ::: "memory"); \
    _Pragma("unroll") for (int d = 0; d < 4; ++d) _Pragma("unroll") for (int r = 0; r < 16; ++r) o[d][r] *= al_l[crow(r, hi)]; } } while (0)
  f32x16 pA0, pA1, pB0, pB1; float mnA, mnB, alA, alB; bf16x8 pa0, pa1, pa2, pa3; const int NT = a.NT;
  const float qinit = FIX ? -a.m_init : 0.f;
  f32x16 lsum = {}; const bf16x8 ones = (bf16x8){(short)0x3F80, (short)0x3F80, (short)0x3F80, (short)0x3F80, (short)0x3F80, (short)0x3F80, (short)0x3F80, (short)0x3F80};
#define LSUM() do { if (ATT_LSUM && FIX) { lsum = __builtin_amdgcn_mfma_f32_32x32x16_bf16(pa0, ones, lsum, 0, 0, 0); lsum = __builtin_amdgcn_mfma_f32_32x32x16_bf16(pa1, ones, lsum, 0, 0, 0); \
    lsum = __builtin_amdgcn_mfma_f32_32x32x16_bf16(pa2, ones, lsum, 0, 0, 0); lsum = __builtin_amdgcn_mfma_f32_32x32x16_bf16(pa3, ones, lsum, 0, 0, 0); } } while (0)
  constexpr int SE = 0, SO = 1;
#define R1_PIPE() do { if (FIX && ATT_PIPE) { if (ATT_PREK) __builtin_amdgcn_sched_group_barrier(0x100, 2, 0);                        \
    _Pragma("unroll") for (int s_ = 0; s_ < 8; ++s_) { __builtin_amdgcn_sched_group_barrier(0x100, 2, 0);               \
      __builtin_amdgcn_sched_group_barrier(0x008, 1, 0); __builtin_amdgcn_sched_group_barrier(0x402, ATT_PIPE, 0);      \
      __builtin_amdgcn_sched_group_barrier(0x008, 1, 0); __builtin_amdgcn_sched_group_barrier(0x402, ATT_PIPE, 0); } } } while (0)
  SLOAD(SE, 0); asm volatile("s_waitcnt vmcnt(0)" ::: "memory"); SWRITE(0, SE); __syncthreads();
  qkt(pA0, pA1, K_lds, qr, r32, hi, qinit); partialSM<MASK, FIX>(pA0, pA1, m_reg, mnA, alA, DQ(0), hi);
  SLOAD(SO, 1); if (2 < NT) SLOAD(SE, 2);
  SWAIT(); SWRITE(1, SO); __syncthreads();
  for (int j = 1; j + 1 < NT; j += 2) {
    LANE_CONSTS();
    SBAR(); qkt(pB0, pB1, K_lds + SHM_K, qr, r32, hi, qinit);
    finishSM<FIX>(pA0, pA1, alA, l_reg, pa0, pa1, pa2, pa3); R1_PIPE(); SBAR();
    SLOAD(SO, j + 2); SBAR();
    pv_d0<FIX>(o, vb0, pa0, pa1, pa2, pa3, pB0); LSUM(); partialSM<MASK, FIX, true>(pB0, pB1, m_reg, mnB, alB, DQ(j), hi);
    __syncthreads(); SWAIT(); SWRITE(0, SE);
    RESC(alB); __syncthreads();
    SBAR(); qkt(pA0, pA1, K_lds, qr, r32, hi, qinit);
    finishSM<FIX>(pB0, pB1, alB, l_reg, pa0, pa1, pa2, pa3); R1_PIPE(); SBAR();
    if (j + 3 < NT) SLOAD(SE, j + 3); SBAR();
    pv_d0<FIX>(o, vb0 + (int)SHM_V, pa0, pa1, pa2, pa3, pA0); LSUM(); partialSM<MASK, FIX, true>(pA0, pA1, m_reg, mnA, alA, DQ(j + 1), hi);
    __syncthreads(); SWAIT(); SWRITE(1, SO);
    RESC(alA); __syncthreads();
  }
  SBAR(); qkt(pB0, pB1, K_lds + SHM_K, qr, r32, hi, qinit);
  finishSM<FIX>(pA0, pA1, alA, l_reg, pa0, pa1, pa2, pa3); SBAR();
  pv_d0<FIX>(o, vb0, pa0, pa1, pa2, pa3, pB0); LSUM(); partialSM<MASK, FIX, true>(pB0, pB1, m_reg, mnB, alB, DQ(NT - 1), hi);
  __syncthreads(); RESC(alB);
  finishSM<FIX>(pB0, pB1, alB, l_reg, pa0, pa1, pa2, pa3); SBAR();
  pv_d0<false>(o, vb0 + (int)SHM_V, pa0, pa1, pa2, pa3, pB0); LSUM();
  if (hi == 0) li_l[r32] = l_reg; asm volatile("s_waitcnt lgkmcnt(0)" ::: "memory");
  float rli[16];
#pragma unroll
  for (int r = 0; r < 16; ++r) rli[r] = __builtin_amdgcn_rcpf((ATT_LSUM && FIX) ? lsum[r] : li_l[crow(r, hi)]);
  bf16_t* Ow = a.O + (long)(wid * QBLK) * a.ldo;
#pragma unroll
  for (int r = 0; r < 16; ++r) { int orow = crow(r, hi);
#pragma unroll
    for (int d0 = 0; d0 < 4; ++d0) { const float v = o[d0][r] * rli[r]; Ow[(long)orow * a.ldo + d0 * 32 + r32] = (bf16_t)(cvt_pk_bf16(v, v) & 0xffffu); } }
  __syncthreads();
#undef LANE_CONSTS
#undef R1_PIPE
#undef LSUM
#undef KROW
#undef DQ
#undef SLOAD
#undef SWRITE
#undef SWAIT
#undef RESC
}

__device__ __forceinline__ void attn_body_dma(const Args a, LAS char* lds, int wave) {
  constexpr bool FIX = true;
  const int tid = tid_of(wave), wid = wave, lane = tid & 63, r32 = lane & 31, hi = lane >> 5;
  LAS float* li_l = (LAS float*)(lds + 131072) + wid * 32;
  float l_reg = a.l_init; f32x16 o[4] = {}; bf16x8 qr[8];
  const bf16_t* Qw = a.Q + (long)(wid * QBLK + r32) * D + hi * 8;
#pragma unroll
  for (int d0 = 0; d0 < 8; ++d0) qr[d0] = __builtin_nontemporal_load(reinterpret_cast<const bf16x8*>(Qw + d0 * 16));
  unsigned kof0, kof1, vof0, vof1;
  { const int g0 = wid * 64 + lane, g1 = g0 + 512;
    { const int row = g0 >> 4, sw = g0 & 15; kof0 = (unsigned)(row * 256 + ((sw ^ (row & 7)) << 4)); }
    { const int row = g1 >> 4, sw = g1 & 15; kof1 = (unsigned)(row * 256 + ((sw ^ (row & 7)) << 4)); }
    { const int st = g0 >> 5, gi = g0 & 31, kk = ((st >> 2) << 3) | (gi >> 2), k = (kk & ~0xC) | ((kk & 4) << 1) | ((kk & 8) >> 1), c = (st & 3) * 32 + (gi & 3) * 8; vof0 = (unsigned)((k * D + c) * 2); }
    { const int st = g1 >> 5, gi = g1 & 31, kk = ((st >> 2) << 3) | (gi >> 2), k = (kk & ~0xC) | ((kk & 4) << 1) | ((kk & 8) >> 1), c = (st & 3) * 32 + (gi & 3) * 8; vof1 = (unsigned)((k * D + c) * 2); } }
  const int vbl = (int)(unsigned)(uintptr_t)lds + 16384 + v_rd_base(lane);
  const int NT = a.NT; const float qinit = -a.m_init;
#define KROW(j) (((j) < a.n0) ? (a.base0 + 64 * (j)) : (a.base1 + 64 * ((j) - a.n0)))
#define ADMA(t_) do { const int tc_ = (t_) < NT ? (t_) : NT - 1; const long k0_ = KROW(tc_);     \
    const char* kt_ = (const char*)(a.K + k0_ * D); const char* vt_ = (const char*)(a.V + k0_ * D);                     \
    LAS unsigned char* sb_ = (LAS unsigned char*)lds + ((t_) & 3) * 32768 + wid * 1024;                                                                                   \
    __builtin_amdgcn_global_load_lds((const unsigned*)(kt_ + kof0), (LAS unsigned*)(sb_), 16, 0, 0);                                                                      \
    __builtin_amdgcn_global_load_lds((const unsigned*)(kt_ + kof1), (LAS unsigned*)(sb_ + 8192), 16, 0, 0);                                                               \
    __builtin_amdgcn_global_load_lds((const unsigned*)(vt_ + vof0), (LAS unsigned*)(sb_ + 16384), 16, 0, 0);                                                              \
    __builtin_amdgcn_global_load_lds((const unsigned*)(vt_ + vof1), (LAS unsigned*)(sb_ + 16384 + 8192), 16, 0, 0); } while (0)
#define KS(t_) (lds + ((t_) & 3) * 32768)
#define VB(t_) (vbl + ((t_) & 3) * 32768)
#define TILE_SYNC(more) do { SBAR(); asm volatile("s_waitcnt vmcnt(4)" ::: "memory"); __builtin_amdgcn_s_barrier(); SBAR(); } while (0)
#define R1_PIPE() do { if (ATT_PIPE) { if (ATT_PREK) __builtin_amdgcn_sched_group_barrier(0x100, 2, 0);                                                                 \
    _Pragma("unroll") for (int s_ = 0; s_ < 8; ++s_) { __builtin_amdgcn_sched_group_barrier(0x100, 2, 0);                                                                 \
      __builtin_amdgcn_sched_group_barrier(0x008, 1, 0); __builtin_amdgcn_sched_group_barrier(0x402, ATT_PIPE, 0);                                                        \
      __builtin_amdgcn_sched_group_barrier(0x008, 1, 0); __builtin_amdgcn_sched_group_barrier(0x402, ATT_PIPE, 0); } } } while (0)
#if ATT_PREK
#define QKT qkt_pf
#else
#define QKT qkt
#endif
  f32x16 pA0, pA1, pB0, pB1; bf16x8 pa0, pa1, pa2, pa3; float m_reg = a.m_init, mnA, alA;
  ADMA(0); ADMA(1);
  TILE_SYNC(true);
  qkt(pA0, pA1, KS(0), qr, r32, hi, qinit); partialSM<false, FIX>(pA0, pA1, m_reg, mnA, alA, 0, hi);
  ADMA(2);
  TILE_SYNC(2 < NT);
  for (int t = 1; t + 1 < NT; t += 2) {
    ADMA(t + 2);
    SBAR(); QKT(pB0, pB1, KS(t), qr, r32, hi, qinit);
    finishSM<FIX>(pA0, pA1, 1.f, l_reg, pa0, pa1, pa2, pa3); R1_PIPE(); SBAR();
    pv_d0<true>(o, VB(t - 1), pa0, pa1, pa2, pa3, pB0);
    TILE_SYNC(t + 2 < NT);
    ADMA(t + 3);
    SBAR(); QKT(pA0, pA1, KS(t + 1), qr, r32, hi, qinit);
    finishSM<FIX>(pB0, pB1, 1.f, l_reg, pa0, pa1, pa2, pa3); R1_PIPE(); SBAR();
    pv_d0<true>(o, VB(t), pa0, pa1, pa2, pa3, pA0);
    TILE_SYNC(t + 3 < NT);
  }
  SBAR(); qkt(pB0, pB1, KS(NT - 1), qr, r32, hi, qinit);
  finishSM<FIX>(pA0, pA1, 1.f, l_reg, pa0, pa1, pa2, pa3); SBAR();
  pv_d0<true>(o, VB(NT - 2), pa0, pa1, pa2, pa3, pB0);
  finishSM<FIX>(pB0, pB1, 1.f, l_reg, pa0, pa1, pa2, pa3); SBAR();
  pv_d0<false>(o, VB(NT - 1), pa0, pa1, pa2, pa3, pB0);
  if (hi == 0) li_l[r32] = l_reg; asm volatile("s_waitcnt lgkmcnt(0)" ::: "memory");
  float rli[16];
#pragma unroll
  for (int r = 0; r < 16; ++r) rli[r] = __builtin_amdgcn_rcpf(li_l[crow(r, hi)]);
  bf16_t* Ow = a.O + (long)(wid * QBLK) * a.ldo;
#pragma unroll
  for (int r = 0; r < 16; ++r) { int orow = crow(r, hi);
#pragma unroll
    for (int d0 = 0; d0 < 4; ++d0) { const float v = o[d0][r] * rli[r]; Ow[(long)orow * a.ldo + d0 * 32 + r32] = (bf16_t)(cvt_pk_bf16(v, v) & 0xffffu); } }
  __syncthreads();
#undef KROW
#undef ADMA
#undef KS
#undef VB
#undef TILE_SYNC
#undef QKT
#undef R1_PIPE
}
}
namespace ml {
using namespace att;
struct Args { const bf16_t* Q; const bf16_t* K; const bf16_t* V; const float* GI; const float* GF; float* HM; int dir, ctx_out; };
constexpr int G_A = 0, G_M = 512, G_EBM = 1024, G_WINT = 1536, G_WK = 2048, G_STRIDE = 2560;
constexpr int SM_N = 5120, SM_RDEN = 5632, SM_SCAL = 6656, SM_NACC = 6720;

__device__ __forceinline__ void chunk_map(int c, int dir, int& P0, int& sgn) {
  const int cc = c < 2 ? c : c - 2, pbase = c < 2 ? SEQ : 0, nseg = c < 2 ? CTXL : SEQ;
  if (dir == 0) { P0 = pbase + cc * 128; sgn = 1; } else { P0 = pbase + nseg - 1 - cc * 128; sgn = -1; }
}
__device__ __forceinline__ float scan_add(float x, int lane) {
#pragma unroll
  for (int o = 1; o < 64; o <<= 1) { const float t = __int_as_float(__builtin_amdgcn_ds_bpermute((lane - o) << 2, __float_as_int(x))); if (lane >= o) x += t; }
  return x;
}
__device__ __forceinline__ float scan_max(float x, int lane) {
#pragma unroll
  for (int o = 1; o < 64; o <<= 1) { const float t = __int_as_float(__builtin_amdgcn_ds_bpermute((lane - o) << 2, __float_as_int(x))); if (lane >= o) x = fmaxf(x, t); }
  return x;
}
__device__ __forceinline__ void gate_tables(LAS char* gt, LAS float* scal, float ig0, float ig1, float lf0, float lf1, float m_prev, int lane) {
  float b0 = scan_add(lf0, lane); const float t0 = __int_as_float(__builtin_amdgcn_readlane(__float_as_int(b0), 63)); float b1 = scan_add(lf1, lane) + t0;
  const float a0 = ig0 - b0, a1 = ig1 - b1;
  float A0 = scan_max(a0, lane); const float tA = __int_as_float(__builtin_amdgcn_readlane(__float_as_int(A0), 63)); float A1 = fmaxf(scan_max(a1, lane), tA);
  const float M0 = fmaxf(m_prev, A0), M1 = fmaxf(m_prev, A1), Ml = __int_as_float(__builtin_amdgcn_readlane(__float_as_int(M1), 63)), bl = __int_as_float(__builtin_amdgcn_readlane(__float_as_int(b1), 63));
  LAS float* fa = (LAS float*)(gt + G_A); LAS float* fM = (LAS float*)(gt + G_M); LAS float* fe = (LAS float*)(gt + G_EBM); LAS float* fw = (LAS float*)(gt + G_WINT); LAS float* fk = (LAS float*)(gt + G_WK);
  fa[lane] = a0; fa[64 + lane] = a1; fM[lane] = M0; fM[64 + lane] = M1;
  fe[lane] = __expf(-(b0 + M0)); fe[64 + lane] = __expf(-(b1 + M1));
  fw[lane] = __expf(m_prev - M0); fw[64 + lane] = __expf(m_prev - M1);
  fk[lane] = __expf(a0 - Ml); fk[64 + lane] = __expf(a1 - Ml);
  if (lane == 0) { scal[0] = __expf(m_prev - Ml); scal[1] = bl + Ml; }
}

struct ScanArgs { const bf16_t* K; const bf16_t* V; const float* GI; const float* GF; unsigned char* CIMG; float* NST; float* GT; unsigned* prog; int dir; };
struct OutArgs { const bf16_t* Q; const bf16_t* K; const bf16_t* V; const unsigned char* CIMG; const float* NST; const float* GT; float* HM; unsigned* prog; int dir, c; };
__device__ __forceinline__ void st_sc1_u64(void* p, unsigned long long v) { __hip_atomic_store((unsigned long long*)p, v, __ATOMIC_RELAXED, __HIP_MEMORY_SCOPE_AGENT); }
__device__ __forceinline__ void st_sc1_f32(float* p, float v) { __hip_atomic_store((unsigned*)p, __float_as_uint(v), __ATOMIC_RELAXED, __HIP_MEMORY_SCOPE_AGENT); }

__device__ __forceinline__ void mlstm_scan(const ScanArgs a, LAS char* lds, int wave) {
  int tid = tid_of(wave); const int wid = wave, jb = wid & 3, eh = wid >> 2;
  int lane = tid & 63, r32 = lane & 31, hi = lane >> 5;
  LAS char* V_lds = lds; LAS char* KW_lds = lds + 32768; LAS char* CS_lds = lds + 65536; LAS float* WK = (LAS float*)(lds + 98304);
  LAS float* sm = (LAS float*)(lds + ML_SM); LAS float* AL = sm; LAS float* BL = sm + 64; LAS float* MC = sm + 128; LAS float* DEC = sm + 192;
  float ga0[5], ga1[5], gb0[5], gb1[5], gA0[5], gA1[5];
#pragma unroll
  for (int i = 0; i < 5; ++i) { const int c = wid + 8 * i;
    if (c < 34) { int P0, sg; chunk_map(c, a.dir, P0, sg);
      const float i0 = a.GI[P0 + sg * lane], i1 = a.GI[P0 + sg * (64 + lane)], f0 = a.GF[P0 + sg * lane], f1 = a.GF[P0 + sg * (64 + lane)];
      float b0 = scan_add(f0, lane); const float t0 = __int_as_float(__builtin_amdgcn_readlane(__float_as_int(b0), 63)); float b1 = scan_add(f1, lane) + t0;
      const float a0 = i0 - b0, a1 = i1 - b1;
      float A0 = scan_max(a0, lane); const float tA = __int_as_float(__builtin_amdgcn_readlane(__float_as_int(A0), 63)); float A1 = fmaxf(scan_max(a1, lane), tA);
      ga0[i] = a0; ga1[i] = a1; gb0[i] = b0; gb1[i] = b1; gA0[i] = A0; gA1[i] = A1;
      if (lane == 63) { AL[c] = A1; BL[c] = b1; } } }
  if (tid < 128) st_sc1_f32(a.NST + tid, 0.f);
#pragma unroll
  for (int i = 0; i < 8; ++i) st_sc1_u64(a.CIMG + (size_t)tid * 64 + i * 8, 0ull);
  __syncthreads();
  if (tid == 0) { float mm = -1e30f; for (int c = 0; c < 34; ++c) { const float Ml = fmaxf(mm, AL[c]); MC[c] = mm; DEC[c] = __expf(mm - Ml); mm = BL[c] + Ml; } }
  __syncthreads();
#pragma unroll
  for (int i = 0; i < 5; ++i) { const int c = wid + 8 * i;
    if (c < 34) { const float mm = MC[c], Ml = fmaxf(mm, AL[c]); float* d = a.GT + (size_t)c * 512;
      const float M0 = fmaxf(mm, gA0[i]), M1 = fmaxf(mm, gA1[i]);
      st_sc1_f32(d + lane, ga0[i]); st_sc1_f32(d + 64 + lane, ga1[i]); st_sc1_f32(d + 128 + lane, M0); st_sc1_f32(d + 192 + lane, M1);
      st_sc1_f32(d + 256 + lane, __expf(-(gb0[i] + M0))); st_sc1_f32(d + 320 + lane, __expf(-(gb1[i] + M1)));
      st_sc1_f32(d + 384 + lane, __expf(mm - M0)); st_sc1_f32(d + 448 + lane, __expf(mm - M1));
      WK[c * 128 + lane] = __expf(ga0[i] - Ml); WK[c * 128 + 64 + lane] = __expf(ga1[i] - Ml); } }
  f32x16 cst[2] = {}, nst = {};
  int sr = tid >> 4, sc = (tid & 15) * 8;
  int vbV = (int)(unsigned)(uintptr_t)V_lds + v_rd_base(lane) + eh * 1024;
  int vbKW = (int)(unsigned)(uintptr_t)KW_lds + v_rd_base(lane) + jb * 512;
  bf16x8 stK[4], stV[4];
#define ML_LOADKV(c) do { int P0_, sg_; chunk_map((c), a.dir, P0_, sg_); _Pragma("unroll") for (int i = 0; i < 4; ++i) { const long pos = P0_ + sg_ * (sr + 32 * i); \
    stK[i] = *reinterpret_cast<const bf16x8*>(a.K + pos * 128 + sc); stV[i] = *reinterpret_cast<const bf16x8*>(a.V + pos * 128 + sc); } } while (0)
#define ML_WRITEKV(c) do { const LAS float* fk_ = WK + (c) * 128; _Pragma("unroll") for (int i = 0; i < 4; ++i) { const int s = sr + 32 * i, tl = s >> 6, rr = s & 63; \
    *(LAS bf16x8*)(V_lds + tl * 16384 + v_st(rr, sc)) = stV[i]; \
    const float w_ = fk_[s]; const u32x4 kk = *reinterpret_cast<const u32x4*>(&stK[i]); u32x4 o_; \
    o_.x = cvt_pk_bf16(bflo(kk.x) * w_, bfhi(kk.x) * w_); o_.y = cvt_pk_bf16(bflo(kk.y) * w_, bfhi(kk.y) * w_); o_.z = cvt_pk_bf16(bflo(kk.z) * w_, bfhi(kk.z) * w_); o_.w = cvt_pk_bf16(bflo(kk.w) * w_, bfhi(kk.w) * w_); \
    *(LAS u32x4*)(KW_lds + tl * 16384 + v_st(rr, sc)) = o_; } } while (0)
  ML_LOADKV(0);
  __syncthreads();
  const bf16x8 ones = (bf16x8){(short)0x3F80, (short)0x3F80, (short)0x3F80, (short)0x3F80, (short)0x3F80, (short)0x3F80, (short)0x3F80, (short)0x3F80};
  for (int c = 0; c < 33; ++c) {
    asm volatile("" : "+v"(tid)); lane = tid & 63; r32 = lane & 31; hi = lane >> 5; sr = tid >> 4; sc = (tid & 15) * 8;
    vbV = (int)(unsigned)(uintptr_t)V_lds + v_rd_base(lane) + eh * 1024; vbKW = (int)(unsigned)(uintptr_t)KW_lds + v_rd_base(lane) + jb * 512;
    ML_WRITEKV(c);
    if (c < 32) ML_LOADKV(c + 1);
    const float decay = DEC[c];
    __syncthreads();
#pragma unroll
    for (int r = 0; r < 16; ++r) { cst[0][r] *= decay; cst[1][r] *= decay; nst[r] *= decay; }
#pragma unroll
    for (int t = 0; t < 2; ++t) {
#define ML_UPD(KS) do { const s16x4 kl = tr_read<v_rd_off(0, KS, 0)>(vbKW + t * 16384), kh = tr_read<v_rd_off(0, KS, 1)>(vbKW + t * 16384); \
      const s16x4 v0l = tr_read<v_rd_off(0, KS, 0)>(vbV + t * 16384), v0h = tr_read<v_rd_off(0, KS, 1)>(vbV + t * 16384); \
      const s16x4 v1l = tr_read<v_rd_off(1, KS, 0)>(vbV + t * 16384), v1h = tr_read<v_rd_off(1, KS, 1)>(vbV + t * 16384); \
      asm volatile("s_waitcnt lgkmcnt(0)" ::: "memory"); SBAR(); \
      const bf16x8 ka = PKV(kl, kh); \
      cst[0] = __builtin_amdgcn_mfma_f32_32x32x16_bf16(ka, PKV(v0l, v0h), cst[0], 0, 0, 0); \
      cst[1] = __builtin_amdgcn_mfma_f32_32x32x16_bf16(ka, PKV(v1l, v1h), cst[1], 0, 0, 0); \
      nst = __builtin_amdgcn_mfma_f32_32x32x16_bf16(ka, ones, nst, 0, 0, 0); } while (0)
      ML_UPD(0); ML_UPD(1); ML_UPD(2); ML_UPD(3);
#undef ML_UPD
    }
#pragma unroll
    for (int i = 0; i < 2; ++i)
#pragma unroll
      for (int r = 0; r < 16; ++r) { const int dk = jb * 32 + crow(r, hi), e = (2 * eh + i) * 32 + r32;
        *(LAS bf16_t*)(CS_lds + (dk >> 6) * 16384 + v_st(dk & 63, e)) = (bf16_t)(cvt_pk_bf16(cst[i][r], cst[i][r]) & 0xffffu); }
    if (eh == 0 && r32 == 0) {
#pragma unroll
      for (int r = 0; r < 16; ++r) st_sc1_f32(a.NST + (size_t)(c + 1) * 128 + jb * 32 + crow(r, hi), nst[r]); }
    __syncthreads();
    { unsigned char* dst = a.CIMG + (size_t)(c + 1) * 32768 + (size_t)tid * 64; const LAS unsigned long long* src = (const LAS unsigned long long*)(CS_lds + tid * 64);
#pragma unroll
      for (int i = 0; i < 8; ++i) st_sc1_u64(dst + i * 8, src[i]); }
#ifdef SCAN_PUB_EACH
    VM_WAIT(); __syncthreads();
#endif
  }
#undef ML_LOADKV
#undef ML_WRITEKV
  VM_WAIT(); __syncthreads();
  if (tid == 0) __hip_atomic_store(a.prog, 34u, __ATOMIC_RELAXED, __HIP_MEMORY_SCOPE_AGENT);
  __syncthreads();
}

__device__ __forceinline__ void mlstm_out(const OutArgs a, LAS char* lds, int wave) {
  const int tid = tid_of(wave), wid = wave, jb = wid & 3, eh = wid >> 2, lane = tid & 63, r32 = lane & 31, hi = lane >> 5;
  LAS char* K_lds = lds; LAS char* V_lds = lds + 32768; LAS char* C_lds = lds + 65536; LAS char* sm = lds + ML_SM;
  LAS float* n_lds = (LAS float*)(sm + SM_N); LAS float* rden = (LAS float*)(sm + SM_RDEN) + wid * 32;
  if (wid == 0) { unsigned sp = 0; while (__hip_atomic_load(a.prog, __ATOMIC_RELAXED, __HIP_MEMORY_SCOPE_AGENT) < (unsigned)(a.c + 1)) { __builtin_amdgcn_s_sleep(4); if (++sp > (1u << 22)) break; }
    __builtin_amdgcn_fence(__ATOMIC_ACQUIRE, "agent"); VM_WAIT(); }
  __syncthreads();
  const int sr = tid >> 4, sc = (tid & 15) * 8;
  int P0, sgn; chunk_map(a.c, a.dir, P0, sgn);
  bf16x8 qr[8];
  { bf16x8 stK[4], stV[4]; u32x4 ci[4];
#pragma unroll
    for (int i = 0; i < 4; ++i) { const long pos = P0 + sgn * (sr + 32 * i); stK[i] = *reinterpret_cast<const bf16x8*>(a.K + pos * 128 + sc); stV[i] = *reinterpret_cast<const bf16x8*>(a.V + pos * 128 + sc); }
#pragma unroll
    for (int i = 0; i < 4; ++i) ci[i] = __builtin_nontemporal_load((const u32x4*)(a.CIMG + (size_t)tid * 64 + i * 16));
    { const long pos = P0 + sgn * (jb * 32 + r32);
#pragma unroll
      for (int d0 = 0; d0 < 8; ++d0) qr[d0] = __builtin_nontemporal_load(reinterpret_cast<const bf16x8*>(a.Q + pos * 128 + d0 * 16 + hi * 8)); }
    if (tid < 128) { LAS float* g = (LAS float*)sm;
#pragma unroll
      for (int q = 0; q < 4; ++q) g[q * 128 + tid] = __builtin_nontemporal_load(a.GT + q * 128 + tid);
      n_lds[tid] = __builtin_nontemporal_load(a.NST + tid); }
#pragma unroll
    for (int i = 0; i < 4; ++i) { const int s = sr + 32 * i, tl = s >> 6, rr = s & 63;
      *(LAS bf16x8*)(K_lds + tl * 16384 + KSWZ(rr, sc * 2)) = stK[i]; *(LAS bf16x8*)(V_lds + tl * 16384 + v_st(rr, sc)) = stV[i]; }
#pragma unroll
    for (int i = 0; i < 4; ++i) *(LAS u32x4*)(C_lds + tid * 64 + i * 16) = ci[i];
  }
  __syncthreads();
  const int vbV = (int)(unsigned)(uintptr_t)V_lds + v_rd_base(lane) + eh * 1024, vbC = (int)(unsigned)(uintptr_t)C_lds + v_rd_base(lane) + eh * 1024;
  const LAS float* fa = (const LAS float*)(sm + G_A); const LAS float* fM = (const LAS float*)(sm + G_M); const LAS float* fe = (const LAS float*)(sm + G_EBM); const LAS float* fw = (const LAS float*)(sm + G_WINT);
  const int j = jb * 32 + r32; const float Mj = fM[j], wintj = fw[j];
  f32x16 o[2] = {};
  pv_one<0>(o[0], vbC, qr[0], qr[1], qr[2], qr[3]); pv_one<1>(o[1], vbC, qr[0], qr[1], qr[2], qr[3]);
  pv_one<0>(o[0], vbC + 16384, qr[4], qr[5], qr[6], qr[7]); pv_one<1>(o[1], vbC + 16384, qr[4], qr[5], qr[6], qr[7]);
#pragma unroll
  for (int r = 0; r < 16; ++r) { const float w = fw[jb * 32 + crow(r, hi)]; o[0][r] *= w; o[1][r] *= w; }
  float qn = 0.f;
#pragma unroll
  for (int d0 = 0; d0 < 8; ++d0) { const u32x4 qq = *reinterpret_cast<const u32x4*>(&qr[d0]); const f32x4 n0 = *(const LAS f32x4*)(n_lds + d0 * 16 + hi * 8), n1 = *(const LAS f32x4*)(n_lds + d0 * 16 + hi * 8 + 4);
    qn += bflo(qq.x) * n0[0] + bfhi(qq.x) * n0[1] + bflo(qq.y) * n0[2] + bfhi(qq.y) * n0[3] + bflo(qq.z) * n1[0] + bfhi(qq.z) * n1[1] + bflo(qq.w) * n1[2] + bfhi(qq.w) * n1[3]; }
  { auto rr = __builtin_amdgcn_permlane32_swap(__float_as_uint(qn), __float_as_uint(qn), false, false); qn = __uint_as_float(rr[0]) + __uint_as_float(rr[1]); }
  float den = wintj * qn;
#pragma unroll
  for (int t = 0; t < 2; ++t) {
    if (t * 64 <= jb * 32 + 31) {
      f32x16 p0, p1; qkt(p0, p1, K_lds + t * 16384, qr, r32, hi);
      float ps = 0.f;
#pragma unroll
      for (int r = 0; r < 16; ++r) { const int s0 = t * 64 + crow(r, hi), s1 = s0 + 32;
        const float e0 = __expf(fa[s0] - Mj), e1 = __expf(fa[s1] - Mj);
        p0[r] = (s0 <= j) ? p0[r] * e0 : 0.f; p1[r] = (s1 <= j) ? p1[r] * e1 : 0.f; ps += p0[r] + p1[r]; }
      { auto rr = __builtin_amdgcn_permlane32_swap(__float_as_uint(ps), __float_as_uint(ps), false, false); ps = __uint_as_float(rr[0]) + __uint_as_float(rr[1]); }
      den += ps;
      bf16x8 pa0, pa1, pa2, pa3; PK4(p0, 0, pa0); PK4(p0, 8, pa1); PK4(p1, 0, pa2); PK4(p1, 8, pa3);
      pv_one<0>(o[0], vbV + t * 16384, pa0, pa1, pa2, pa3); pv_one<1>(o[1], vbV + t * 16384, pa0, pa1, pa2, pa3);
    }
  }
  const float rd = __builtin_amdgcn_rcpf(fmaxf(fabsf(den), fe[j]));
  if (hi == 0) rden[r32] = rd;
  asm volatile("s_waitcnt lgkmcnt(0)" ::: "memory");
  float* hp = a.HM + ((size_t)a.c * 128 + jb * 32 + 4 * hi) * 128 + eh * 64 + r32;
#pragma unroll
  for (int r = 0; r < 16; ++r) { const int jr = (r & 3) + 8 * (r >> 2); const float rv = rden[jr + 4 * hi];
    hp[jr * 128] = o[0][r] * rv; hp[jr * 128 + 32] = o[1][r] * rv; }
  __syncthreads();
}
}
struct Frame {
    char* lds; LAS unsigned char* lds3; volatile LAS unsigned* LC; unsigned* ctl; unsigned char* ws;
    int tid, lane, wave, G, bid;
    const float* const __attribute__((address_space(4)))* karg;
};
__device__ __forceinline__ const float* inp(const Frame& F, int k) { auto p = F.karg; asm volatile("" : "+s"(p)); return p[k]; }
__device__ __forceinline__ unsigned char* wsp_(const Frame& F) { auto p = F.karg; asm volatile("" : "+s"(p)); return (unsigned char*)p[29]; }
__device__ __forceinline__ float* outp(const Frame& F) { auto p = F.karg; asm volatile("" : "+s"(p)); return (float*)p[28]; }
#define WSP(T, off) ((T*)(F.ws + (off)))

__device__ __forceinline__ void p_mod_partial(Frame& F) {
    float* sv = (float*)F.lds;
    float* MODP = WSP(float, WS_P1);
    for (int it = F.bid; it < 2 * 32 * 6; it += F.G) {
        const int l = it / 192, ks = (it % 192) / 6, cc = it % 6, k0 = ks * 64, n = cc * 2048 + F.tid * 4;
        __syncthreads();
        for (int i = F.tid; i < 320; i += NTHR) { const int r = i >> 6, k = i & 63; const float c = (r < 4) ? inp(F, 1)[r * DM + k0 + k] : inp(F, 3)[k0 + k]; sv[i] = siluf_(c); }
        __syncthreads();
        const float* w = inp(F, 6) + (size_t)l * DM * 12288 + (size_t)k0 * 12288 + n;
        f32x4 a0 = {0.f, 0.f, 0.f, 0.f}, a1 = a0, a2 = a0, a3 = a0, a4 = a0;
#pragma unroll 16
        for (int k = 0; k < 64; ++k) { const f32x4 wv = __builtin_nontemporal_load((const f32x4*)(w + (size_t)k * 12288)); a0 += sv[k] * wv; a1 += sv[64 + k] * wv; a2 += sv[128 + k] * wv; a3 += sv[192 + k] * wv; a4 += sv[256 + k] * wv; }
        float* o = MODP + ((size_t)(l * 32 + ks) * 5) * 12288 + n;
        *(f32x4*)(o) = a0; *(f32x4*)(o + 12288) = a1; *(f32x4*)(o + 2 * 12288) = a2; *(f32x4*)(o + 3 * 12288) = a3; *(f32x4*)(o + 4 * 12288) = a4;
    }
    __syncthreads();
}
__device__ __forceinline__ void p_rope_tables(Frame& F) {
    float* ct = WSP(float, WS_ROPE); float* st = ct + SEQ * 64;
    for (int i = F.bid * NTHR + F.tid; i < SEQ * 64; i += F.G * NTHR) {
        const int t = i >> 6, j = i & 63, ax = j >> 5, f = j & 31;
        const float inv = powf(10000.0f, -(float)(2 * f) / 64.0f);
        const float ang = (float)(ax == 0 ? (t >> 6) : (t & 63)) * inv;
        ct[i] = __cosf(ang); st[i] = __sinf(ang);
    }
    float* WRT = (float*)(F.ws + WS_ROUTE + RT_WRT);
    for (int i = F.bid * NTHR + F.tid; i < 2 * 5 * 2048; i += F.G * NTHR) {
        const int k = i & 2047, pl = (i >> 11) % 5, l = i / (5 * 2048);
        const int j = k >> 8, lane = (k >> 2) & 63, ii = k & 3, ji = j * 4 + ii;
        const float* src = pl == 0 ? inp(F, 20) + ((size_t)l * DM + k) * 4 : inp(F, 22) + ((size_t)l * DM + k) * 16 + (pl - 1) * 4;
        *(f32x4*)(WRT + ((size_t)((l * 5 + pl) * 32 + ji) * 64 + lane) * 4) = *(const f32x4*)src;
    }
}
__device__ __forceinline__ void p_mod_reduce(Frame& F) {
    const float* MODP = WSP(float, WS_P1); float* MOD = WSP(float, WS_MOD);
    for (int i = F.bid * NTHR + F.tid; i < 2 * 5 * 12288; i += F.G * NTHR) {
        const int l = i / 61440, r = (i % 61440) / 12288, n = i % 12288;
        float s = inp(F, 7)[l * 12288 + n];
#pragma unroll
        for (int ks = 0; ks < 32; ++ks) s += MODP[((size_t)(l * 32 + ks) * 5 + r) * 12288 + n];
        MOD[i] = s;
    }
}
struct TrItem { const float* src; size_t lds_; int k0, ns0, nvalid; bf16_t* dst; size_t ldd; int kd0, mode, rowbase; const unsigned* wmax; };
struct TrRegs { f32x4 ld[8]; };
__device__ __forceinline__ void tr_load(const TrItem& d, TrRegs& r, int lane) {
    const int c4 = (lane & 7) * 4, r0 = lane >> 3;
#pragma unroll
    for (int i = 0; i < 8; ++i) r.ld[i] = (c4 < d.nvalid) ? __builtin_nontemporal_load((const f32x4*)(d.src + (size_t)(d.k0 + i * 8 + r0) * d.lds_ + d.ns0 + c4)) : (f32x4){0.f, 0.f, 0.f, 0.f};
}
__device__ __forceinline__ void tr_store(const TrItem& d, const TrRegs& r, float* scr, int lane) {
    const int c4 = (lane & 7) * 4, r0 = lane >> 3;
#pragma unroll
    for (int i = 0; i < 8; ++i) { float* p = scr + (i * 8 + r0) * 33 + c4; p[0] = r.ld[i][0]; p[1] = r.ld[i][1]; p[2] = r.ld[i][2]; p[3] = r.ld[i][3]; }
    LDS_WAIT(); asm volatile("" ::: "memory");
    const int c = lane & 7;
    if (d.mode & 2) {
#pragma unroll
        for (int j = 0; j < 4; ++j) { const int n = (lane >> 3) + 8 * j; const float* s = scr + (8 * c) * 33 + n;
            const int drow = (d.mode & 1) ? d.rowbase + 8 * (n >> 2) + (n & 3) : d.rowbase + n;
            const float mx = __uint_as_float(d.wmax[drow]); const float sc = mx > 0.f ? 127.0f / mx : 0.f; unsigned q[8];
#pragma unroll
            for (int i = 0; i < 8; ++i) q[i] = (unsigned)((int)rintf(s[i * 33] * sc) & 0xff);
            u32x2 o; o.x = q[0] | (q[1] << 8) | (q[2] << 16) | (q[3] << 24); o.y = q[4] | (q[5] << 8) | (q[6] << 16) | (q[7] << 24);
            *(u32x2*)((unsigned char*)(d.dst + (size_t)drow * d.ldd) + d.kd0 + 8 * c) = o; }
        LDS_WAIT(); asm volatile("" ::: "memory");
        return;
    }
#pragma unroll
    for (int j = 0; j < 4; ++j) { const int n = (lane >> 3) + 8 * j; const float* s = scr + (8 * c) * 33 + n;
        u32x4 o; o.x = cvt_pk_bf16(s[0 * 33], s[1 * 33]); o.y = cvt_pk_bf16(s[2 * 33], s[3 * 33]); o.z = cvt_pk_bf16(s[4 * 33], s[5 * 33]); o.w = cvt_pk_bf16(s[6 * 33], s[7 * 33]);
        const int drow = (d.mode & 1) ? d.rowbase + 8 * (n >> 2) + (n & 3) : d.rowbase + n;
        *(u32x4*)(d.dst + (size_t)drow * d.ldd + d.kd0 + 8 * c) = o; }
    LDS_WAIT(); asm volatile("" ::: "memory");
}
struct CvtCtx { bf16_t *WIN, *WBR, *WOUT, *WGU, *WD; const float *w_in, *w_a, *w_m, *w_c, *w_o, *w_g, *w_u, *w_d; const unsigned* wmax; const unsigned* wmax2; };
__device__ __forceinline__ TrItem tr_decode(const CvtCtx& C, int it) {
    constexpr int I_IN = 344 * 32, I_A = 16 * 64, I_M = 8 * 64, I_O = 32 * 64, I_G = NEXP * 32 * 16;
    int r = it;
    if (r < I_IN) { const int nb = r >> 5, kb = r & 31;
        int ns0, nv; if (nb < 112) { ns0 = nb * 32; nv = 32; } else if (nb < 336) { ns0 = nb * 32 + 16; nv = 32; } else if (nb == 336) { ns0 = 3584; nv = 16; } else { ns0 = 0; nv = 0; }
        if (nb < 144) return TrItem{C.w_in, (size_t)PIN, kb * 64, ns0, nv, C.WIN + (size_t)4608 * DM, (size_t)1024, kb * 64, 2, 6144 + nb * 32, C.wmax};
        if (nb >= 144 && nb < 336) return TrItem{C.w_in, (size_t)PIN, kb * 64, ns0, nv, C.WIN + (size_t)4608 * DM, (size_t)1024, kb * 64, 2, (nb - 144) * 32, C.wmax};
        return TrItem{C.w_in, (size_t)PIN, kb * 64, ns0, nv, C.WIN, (size_t)DM, kb * 64, 0, nb * 32, nullptr}; } r -= I_IN;
    if (r < I_A) { const int kb = r >> 6, nb = r & 63; return TrItem{C.w_a, (size_t)DM, kb * 64, nb * 32, 32, C.WBR, (size_t)DM, kb * 64, 0, nb * 32, nullptr}; } r -= I_A;
    if (r < I_M) { const int kb = r >> 6, nb = r & 63; return TrItem{C.w_m, (size_t)DM, kb * 64, nb * 32, 32, C.WBR, (size_t)DM, 1024 + kb * 64, 0, nb * 32, nullptr}; } r -= I_M;
    if (r < I_M) { const int kb = r >> 6, nb = r & 63; return TrItem{C.w_c, (size_t)DM, kb * 64, nb * 32, 32, C.WBR, (size_t)DM, 1536 + kb * 64, 0, nb * 32, nullptr}; } r -= I_M;
    if (r < I_O) { const int kb = r >> 6, nb = r & 63; return TrItem{C.w_o, (size_t)DM, kb * 64, nb * 32, 32, C.WOUT, (size_t)DM, kb * 64, 0, nb * 32, nullptr}; } r -= I_O;
    if (r < I_G) { const int e = r >> 9, kb = (r >> 4) & 31, fb = r & 15; return TrItem{C.w_g + (size_t)e * DM * DFF, (size_t)DFF, kb * 64, fb * 32, 32, C.WGU, (size_t)1024, kb * 64, 3, e * 1024 + fb * 64, C.wmax2}; } r -= I_G;
    if (r < I_G) { const int e = r >> 9, kb = (r >> 4) & 31, fb = r & 15; return TrItem{C.w_u + (size_t)e * DM * DFF, (size_t)DFF, kb * 64, fb * 32, 32, C.WGU, (size_t)1024, kb * 64, 3, e * 1024 + fb * 64 + 4, C.wmax2}; } r -= I_G;
    { const int e = r >> 9, kb = (r >> 6) & 7, nb = r & 63; return TrItem{C.w_d + (size_t)e * DFF * DM, (size_t)DM, kb * 64, nb * 32, 32, C.WD, (size_t)DFF, kb * 64, 0, e * 2048 + nb * 32, nullptr}; }
}
__device__ __forceinline__ void p_convert_weights(Frame& F, int l, int part) {
    float* scr = (float*)(F.lds + F.wave * 16384);
    const int gw = opaque_s(F.bid * NWAVES + F.wave), NGW = F.G * NWAVES;
    CvtCtx C; C.WIN = WSP(bf16_t, WS_WIN); C.WBR = WSP(bf16_t, WS_WBR); C.WOUT = WSP(bf16_t, WS_WOUT); C.WGU = WSP(bf16_t, WS_WGU); C.WD = WSP(bf16_t, WS_WD);
    C.w_in = inp(F, 8) + (size_t)l * DM * PIN;
    C.w_a = inp(F, 16) + (size_t)l * 1024 * DM; C.w_m = inp(F, 17) + (size_t)l * 512 * DM; C.w_c = inp(F, 18) + (size_t)l * 512 * DM;
    C.w_o = inp(F, 19) + (size_t)l * DM * DM;
    C.wmax = F.ctl + CW_WMAX + l * 10752; C.wmax2 = F.ctl + CW_WMAX2 + l * 16384;
    C.w_g = inp(F, 24) + (size_t)l * NEXP * DM * DFF; C.w_u = inp(F, 25) + (size_t)l * NEXP * DM * DFF; C.w_d = inp(F, 26) + (size_t)l * NEXP * DFF * DM;
    constexpr int NIT = 344 * 32 + 16 * 64 + 2 * 8 * 64 + 32 * 64 + 2 * NEXP * 32 * 16 + NEXP * 8 * 64;
    {
        int it = gw; TrItem cur{}; TrRegs rc; bool have = false;
        for (; it < NIT; it += NGW) { cur = tr_decode(C, it); if (part == 2 || (part == 1) == ((cur.mode & 2) != 0)) { have = true; break; } }
        if (have) tr_load(cur, rc, F.lane);
        while (have) {
            TrItem nxt{}; TrRegs rn = rc; bool hn = false; int jt = it + NGW;
            for (; jt < NIT; jt += NGW) { nxt = tr_decode(C, jt); if (part == 2 || (part == 1) == ((nxt.mode & 2) != 0)) { hn = true; break; } }
            if (hn) tr_load(nxt, rn, F.lane);
            tr_store(cur, rc, scr, F.lane);
            cur = nxt; rc = rn; have = hn; it = jt;
        }
    }
    if (part != 0) { float* ws8 = WSP(float, WS_WS8) + l * 10752;
        const int i = F.bid * NTHR + F.tid; if (i < 10752) ws8[i] = __uint_as_float(C.wmax[i]) * (1.0f / 127.0f);
        float* wgs = (float*)(F.ws + WS_ROUTE + RT_WGS) + l * 16384; if (i < 16384) wgs[i] = __uint_as_float(C.wmax2[i]) * (1.0f / 127.0f); }
}

__device__ __forceinline__ TrItem i8_strip_item(const CvtCtx& C, int s, int kb) {
    if (s < 337) { const int nb = s, ns0 = nb < 112 ? nb * 32 : (nb < 336 ? nb * 32 + 16 : 3584), rowbase = nb < 144 ? 6144 + nb * 32 : (nb < 336 ? (nb - 144) * 32 : 10752);
        return TrItem{C.w_in, (size_t)PIN, kb * 64, ns0, nb == 336 ? 16 : 32, C.WIN + (size_t)4608 * DM, (size_t)1024, kb * 64, 2, rowbase, nullptr}; }
    const int r = s - 337, e = r >> 5, mat = (r >> 4) & 1, fb = r & 15;
    return TrItem{(mat ? C.w_u : C.w_g) + (size_t)e * DM * DFF, (size_t)DFF, kb * 64, fb * 32, 32, C.WGU, (size_t)1024, kb * 64, 3, e * 1024 + fb * 64 + mat * 4, nullptr};
}
__device__ __forceinline__ void tr_store_i8(const TrItem& d, const TrRegs& r, float* scr, int lane, const float (&cmv)[4]) {
    const int c4 = (lane & 7) * 4, r0 = lane >> 3;
#pragma unroll
    for (int i = 0; i < 8; ++i) { float* p = scr + (i * 8 + r0) * 33 + c4; p[0] = r.ld[i][0]; p[1] = r.ld[i][1]; p[2] = r.ld[i][2]; p[3] = r.ld[i][3]; }
    LDS_WAIT(); asm volatile("" ::: "memory");
    const int c = lane & 7;
#pragma unroll
    for (int j = 0; j < 4; ++j) { const int n = (lane >> 3) + 8 * j; const float* s = scr + (8 * c) * 33 + n;
        const int drow = (d.mode & 1) ? d.rowbase + 8 * (n >> 2) + (n & 3) : d.rowbase + n;
        const float mx = cmv[j]; const float sc = mx > 0.f ? 127.0f / mx : 0.f; unsigned q[8];
#pragma unroll
        for (int i = 0; i < 8; ++i) q[i] = (unsigned)((int)rintf(s[i * 33] * sc) & 0xff);
        u32x2 o; o.x = q[0] | (q[1] << 8) | (q[2] << 16) | (q[3] << 24); o.y = q[4] | (q[5] << 8) | (q[6] << 16) | (q[7] << 24);
        *(u32x2*)((unsigned char*)(d.dst + (size_t)drow * d.ldd) + d.kd0 + 8 * c) = o; }
    LDS_WAIT(); asm volatile("" ::: "memory");
}
__device__ __forceinline__ void p_convert_i8(Frame& F, int l) {
    float* scr = (float*)(F.lds + F.wave * 16384);
    float* mb = (float*)(F.lds + 131072);
    CvtCtx C; C.WIN = WSP(bf16_t, WS_WIN); C.WGU = WSP(bf16_t, WS_WGU);
    C.w_in = inp(F, 8) + (size_t)l * DM * PIN; C.w_g = inp(F, 24) + (size_t)l * NEXP * DM * DFF; C.w_u = inp(F, 25) + (size_t)l * NEXP * DM * DFF;
    float* ws8 = WSP(float, WS_WS8) + l * 11008; float* wgs = (float*)(F.ws + WS_ROUTE + RT_WGS) + l * 16384;
    const int kb0 = F.wave * 4;
    constexpr int NSTRIP = 337 + 512;
#define I8_ACC(R) do { _Pragma("unroll") for (int i_ = 0; i_ < 8; ++i_) _Pragma("unroll") for (int c_ = 0; c_ < 4; ++c_) m[c_] = fmaxf(m[c_], fabsf(R.ld[i_][c_])); } while (0)
    for (int s = F.bid; s < NSTRIP; s += F.G) {
        TrRegs r0, r1, r2, r3;
        tr_load(i8_strip_item(C, s, kb0), r0, F.lane); tr_load(i8_strip_item(C, s, kb0 + 1), r1, F.lane); tr_load(i8_strip_item(C, s, kb0 + 2), r2, F.lane); tr_load(i8_strip_item(C, s, kb0 + 3), r3, F.lane);
        float m[4] = {0.f, 0.f, 0.f, 0.f};
        I8_ACC(r0); I8_ACC(r1); I8_ACC(r2); I8_ACC(r3);
#pragma unroll
        for (int c = 0; c < 4; ++c) { m[c] = fmaxf(m[c], xshfl<8>(m[c])); m[c] = fmaxf(m[c], xshfl<16>(m[c])); m[c] = fmaxf(m[c], xshfl<32>(m[c])); }
        if (F.lane < 8) { float* p = mb + F.wave * 32 + F.lane * 4; p[0] = m[0]; p[1] = m[1]; p[2] = m[2]; p[3] = m[3]; }
        __syncthreads();
        float cmv[4];
#pragma unroll
        for (int j = 0; j < 4; ++j) { const int n = (F.lane >> 3) + 8 * j; const float* p = mb + n;
            cmv[j] = fmaxf(fmaxf(fmaxf(p[0], p[32]), fmaxf(p[64], p[96])), fmaxf(fmaxf(p[128], p[160]), fmaxf(p[192], p[224]))); }
        if (F.wave == 0 && F.lane < 32) { const int n = F.lane; const float* p = mb + n;
            const float cm = fmaxf(fmaxf(fmaxf(p[0], p[32]), fmaxf(p[64], p[96])), fmaxf(fmaxf(p[128], p[160]), fmaxf(p[192], p[224])));
            const TrItem d = i8_strip_item(C, s, 0); const int drow = (d.mode & 1) ? d.rowbase + 8 * (n >> 2) + (n & 3) : d.rowbase + n;
            (s < 337 ? ws8 : wgs)[drow] = cm * (1.0f / 127.0f); }
        tr_store_i8(i8_strip_item(C, s, kb0), r0, scr, F.lane, cmv); tr_store_i8(i8_strip_item(C, s, kb0 + 1), r1, scr, F.lane, cmv);
        tr_store_i8(i8_strip_item(C, s, kb0 + 2), r2, scr, F.lane, cmv); tr_store_i8(i8_strip_item(C, s, kb0 + 3), r3, scr, F.lane, cmv);
        __syncthreads();
    }
#undef I8_ACC
}

struct RowVec { f32x4 v[8]; };
__device__ __forceinline__ void row_load(RowVec& x, const float* p, int lane) {
#pragma unroll
    for (int j = 0; j < 8; ++j) x.v[j] = __builtin_nontemporal_load((const f32x4*)(p + (j * 64 + lane) * 4));
}
__device__ __forceinline__ void row_load_bf16(RowVec& x, const bf16_t* p, int lane) {
#pragma unroll
    for (int j = 0; j < 8; ++j) { const u32x2 a = __builtin_nontemporal_load((const u32x2*)(p + (j * 64 + lane) * 4)); x.v[j] = (f32x4){bflo(a.x), bfhi(a.x), bflo(a.y), bfhi(a.y)}; }
}
__device__ __forceinline__ float row_rms(const RowVec& x) {
    float s = 0.f;
#pragma unroll
    for (int j = 0; j < 8; ++j) s += (x.v[j][0] * x.v[j][0] + x.v[j][1] * x.v[j][1]) + (x.v[j][2] * x.v[j][2] + x.v[j][3] * x.v[j][3]);
    return rsqrtf(wave_sum(s) * (1.0f / DM) + EPS);
}
__device__ __forceinline__ void row_add_moe(RowVec& x, const bf16_t* MOEOUT, int d0, int d1, const float* g2, int lane) {
#pragma unroll
    for (int j = 0; j < 8; ++j) { const int c = (j * 64 + lane) * 4;
        const u32x2 a = __builtin_nontemporal_load((const u32x2*)(MOEOUT + (size_t)d0 * DM + c)), b = __builtin_nontemporal_load((const u32x2*)(MOEOUT + (size_t)d1 * DM + c)); const f32x4 g = *(const f32x4*)(g2 + c);
        x.v[j][0] += g[0] * (bflo(a.x) + bflo(b.x)); x.v[j][1] += g[1] * (bfhi(a.x) + bfhi(b.x)); x.v[j][2] += g[2] * (bflo(a.y) + bflo(b.y)); x.v[j][3] += g[3] * (bfhi(a.y) + bfhi(b.y)); }
}
__device__ __forceinline__ void row_modulate(RowVec& x, float rms, const float* ng, const float* sh, const float* sc, int lane) {
#pragma unroll
    for (int j = 0; j < 8; ++j) { const int c = (j * 64 + lane) * 4; const f32x4 g = *(const f32x4*)(ng + c), s = *(const f32x4*)(sc + c), h = *(const f32x4*)(sh + c);
        x.v[j] = (x.v[j] * rms * g) * (s + 1.0f) + h; }
}
__device__ __forceinline__ void row_store_bf16(const RowVec& x, bf16_t* p, int lane) {
#pragma unroll
    for (int j = 0; j < 8; ++j) { u32x2 o; o.x = cvt_pk_bf16(x.v[j][0], x.v[j][1]); o.y = cvt_pk_bf16(x.v[j][2], x.v[j][3]); *(u32x2*)(p + (j * 64 + lane) * 4) = o; }
}
__device__ __forceinline__ void row_store_i8(const RowVec& x, unsigned char* p, float* hs, int lane) {
    float am = 0.f;
#pragma unroll
    for (int j = 0; j < 8; ++j) am = fmaxf(am, fmaxf(fmaxf(fabsf(x.v[j][0]), fabsf(x.v[j][1])), fmaxf(fabsf(x.v[j][2]), fabsf(x.v[j][3]))));
    am = fmaxf(wave_max(am), 1e-20f); const float s = 127.0f / am;
#pragma unroll
    for (int j = 0; j < 8; ++j) { const int q0 = (int)rintf(x.v[j][0] * s), q1 = (int)rintf(x.v[j][1] * s), q2 = (int)rintf(x.v[j][2] * s), q3 = (int)rintf(x.v[j][3] * s);
        *(unsigned*)(p + (j * 64 + lane) * 4) = (unsigned)(q0 & 0xff) | ((unsigned)(q1 & 0xff) << 8) | ((unsigned)(q2 & 0xff) << 16) | ((unsigned)(q3 & 0xff) << 24); }
    if (lane == 0) *hs = am * (1.0f / 127.0f);
}
__device__ __forceinline__ void row_store_f32(const RowVec& x, float* p, int lane) {
#pragma unroll
    for (int j = 0; j < 8; ++j) *(f32x4*)(p + (j * 64 + lane) * 4) = x.v[j];
}
__device__ __forceinline__ void p_norm1(Frame& F, int l) {
    const int gw = opaque_s(F.bid * NWAVES + F.wave), NGW = F.G * NWAVES;
    const float* MOD = WSP(float, WS_MOD); bf16_t* H = WSP(bf16_t, WS_H); bf16_t* XL = WSP(bf16_t, WS_XL); bf16_t* XC = WSP(bf16_t, WS_XC);
    const bf16_t* MOEOUT = WSP(bf16_t, WS_MOEOUT); const int* SLOTD = (const int*)(F.ws + WS_ROUTE + RT_SLOTD);
    const float* ng = inp(F, 4) + l * DM;
    int nd0 = 0, nd1 = 0, nd2 = 0, nd3 = 0;
    if (l > 0 && gw * 2 < NROW) { nd0 = SLOTD[gw * 4]; nd1 = SLOTD[gw * 4 + 1]; nd2 = SLOTD[gw * 4 + 2]; nd3 = SLOTD[gw * 4 + 3]; }
    for (int r0 = gw * 2; r0 < NROW; r0 += NGW * 2) {
        const bool lat = r0 < NLAT; const int mr = lat ? (r0 >> 12) : 4;
        RowVec xa, xb;
        if (l == 0) { const float* p = lat ? inp(F, 0) + (size_t)r0 * DM : inp(F, 2) + (size_t)(r0 - NLAT) * DM; row_load(xa, p, F.lane); row_load(xb, p + DM, F.lane); }
        else { bf16_t* xp = lat ? XL + (size_t)r0 * DM : XC + (size_t)(r0 - NLAT) * DM;
            const int d0 = nd0, d1 = nd1, d2 = nd2, d3 = nd3;
            { const int rn = r0 + NGW * 2; if (rn < NROW) { nd0 = SLOTD[rn * 2]; nd1 = SLOTD[rn * 2 + 1]; nd2 = SLOTD[rn * 2 + 2]; nd3 = SLOTD[rn * 2 + 3]; } }
            row_load_bf16(xa, xp, F.lane); row_load_bf16(xb, xp + DM, F.lane);
            const float* g2 = MOD + (size_t)((l - 1) * 5 + mr) * 12288 + 10240;
            row_add_moe(xa, MOEOUT, d0, d1, g2, F.lane); row_add_moe(xb, MOEOUT, d2, d3, g2, F.lane);
            row_store_bf16(xa, xp, F.lane); row_store_bf16(xb, xp + DM, F.lane); }
        const float ra = row_rms(xa), rb = row_rms(xb); const float* m = MOD + (size_t)(l * 5 + mr) * 12288;
        row_modulate(xa, ra, ng, m, m + 2048, F.lane); row_modulate(xb, rb, ng, m, m + 2048, F.lane);
        row_store_i8(xa, F.ws + WS_H8 + (size_t)r0 * 2048, WSP(float, WS_HS) + r0, F.lane); row_store_i8(xb, F.ws + WS_H8 + (size_t)(r0 + 1) * 2048, WSP(float, WS_HS) + r0 + 1, F.lane);
    }
}
__device__ __forceinline__ void p_final(Frame& F) {
    const int gw = opaque_s(F.bid * NWAVES + F.wave), NGW = F.G * NWAVES;
    const float* MOD = WSP(float, WS_MOD); const bf16_t* XL = WSP(bf16_t, WS_XL);
    const bf16_t* MOEOUT = WSP(bf16_t, WS_MOEOUT); const int* SLOTD = (const int*)(F.ws + WS_ROUTE + RT_SLOTD);
    int nd0 = 0, nd1 = 0, nd2 = 0, nd3 = 0;
    if (gw * 2 < NLAT) { nd0 = SLOTD[gw * 4]; nd1 = SLOTD[gw * 4 + 1]; nd2 = SLOTD[gw * 4 + 2]; nd3 = SLOTD[gw * 4 + 3]; }
    for (int r0 = gw * 2; r0 < NLAT; r0 += NGW * 2) {
        float* out_ = outp(F); const float* fg_ = inp(F, 27);
        const int d0 = nd0, d1 = nd1, d2 = nd2, d3 = nd3;
        { const int rn = r0 + NGW * 2; if (rn < NLAT) { nd0 = SLOTD[rn * 2]; nd1 = SLOTD[rn * 2 + 1]; nd2 = SLOTD[rn * 2 + 2]; nd3 = SLOTD[rn * 2 + 3]; } }
        RowVec xa, xb; row_load_bf16(xa, XL + (size_t)r0 * DM, F.lane); row_load_bf16(xb, XL + (size_t)(r0 + 1) * DM, F.lane);
        const float* g2 = MOD + (size_t)(5 + (r0 >> 12)) * 12288 + 10240;
        row_add_moe(xa, MOEOUT, d0, d1, g2, F.lane); row_add_moe(xb, MOEOUT, d2, d3, g2, F.lane);
        const float ra = row_rms(xa), rb = row_rms(xb);
#pragma unroll
        for (int j = 0; j < 8; ++j) { const int c = (j * 64 + F.lane) * 4; const f32x4 g = *(const f32x4*)(fg_ + c);
            *(f32x4*)(out_ + (size_t)r0 * DM + c) = xa.v[j] * ra * g; *(f32x4*)(out_ + (size_t)(r0 + 1) * DM + c) = xb.v[j] * rb * g; }
    }
}
__device__ __forceinline__ void p_norm2_route(Frame& F, int l, int nrows, bool dry = false) {
    const int gw = opaque_s(F.bid * NWAVES + F.wave), NGW = F.G * NWAVES;
    const float* MOD = WSP(float, WS_MOD); bf16_t* H = WSP(bf16_t, WS_H); const bf16_t* XL = WSP(bf16_t, WS_XL); const bf16_t* XC = WSP(bf16_t, WS_XC);
    const float* ng = inp(F, 5) + l * DM; const float* w_rg = inp(F, 20) + (size_t)l * DM * 4; const float* w_re = inp(F, 22) + (size_t)l * DM * 16;
    const float* b_rg = inp(F, 21) + l * 4; const float* b_re = inp(F, 23) + l * 16;
    const float* WRT = (const float*)(F.ws + WS_ROUTE + RT_WRT) + (size_t)l * 5 * 8192;
    int* lc = (int*)F.lds;
    if (F.tid < 64) lc[F.tid] = 0;
    __syncthreads();
    for (int row = gw; row < nrows; row += 2 * NGW) {
        const int rowb = row + NGW; const bool hb = rowb < nrows; const int rb = hb ? rowb : row;
        const bool lat = row < NLAT, latb = rb < NLAT; const int mr = lat ? (row >> 12) : 4, mrb = latb ? (rb >> 12) : 4;
        RowVec x, y; row_load_bf16(x, lat ? XL + (size_t)row * DM : XC + (size_t)(row - NLAT) * DM, F.lane); row_load_bf16(y, latb ? XL + (size_t)rb * DM : XC + (size_t)(rb - NLAT) * DM, F.lane);
        { const float rms = row_rms(x); const float* m = MOD + (size_t)(l * 5 + mr) * 12288; row_modulate(x, rms, ng, m + 6144, m + 8192, F.lane); }
        { const float rms = row_rms(y); const float* m = MOD + (size_t)(l * 5 + mrb) * 12288; row_modulate(y, rms, ng, m + 6144, m + 8192, F.lane); }
        row_store_i8(x, (unsigned char*)H + (size_t)row * 2048, (float*)(F.ws + WS_ROUTE + RT_HS2) + row, F.lane);
        if (hb) row_store_i8(y, (unsigned char*)H + (size_t)rb * 2048, (float*)(F.ws + WS_ROUTE + RT_HS2) + rb, F.lane);
        float lg[4], lh[4];
#pragma unroll
        for (int i = 0; i < 4; ++i) { lg[i] = 0.f; lh[i] = 0.f; }
        const int lane_o = opaque(F.lane);
#pragma unroll
        for (int j = 0; j < 8; ++j) {
#pragma unroll
            for (int i = 0; i < 4; ++i) { const int k = (j * 64 + lane_o) * 4 + i; const float hv = x.v[j][i], hw = y.v[j][i];
                const f32x4 wg = *(const f32x4*)(WRT + ((size_t)(j * 4 + i) * 64 + lane_o) * 4);
#pragma unroll
                for (int q = 0; q < 4; ++q) { lg[q] += hv * wg[q]; lh[q] += hw * wg[q]; } }
            asm volatile("" ::: "memory"); }
#pragma unroll
        for (int i = 0; i < 4; ++i) { lg[i] = wave_sum(lg[i]) + b_rg[i]; lh[i] = wave_sum(lh[i]) + b_rg[i]; }
        int gsx = 0, gsy = 0;
        { float gm = lg[0]; if (lg[1] > gm) { gm = lg[1]; gsx = 1; } if (lg[2] > gm) { gm = lg[2]; gsx = 2; } if (lg[3] > gm) { gm = lg[3]; gsx = 3; } }
        { float gm = lh[0]; if (lh[1] > gm) { gm = lh[1]; gsy = 1; } if (lh[2] > gm) { gm = lh[2]; gsy = 2; } if (lh[3] > gm) { gm = lh[3]; gsy = 3; } }
        gsx = __builtin_amdgcn_readfirstlane(gsx); gsy = __builtin_amdgcn_readfirstlane(gsy);
        float ex[4], ey[4];
#pragma unroll
        for (int i = 0; i < 4; ++i) { ex[i] = 0.f; ey[i] = 0.f; }
        const float* wex = WRT + (size_t)(1 + gsx) * 8192; const float* wey = WRT + (size_t)(1 + gsy) * 8192;
#pragma unroll
        for (int j = 0; j < 8; ++j) {
#pragma unroll
            for (int i = 0; i < 4; ++i) { const int k = (j * 64 + lane_o) * 4 + i; const float hv = x.v[j][i], hw = y.v[j][i];
                const f32x4 ea = *(const f32x4*)(wex + ((size_t)(j * 4 + i) * 64 + lane_o) * 4), eb = *(const f32x4*)(wey + ((size_t)(j * 4 + i) * 64 + lane_o) * 4);
#pragma unroll
                for (int q = 0; q < 4; ++q) { ex[q] += hv * ea[q]; ey[q] += hw * eb[q]; } }
            asm volatile("" ::: "memory"); }
#pragma unroll
        for (int i = 0; i < 4; ++i) { ex[i] = wave_sum(ex[i]); ey[i] = wave_sum(ey[i]); }
#pragma unroll 1
        for (int rr = 0; rr < 2; ++rr) {
            if (rr == 1) {
                if (!hb) break;
#pragma unroll
                for (int i = 0; i < 4; ++i) { lg[i] = lh[i]; ex[i] = ey[i]; }
                gsx = gsy; }
            const int crow = rr ? rb : row;
            if (F.lane == 0) {
                const int gs = gsx; const float gm = fmaxf(fmaxf(lg[0], lg[1]), fmaxf(lg[2], lg[3]));
                const float pg = 1.0f / (__expf(lg[0] - gm) + __expf(lg[1] - gm) + __expf(lg[2] - gm) + __expf(lg[3] - gm));
                float el[4];
#pragma unroll
                for (int q = 0; q < 4; ++q) el[q] = ex[q] + b_re[gs * 4 + q];
                int i0 = 0; float m0 = el[0];
#pragma unroll
                for (int q = 1; q < 4; ++q) if (el[q] > m0) { m0 = el[q]; i0 = q; }
                int i1 = -1; float m1 = -3.0e38f;
#pragma unroll
                for (int q = 0; q < 4; ++q) if (q != i0 && el[q] > m1) { m1 = el[q]; i1 = q; }
                const float p1 = __expf(m1 - m0);
                const float w0 = pg / (1.0f + p1), w1 = pg * p1 / (1.0f + p1);
                const int e0 = gs * 4 + i0, e1 = gs * 4 + i1;
                if (!dry) {
                    const int n = atomicAdd(&lc[32], 2);
                    const int q0 = atomicAdd(&lc[e0], 1), q1 = atomicAdd(&lc[e1], 1);
                    int* en = lc + 64 + n * 4;
                    en[0] = crow * 2; en[1] = e0; en[2] = q0; ((float*)en)[3] = w0;
                    en[4] = crow * 2 + 1; en[5] = e1; en[6] = q1; ((float*)en)[7] = w1; }
            }
        }
    }
    __syncthreads();
    if (dry) return;
    if (F.tid < 16) lc[16 + F.tid] = (int)atomicAdd(F.ctl + CW_ECNT + (l * 16 + F.tid) * 64, (unsigned)lc[F.tid]);
    __syncthreads();
    int* SLOTE = (int*)(F.ws + WS_ROUTE + RT_SLOTE); int* SLOTP = (int*)(F.ws + WS_ROUTE + RT_SLOTP); float* SLOTW = (float*)(F.ws + WS_ROUTE + RT_SLOTW);
    const int ne = lc[32];
    for (int i = F.tid; i < ne; i += NTHR) { const int* en = lc + 64 + i * 4; const int s = en[0], e = en[1]; SLOTE[s] = e; SLOTP[s] = lc[16 + e] + en[2]; SLOTW[s] = ((const float*)en)[3]; }
    __syncthreads();
}
__device__ __forceinline__ int moe_tables(Frame& F, int l) {
    volatile LAS int* T = (volatile LAS int*)(F.LC + LC_TILE);
    __syncthreads();
    if (F.tid < NEXP) T[184 + F.tid] = (int)__hip_atomic_load(F.ctl + CW_ECNT + (l * 16 + F.tid) * 64, __ATOMIC_RELAXED, __HIP_MEMORY_SCOPE_AGENT);
    __syncthreads();
    if (F.tid < NEXP) {
        int off = 0, nt = 0;
#pragma unroll 1
        for (int e = 0; e < F.tid; ++e) { const int t = (T[184 + e] + 255) >> 8; nt += t; off += t * 256; }
        const int t = (T[184 + F.tid] + 255) >> 8;
        T[160 + F.tid] = off;
#pragma unroll 1
        for (int i = 0; i < t; ++i) T[nt + i] = F.tid;
        if (F.tid == NEXP - 1) { T[176] = off + t * 256; T[180] = nt + t; }
    }
    __syncthreads();
    return T[180];
}
__device__ __forceinline__ void p_gather(Frame& F, int l, int nrows) {
    (void)moe_tables(F, l);
    volatile LAS int* T = (volatile LAS int*)(F.LC + LC_TILE);
    const int gw = opaque_s(F.bid * NWAVES + F.wave), NGW = F.G * NWAVES;
    const int* SLOTE = (const int*)(F.ws + WS_ROUTE + RT_SLOTE); const int* SLOTP = (const int*)(F.ws + WS_ROUTE + RT_SLOTP); const float* SLOTW = (const float*)(F.ws + WS_ROUTE + RT_SLOTW);
    int* SLOTD = (int*)(F.ws + WS_ROUTE + RT_SLOTD); float* WSORT = (float*)(F.ws + WS_ROUTE + RT_WSORT);
    const bf16_t* H = WSP(bf16_t, WS_H); bf16_t* XS = WSP(bf16_t, WS_XS); float* XSS = (float*)(F.ws + WS_ROUTE + RT_XSS); const float* HS2 = (const float*)(F.ws + WS_ROUTE + RT_HS2);
    for (int s0 = gw; s0 < nrows * 2; s0 += 4 * NGW) {
        int e4[4], p4[4]; float w4[4], hs4[4]; u32x4 a4[4], b4[4];
#pragma unroll
        for (int u = 0; u < 4; ++u) { const int s = s0 + u * NGW; const bool ok = s < nrows * 2; e4[u] = ok ? SLOTE[s] : 0; p4[u] = ok ? SLOTP[s] : 0; w4[u] = ok ? SLOTW[s] : 0.f; hs4[u] = ok ? HS2[s >> 1] : 0.f; }
#pragma unroll
        for (int u = 0; u < 4; ++u) { const int s = s0 + u * NGW; if (s < nrows * 2) { const u32x4* src = (const u32x4*)((const unsigned char*)H + (size_t)(s >> 1) * 2048); a4[u] = __builtin_nontemporal_load(src + F.lane); b4[u] = __builtin_nontemporal_load(src + 64 + F.lane); } }
#pragma unroll
        for (int u = 0; u < 4; ++u) { const int s = s0 + u * NGW; if (s < nrows * 2) { const int d = T[160 + e4[u]] + p4[u];
            u32x4* dst = (u32x4*)((unsigned char*)XS + (size_t)d * 2048); dst[F.lane] = a4[u]; dst[64 + F.lane] = b4[u];
            if (F.lane == 0) { SLOTD[s] = d; WSORT[d] = w4[u]; XSS[d] = hs4[u]; } } }
    }
    for (int i = F.bid * NTHR + F.tid; i < NEXP * 256; i += F.G * NTHR) { const int e = i >> 8, j = i & 255;
        const int c = T[184 + e]; const int pad = ((c + 255) & ~255) - c;
        if (j < pad) { WSORT[T[160 + e] + c + j] = 0.f; XSS[T[160 + e] + c + j] = 0.f; } }
}

__device__ __forceinline__ void unpack8(const u32x4 w, float* v) { v[0] = bflo(w.x); v[1] = bfhi(w.x); v[2] = bflo(w.y); v[3] = bfhi(w.y); v[4] = bflo(w.z); v[5] = bfhi(w.z); v[6] = bflo(w.w); v[7] = bfhi(w.w); }
__device__ __forceinline__ u32x4 pack8(const float* v) { u32x4 w; w.x = cvt_pk_bf16(v[0], v[1]); w.y = cvt_pk_bf16(v[2], v[3]); w.z = cvt_pk_bf16(v[4], v[5]); w.w = cvt_pk_bf16(v[6], v[7]); return w; }
struct PrepConst { float c0[8], c1[8], c2[8]; };
__device__ __forceinline__ void prep_token(Frame& F, int row, int g, int li, const u32x4 w0, const u32x4 wm, const u32x4 wp, const f32x4 (&tc)[2], const f32x4 (&ts)[2], const PrepConst& K, u32x4& out, bf16_t*& dptr) {
    const bool lat = row < NLAT; const int b = lat ? (row >> 12) : ((row - NLAT) >> 8), t = lat ? (row & 4095) : ((row - NLAT) & 255);
    const int pos = lat ? t : SEQ + t;
    float v[8]; unpack8(w0, v);
    bf16_t* dst;
    if (g < 10 || (g >= 24 && g < 30)) {
        if (g < 10) {
            float s = 0.f;
#pragma unroll
            for (int i = 0; i < 8; ++i) s += v[i] * v[i];
            s += xshfl<1>(s); s += xshfl<2>(s); s += xshfl<4>(s); s += xshfl<8>(s);
            const float r = rsqrtf(s * (1.0f / 128.0f) + EPS);
#pragma unroll
            for (int i = 0; i < 8; ++i) v[i] = v[i] * r * K.c1[i];
        }
        if (lat) {
            const int half = (li >> 2) & 1;
#pragma unroll
            for (int i = 0; i < 8; ++i) { const float o = xshfl<4>(v[i]); const float c = i < 4 ? tc[0][i & 3] : tc[1][i & 3], s = i < 4 ? ts[0][i & 3] : ts[1][i & 3]; v[i] = half ? (v[i] * c + o * s) : (v[i] * c - o * s); }
        }
        if (g < 8) dst = lat ? WSP(bf16_t, WS_QA) + ((size_t)(b * 8 + g) * SEQ + t) * HD : WSP(bf16_t, WS_QAC) + ((size_t)(b * 8 + g) * CTXL + t) * HD;
        else if (g < 10) dst = WSP(bf16_t, WS_KA) + ((size_t)(b * 2 + (g - 8)) * KVL + pos) * HD;
        else if (g < 28) dst = lat ? WSP(bf16_t, WS_QC) + ((size_t)(b * 4 + (g - 24)) * SEQ + t) * HD : WSP(bf16_t, WS_QCC) + ((size_t)(b * 4 + (g - 24)) * CTXL + t) * HD;
        else dst = WSP(bf16_t, WS_KC) + ((size_t)(b * 2 + (g - 28)) * KVL + pos) * HD;
    } else if (g >= 12 && g < 20) {
        const int T = lat ? SEQ : CTXL;
        float vm[8], vp[8]; unpack8(wm, vm); unpack8(wp, vp);
        const float zm = t > 0 ? 1.f : 0.f, zp = t < T - 1 ? 1.f : 0.f;
        const float ksc = (g >= 16) ? 0.088388347648318440f : 1.0f;
#pragma unroll
        for (int i = 0; i < 8; ++i) { const float y = K.c0[i] * vm[i] * zm + K.c1[i] * v[i] + K.c2[i] * vp[i] * zp; v[i] = siluf_(y) * ksc; }
        dst = (g < 16 ? WSP(bf16_t, WS_QM) : WSP(bf16_t, WS_KM)) + ((size_t)(b * 4 + ((g - 12) & 3)) * KVL + pos) * HD;
    } else if (g < 12) dst = WSP(bf16_t, WS_VA) + ((size_t)(b * 2 + (g - 10)) * KVL + pos) * HD;
    else if (g < 24) dst = WSP(bf16_t, WS_VM) + ((size_t)(b * 4 + (g - 20)) * KVL + pos) * HD;
    else dst = WSP(bf16_t, WS_VC) + ((size_t)(b * 2 + (g - 30)) * KVL + pos) * HD;
    out = pack8(v); dptr = dst + li * 8;
}
__device__ __forceinline__ void p_prep(Frame& F, int l) {
    const bf16_t* P1 = WSP(bf16_t, WS_P1);
    const float* ctab = WSP(float, WS_ROPE); const float* stab = ctab + SEQ * 64;
    const int g = F.tid >> 4, li = F.tid & 15, c0 = g * 128 + li * 8;
    const float* qn = inp(F, 9) + l * HD; const float* kn = inp(F, 10) + l * HD; const float* cw = inp(F, 11) + (size_t)l * 3 * 1024;
    const bool conv = (g >= 12 && g < 20), rope = (g < 10) || (g >= 24 && g < 30);
    const bool vgrp = (g == 10 || g == 11 || (g >= 20 && g < 24) || g >= 30);
    PrepConst K;
    const float one_ = __int_as_float(opaque(0x3f800000)), zero_ = __int_as_float(opaque(0));
#pragma unroll
    for (int i = 0; i < 8; ++i) { K.c0[i] = zero_; K.c1[i] = one_; K.c2[i] = zero_; }
    if (g < 10) {
#pragma unroll
        for (int i = 0; i < 8; ++i) K.c1[i] = (g < 8 ? qn : kn)[li * 8 + i] * (g < 8 ? 0.088388347648318440f * 1.4426950408889634f : 1.0f); }
    if (conv) { const int ch = (g - 12) * 128 + li * 8;
#pragma unroll
        for (int i = 0; i < 8; ++i) { K.c0[i] = cw[ch + i]; K.c1[i] = cw[1024 + ch + i]; K.c2[i] = cw[2048 + ch + i]; } }
    const int rax = li >> 3, rf0 = (li & 3) * 8;
    if (!vgrp) for (int r8 = F.bid; r8 < NROW / 8; r8 += F.G) {
        const int row = r8 * 8; const bool lat = row < NLAT; const int t = lat ? (row & 4095) : ((row - NLAT) & 255), T = lat ? SEQ : CTXL;
        const bf16_t* p = P1 + (size_t)row * 4096 + c0;
        u32x4 w[10];
#pragma unroll
        for (int q = 0; q < 8; ++q) w[1 + q] = __builtin_nontemporal_load((const u32x4*)(p + (size_t)q * 4096));
        w[0] = w[1]; w[9] = w[8];
        if (conv) { if (t > 0) w[0] = __builtin_nontemporal_load((const u32x4*)(p - 4096)); if (t + 8 < T) w[9] = __builtin_nontemporal_load((const u32x4*)(p + (size_t)8 * 4096)); }
        f32x4 tc[4][2], ts[4][2]; u32x4 o4[4]; bf16_t* d4[4];
#define PREP_ROPE(q0) do { _Pragma("unroll") for (int q = 0; q < 4; ++q) { tc[q][0] = tc[q][1] = ts[q][0] = ts[q][1] = (f32x4){0.f, 0.f, 0.f, 0.f}; }                                     \
        if (rope && lat) { _Pragma("unroll") for (int q = 0; q < 4; ++q) { const float* cp = ctab + (size_t)(t + (q0) + q) * 64 + rax * 32 + rf0; const float* sp = stab + (size_t)(t + (q0) + q) * 64 + rax * 32 + rf0; \
            tc[q][0] = *(const f32x4*)cp; tc[q][1] = *(const f32x4*)(cp + 4); ts[q][0] = *(const f32x4*)sp; ts[q][1] = *(const f32x4*)(sp + 4); } } } while (0)
        PREP_ROPE(0);
#pragma unroll
        for (int q = 0; q < 4; ++q) prep_token(F, row + q, g, li, w[1 + q], w[q], w[2 + q], tc[q], ts[q], K, o4[q], d4[q]);
        PREP_ROPE(4);
#pragma unroll
        for (int q = 0; q < 4; ++q) *(u32x4*)d4[q] = o4[q];
#pragma unroll
        for (int q = 0; q < 4; ++q) prep_token(F, row + 4 + q, g, li, w[5 + q], w[4 + q], w[6 + q], tc[q], ts[q], K, o4[q], d4[q]);
#pragma unroll
        for (int q = 0; q < 4; ++q) *(u32x4*)d4[q] = o4[q];
#undef PREP_ROPE
    }
    const float* GRAW = WSP(float, WS_GRAW); float* GI = WSP(float, WS_GATE); float* GF = GI + NB * 2 * 4 * KVL;
    const float* igb = inp(F, 12) + l * 8; const float* fgb = inp(F, 13) + l * 8;
    for (int i = F.bid * NTHR + F.tid; i < NROW * 8; i += F.G * NTHR) {
        const int row = i >> 3, dh = i & 7; const bool lat = row < NLAT; const int b = lat ? (row >> 12) : ((row - NLAT) >> 8), pos = lat ? (row & 4095) : SEQ + ((row - NLAT) & 255);
        const float gi = GRAW[(size_t)row * 16 + dh] + igb[dh]; const float xf = GRAW[(size_t)row * 16 + 8 + dh] + fgb[dh];
        const float lf = fminf(xf, 0.f) - log1pf(__expf(-fabsf(xf)));
        GI[(size_t)(b * 8 + dh) * KVL + pos] = gi; GF[(size_t)(b * 8 + dh) * KVL + pos] = lf;
    }
}
__device__ __forceinline__ void p_omprep(Frame& F, int l, int nrows) {
    const float* HM = WSP(float, WS_HM); const bf16_t* MO = WSP(bf16_t, WS_MO); bf16_t* OALL = WSP(bf16_t, WS_OALL);
    const float* mg = inp(F, 14) + l * 512;
    const int li = F.tid & 15;
    const int it0 = F.bid * 32 + (F.tid >> 4), h = it0 & 3, IS = F.G * 32;
    float mgv[8];
#pragma unroll
    for (int i = 0; i < 8; ++i) mgv[i] = mg[h * 128 + li * 8 + i];
    for (int it = it0; it < nrows * 4; it += 4 * IS) {
        f32x4 a0[4], a1[4], b0[4], b1[4]; u32x4 gw4[4];
#pragma unroll
        for (int u = 0; u < 4; ++u) { const int itu = it + u * IS; if (itu < nrows * 4) {
            const int row = itu >> 2; const size_t o = (size_t)row * 512 + h * 128 + li * 8;
            const bool lat = row < NLAT; const int b = lat ? (row >> 12) : ((row - NLAT) >> 8), t = lat ? (row & 4095) : ((row - NLAT) & 255);
            const int p0 = lat ? CTXL + t : t, p1 = lat ? CTXL + (SEQ - 1 - t) : (CTXL - 1 - t);
            const float* h0 = HM + ((size_t)((0 * 4 + b) * 4 + h) * KVL + p0) * HD + li * 8; const float* h1 = HM + ((size_t)((1 * 4 + b) * 4 + h) * KVL + p1) * HD + li * 8;
            a0[u] = __builtin_nontemporal_load((const f32x4*)(h0)); a1[u] = __builtin_nontemporal_load((const f32x4*)(h0 + 4)); b0[u] = __builtin_nontemporal_load((const f32x4*)(h1)); b1[u] = __builtin_nontemporal_load((const f32x4*)(h1 + 4)); gw4[u] = __builtin_nontemporal_load((const u32x4*)(MO + o)); } }
#pragma unroll
        for (int u = 0; u < 4; ++u) { const int itu = it + u * IS; if (itu < nrows * 4) { const int row = itu >> 2;
            float v[8] = {a0[u][0] + b0[u][0], a0[u][1] + b0[u][1], a0[u][2] + b0[u][2], a0[u][3] + b0[u][3], a1[u][0] + b1[u][0], a1[u][1] + b1[u][1], a1[u][2] + b1[u][2], a1[u][3] + b1[u][3]};
            float s = 0.f;
#pragma unroll
            for (int i = 0; i < 8; ++i) s += v[i] * v[i];
            s += xshfl<1>(s); s += xshfl<2>(s); s += xshfl<4>(s); s += xshfl<8>(s);
            const float r = rsqrtf(s * (1.0f / 128.0f) + EPS);
            float gt[8]; unpack8(gw4[u], gt);
#pragma unroll
            for (int i = 0; i < 8; ++i) v[i] = v[i] * r * mgv[i] * gt[i];
            *(u32x4*)(OALL + (size_t)row * DM + 1024 + h * 128 + li * 8) = pack8(v); } }
    }
}
__device__ __forceinline__ int mixer_pop(Frame& F, int l, int kind, int x, int rep = 0) {
    __syncthreads();
    if (F.tid == 0) F.LC[LC_Q] = atomicAdd(F.ctl + CW_QCTR + ((l * 4 + kind) * 8 + x) * 64 + rep * 32768, 1u);
    __syncthreads();
    return (int)F.LC[LC_Q];
}
constexpr int LC_QS = 48;
__device__ __forceinline__ void mixer_snapshot(Frame& F, int l, int kind, int rep) {
    __syncthreads();
    if (F.tid < 8) F.LC[LC_QS + F.tid] = __hip_atomic_load(F.ctl + CW_QCTR + ((l * 4 + kind) * 8 + F.tid) * 64 + rep * 32768, __ATOMIC_RELAXED, __HIP_MEMORY_SCOPE_AGENT);
    __syncthreads();
}
__device__ __forceinline__ void p_mixers(Frame& F, int l, int rep = 0) {
    const int x0 = (int)(xb_xcc_id() & 7u);
    bf16_t* OALL = WSP(bf16_t, WS_OALL);
    LAS char* lds = (LAS char*)F.lds3;
#ifndef MIX_EN
#define MIX_EN 7
#endif
    mixer_snapshot(F, l, 0, rep);
    if (MIX_EN & 1) for (int dx = 0; dx < 8; ++dx) { const int x = (x0 + dx) & 7, b = x >> 1, kvh = x & 1; if ((int)F.LC[LC_QS + x] >= 4) continue;
        for (;;) { const int u = mixer_pop(F, l, 0, x, rep); if (u >= 4) break;
            const int h = kvh * 2 + (u >> 1), dir = u & 1, seq = (b * 4 + h) * 2 + dir;
            ml::ScanArgs a; const size_t ho = (size_t)(b * 4 + h) * KVL * HD;
            a.K = WSP(bf16_t, WS_KM) + ho; a.V = WSP(bf16_t, WS_VM) + ho;
            a.GI = WSP(float, WS_GATE) + (size_t)((b * 2 + dir) * 4 + h) * KVL; a.GF = a.GI + (size_t)NB * 8 * KVL;
            a.CIMG = F.ws + WS_CIMG + (size_t)seq * 34 * 32768; a.NST = WSP(float, WS_NST) + (size_t)seq * 34 * 128; a.GT = WSP(float, WS_GT) + (size_t)seq * 34 * 512;
            a.prog = F.ctl + CW_PROG + (l * 32 + seq) * 64 + rep * 32768; a.dir = dir;
            ml::mlstm_scan(a, lds, F.wave);
#ifdef REP_SCAN
            ml::mlstm_scan(a, lds, F.wave);
#endif
        }
        mixer_snapshot(F, l, 0, rep); }
    const int nu1 = (l == 0) ? 68 : 64;
    float bnd;
    { const float* gq = inp(F, 9) + l * HD; const float* gk = inp(F, 10) + l * HD; float mq = 0.f, mk = 0.f;
      for (int i = 0; i < HD; ++i) { mq = fmaxf(mq, fabsf(gq[i])); mk = fmaxf(mk, fabsf(gk[i])); }
      bnd = (128.0f * mq * mk * 1.0001f + 1e-3f) * (0.088388347648318440f * 1.4426950408889634f); }
    mixer_snapshot(F, l, 1, rep);
    if (MIX_EN & 2) for (int dx = 0; dx < 8; ++dx) { const int x = (x0 + dx) & 7, b = x >> 1, kvh = x & 1; if ((int)F.LC[LC_QS + x] >= nu1) continue;
        for (;;) { const int u = mixer_pop(F, l, 1, x, rep); if (u >= nu1) break;
            att::Args a; a.ldo = DM; a.base1 = 0; a.qpos0 = 0;
            a.K = WSP(bf16_t, WS_KA) + (size_t)(b * 2 + kvh) * KVL * HD; a.V = WSP(bf16_t, WS_VA) + (size_t)(b * 2 + kvh) * KVL * HD; a.m_init = bnd; a.l_init = 0.f;
            if (u < 64) { const int h = kvh * 4 + (u >> 4), qb = u & 15; a.Q = WSP(bf16_t, WS_QA) + ((size_t)(b * 8 + h) * SEQ + qb * 256) * HD;
                a.O = OALL + (size_t)(b * SEQ + qb * 256) * DM + h * 128; a.n0 = 68; a.base0 = 0; a.NT = 68; }
            else { const int h = kvh * 4 + (u - 64); a.Q = WSP(bf16_t, WS_QAC) + (size_t)(b * 8 + h) * CTXL * HD;
                a.O = OALL + (size_t)(NLAT + b * CTXL) * DM + h * 128; a.n0 = 4; a.base0 = SEQ; a.NT = 4; }
            att::attn_body_dma(a, lds, F.wave);
#ifdef REP_ATT
            att::attn_body_dma(a, lds, F.wave);
#endif
        }
        mixer_snapshot(F, l, 1, rep); }
    const int nu2 = (l == 0) ? 34 : 32;
    mixer_snapshot(F, l, 2, rep);
    if (MIX_EN & 4) for (int dx = 0; dx < 8; ++dx) { const int x = (x0 + dx) & 7, b = x >> 1, kvh = x & 1; if ((int)F.LC[LC_QS + x] >= nu2) continue;
        for (;;) { const int u = mixer_pop(F, l, 2, x, rep); if (u >= nu2) break;
            att::Args a; a.ldo = DM; a.base1 = SEQ;
            a.K = WSP(bf16_t, WS_KC) + (size_t)(b * 2 + kvh) * KVL * HD; a.V = WSP(bf16_t, WS_VC) + (size_t)(b * 2 + kvh) * KVL * HD;
            if (u < 32) { const int h = kvh * 2 + (u >> 4), qb = u & 15;
                const int w0 = qb == 0 ? 0 : qb * 256 - 128, w1 = qb == 15 ? SEQ : qb * 256 + 384;
                a.Q = WSP(bf16_t, WS_QC) + ((size_t)(b * 4 + h) * SEQ + qb * 256) * HD;
                a.O = OALL + (size_t)(b * SEQ + qb * 256) * DM + 1536 + h * 128; a.n0 = (w1 - w0) >> 6; a.base0 = w0; a.NT = a.n0 + 4; a.qpos0 = qb * 256;
                a.m_init = inp(F, 15)[l * 4 + h] * (1.0f / att::SCALE); }
            else { const int h = kvh * 2 + (u - 32); a.Q = WSP(bf16_t, WS_QCC) + (size_t)(b * 4 + h) * CTXL * HD;
                a.O = OALL + (size_t)(NLAT + b * CTXL) * DM + 1536 + h * 128; a.n0 = 0; a.base0 = 0; a.NT = 4; a.qpos0 = 0;
                a.m_init = inp(F, 15)[l * 4 + h] * (1.0f / att::SCALE); }
            a.l_init = 1.f;
            att::attn_body<true, false>(a, lds, F.wave);
#ifdef REP_ATC
            att::attn_body<true, false>(a, lds, F.wave);
#endif
        }
        mixer_snapshot(F, l, 2, rep); }
    const int nco = (l == 0) ? 34 : 32;
    mixer_snapshot(F, l, 3, rep);
    if (MIX_EN & 1) for (int dx = 0; dx < 8; ++dx) { const int x = (x0 + dx) & 7, b = x >> 1, kvh = x & 1; if ((int)F.LC[LC_QS + x] >= 4 * nco) continue;
        for (;;) { const int u = mixer_pop(F, l, 3, x, rep); if (u >= 4 * nco) break;
            const int sl = u / nco, c = (34 - nco) + u % nco, h = kvh * 2 + (sl >> 1), dir = sl & 1, seq = (b * 4 + h) * 2 + dir;
            ml::OutArgs a; const size_t ho = (size_t)(b * 4 + h) * KVL * HD;
            a.Q = WSP(bf16_t, WS_QM) + ho; a.K = WSP(bf16_t, WS_KM) + ho; a.V = WSP(bf16_t, WS_VM) + ho;
            a.CIMG = F.ws + WS_CIMG + ((size_t)seq * 34 + c) * 32768; a.NST = WSP(float, WS_NST) + ((size_t)seq * 34 + c) * 128; a.GT = WSP(float, WS_GT) + ((size_t)seq * 34 + c) * 512;
            a.HM = WSP(float, WS_HM) + (size_t)((dir * 4 + b) * 4 + h) * KVL * HD; a.prog = F.ctl + CW_PROG + (l * 32 + seq) * 64 + rep * 32768; a.dir = dir; a.c = c;
            ml::mlstm_out(a, lds, F.wave);
#ifdef REP_MOUT
            ml::mlstm_out(a, lds, F.wave);
#endif
        }
        mixer_snapshot(F, l, 3, rep); }
}

__device__ __forceinline__ bool ph_in(int lo, int hi, int k) { asm volatile("" : "+s"(lo), "+s"(hi)); return lo <= k && k < hi; }
constexpr int PH_PRE = 0, PH_MODR = 1, PH_L0 = 2, PH_PER_LAYER = 11, PH_FINAL = PH_L0 + 2 * PH_PER_LAYER, N_PHASES = PH_FINAL + 1;
struct Params { const float* in[28]; float* out; unsigned char* ws; int ph_lo, ph_hi; };
__global__ void __launch_bounds__(NTHR, 2) fwd(Params p) {
    extern __shared__ __attribute__((aligned(16))) unsigned char lds[];
    Frame F;
    F.lds = (char*)lds; F.lds3 = (LAS unsigned char*)lds; F.LC = (volatile LAS unsigned*)((LAS unsigned char*)lds + LDSCTL_OFF);
    F.wave = __builtin_amdgcn_readfirstlane((int)threadIdx.x >> 6); F.tid = tid_of(F.wave); F.lane = F.tid & 63; F.G = gridDim.x; F.bid = blockIdx.x;
    F.karg = (const float* const __attribute__((address_space(4)))*)__builtin_amdgcn_kernarg_segment_ptr();
    F.ws = wsp_(F); F.ctl = (unsigned*)(F.ws + WS_CTL);
    for (int u = F.tid; u < (LDS_BYTES - LDSCTL_OFF) / 4; u += NTHR) F.LC[u] = 0u;
    __syncthreads();
    const int lo = p.ph_lo, hi = p.ph_hi;
    XcdBarrier bar; bar.bar = F.ctl + CW_BAR; bar.x = 0; bar.st = nullptr;
    if (hi - lo > 1) bar = xcd_barrier_post(F.ctl + CW_BAR, F.LC + LC_BAR, F.tid);
#ifndef PH_ENABLE
#define PH_ENABLE 0xFFFF
#endif
#define EN(kind) ((PH_ENABLE >> (kind)) & 1)
#define IN(k) ph_in(lo, hi, (k))
#ifndef PROBE_A
#define PROBE_A 0
#endif
#ifndef PROBE_B
#define PROBE_B 0
#endif
#define PROBE ((PROBE_A) | (PROBE_B))
#define TS(kind) do { if (PROBE && F.bid == 0 && F.tid == 0) { const unsigned t_ = (unsigned)__builtin_amdgcn_s_memrealtime(); F.LC[32 + (kind)] += t_ - F.LC[31]; F.LC[31] = t_; } } while (0)
#define PB() do { F.tid = tid_of(F.wave); F.lane = F.tid & 63; F.ws = wsp_(F); } while (0)
#ifdef REP_SEAM
#define SEAM(k) do { if (IN(k) && IN((k) + 1)) { xcd_barrier(bar, tid_of(F.wave)); xcd_barrier(bar, tid_of(F.wave)); xcd_barrier(bar, tid_of(F.wave)); } } while (0)
#else
#define SEAM(k) do { if (IN(k) && IN((k) + 1)) xcd_barrier(bar, tid_of(F.wave)); } while (0)
#endif
    LAS unsigned char* ring = (LAS unsigned char*)lds;
    if (PROBE && F.bid == 0 && F.tid == 0) F.LC[31] = (unsigned)__builtin_amdgcn_s_memrealtime();

    if (EN(0) && IN(PH_PRE)) { PB(); p_mod_partial(F); p_rope_tables(F); p_convert_weights(F, 0, 0); p_convert_i8(F, 0);
#ifdef POISON_ML
        for (size_t i = (size_t)F.bid * NTHR + F.tid; i < (WS_END - WS_CIMG) / 16; i += (size_t)F.G * NTHR) ((u32x4*)(F.ws + WS_CIMG))[i] = (u32x4){0xFFFFFFFFu, 0xFFFFFFFFu, 0xFFFFFFFFu, 0xFFFFFFFFu};
#endif
#ifdef REP_PRE
        p_mod_partial(F); p_rope_tables(F); p_convert_weights(F, 0, 0);
#endif
#ifdef REP_I8
        p_convert_i8(F, 0);
#endif
    } SEAM(PH_PRE); TS(0);
    if (EN(1) && IN(PH_MODR)) { PB(); p_mod_reduce(F); } SEAM(PH_MODR); TS(1);
#pragma unroll 1
    for (int l = 0; l < 2; ++l) {
        const int P = PH_L0 + l * PH_PER_LAYER;
        const int mrows = (l == 0) ? NROW : NLAT;
        if (EN(2) && IN(P + 0)) { PB(); if (l > 0) { p_convert_weights(F, l, 0); p_convert_i8(F, l); }
            p_norm1(F, l);
#ifdef REP_N1
            if (l == 0) p_norm1(F, l);
#endif
        } SEAM(P + 0); TS(2);
        if (EN(3) && IN(P + 1)) { PB();
            int n_i8 = 0;
            {
                pg8::Gemm g{WSP(bf16_t, WS_H8), WSP(bf16_t, WS_WIN) + (size_t)4608 * DM, 0, 0, DM / 2}; pg8::GateOrder S; S.init(l, F.G, F.bid); n_i8 = S.count();
                pg8::EpiGateI8 E{F.ws + WS_G, WSP(float, WS_HS), WSP(float, WS_WS8) + l * 11008, WSP(bf16_t, WS_P1), WSP(bf16_t, WS_MO), F.ws};
                pg8::gemm_phase<pg8::EpiGateI8, pg8::GateOrder>(ring, g, S, E, F.wave);
#ifdef REP_GATE
                if (l == 0) { S.fold = REP_GATE; pg8::gemm_phase<pg8::EpiGateI8, pg8::GateOrder>(ring, g, S, E, F.wave); }
#endif
            }
        } SEAM(P + 1); TS(3);
        if (EN(4) && IN(P + 2)) { PB(); p_prep(F, l);
#ifdef REP_PREP
            p_prep(F, l);
#endif
        } SEAM(P + 2); TS(4);
        if (EN(5) && IN(P + 3)) { PB(); p_mixers(F, l);
#ifdef REP_MIX
            xcd_barrier(bar, tid_of(F.wave)); p_mixers(F, l, 1);
#endif
        } SEAM(P + 3); TS(5);
        if (EN(6) && IN(P + 4)) { PB(); p_omprep(F, l, mrows);
#ifdef REP_OMP
            p_omprep(F, l, mrows);
#endif
        } SEAM(P + 4); TS(6);
        if (EN(7) && IN(P + 5)) { PB(); pg8::Gemm g{WSP(bf16_t, WS_OALL), WSP(bf16_t, WS_WBR), mrows, DM, DM}; pg8::HalfOrder S; S.init(l == 0 ? 64 : 0, F.G, F.bid);
            pg8::EpiBranch E{F.ws + WS_G, WSP(bf16_t, WS_Y)};
            pg8::gemm_phase<pg8::EpiBranch, pg8::HalfOrder>(ring, g, S, E, F.wave);
#ifdef REP_BR
            if (l == 0) pg8::gemm_phase<pg8::EpiBranch, pg8::HalfOrder>(ring, g, S, E, F.wave);
#endif
        } SEAM(P + 5); TS(7);
        if (EN(8) && IN(P + 6)) { PB(); pg8::Gemm g{WSP(bf16_t, WS_Y), WSP(bf16_t, WS_WOUT), mrows, DM, DM}; pg8::HalfOrder S; S.init(l == 0 ? 64 : 0, F.G, F.bid);
            pg8::EpiOut E{F.karg, WSP(float, WS_MOD) + (size_t)l * 5 * 12288, l == 0 ? 1 : 0};
            pg8::gemm_phase<pg8::EpiOut, pg8::HalfOrder>(ring, g, S, E, F.wave);
#ifdef REP_OUT
            if (l == 0) pg8::gemm_phase<pg8::EpiOut, pg8::HalfOrder>(ring, g, S, E, F.wave);
#endif
        } SEAM(P + 6); TS(8);
        if (EN(9) && IN(P + 7)) { PB();
#ifdef REP_N2
            p_norm2_route(F, l, mrows, true);
#endif
            p_norm2_route(F, l, mrows); } SEAM(P + 7); TS(9);
        if (EN(10) && IN(P + 8)) { PB(); p_gather(F, l, mrows);
#ifdef REP_GATHER
            p_gather(F, l, mrows);
#endif
        } SEAM(P + 8); TS(10);
        if (EN(11) && IN(P + 9)) { PB(); const int ntl = moe_tables(F, l);
            pg8::Gemm g{WSP(bf16_t, WS_XS), WSP(bf16_t, WS_WGU), 0, 0, DM / 2}; pg8::MoeOrder S{ntl, 4, F.G, F.bid, (const LAS int*)(F.LC + LC_TILE)};
            pg8::EpiMoe1I8 E{WSP(bf16_t, WS_MID), (const float*)(F.ws + WS_ROUTE + RT_WSORT), (const float*)(F.ws + WS_ROUTE + RT_XSS), (const float*)(F.ws + WS_ROUTE + RT_WGS) + l * 16384};
            pg8::gemm_phase<pg8::EpiMoe1I8, pg8::MoeOrder>(ring, g, S, E, F.wave);
#ifdef REP_G1
            if (l == 0) pg8::gemm_phase<pg8::EpiMoe1I8, pg8::MoeOrder>(ring, g, S, E, F.wave);
#endif
        } SEAM(P + 9); TS(11);
        if (EN(12) && IN(P + 10)) { PB(); const int ntl = moe_tables(F, l);
            pg8::Gemm g{WSP(bf16_t, WS_MID), WSP(bf16_t, WS_WD), 0, 0, DFF}; pg8::MoeOrder S{ntl, 8, F.G, F.bid, (const LAS int*)(F.LC + LC_TILE)};
            pg8::EpiMoe2 E{WSP(bf16_t, WS_MOEOUT)};
            pg8::gemm_phase<pg8::EpiMoe2, pg8::MoeOrder>(ring, g, S, E, F.wave);
#ifdef REP_G2
            if (l == 0) pg8::gemm_phase<pg8::EpiMoe2, pg8::MoeOrder>(ring, g, S, E, F.wave);
#endif
        } SEAM(P + 10); TS(12);
    }
    if (PROBE) {
        if (F.bid == 0 && F.tid == 0) { unsigned a = 0, b = 0;
            for (int k = 0; k < 14; ++k) { if ((PROBE_A >> k) & 1) a += F.LC[32 + k]; if ((PROBE_B >> k) & 1) b += F.LC[32 + k]; }
            __hip_atomic_store(F.ctl + 64, a, __ATOMIC_RELAXED, __HIP_MEMORY_SCOPE_AGENT); __hip_atomic_store(F.ctl + 65, b, __ATOMIC_RELAXED, __HIP_MEMORY_SCOPE_AGENT); }
        xcd_barrier(bar, tid_of(F.wave));
        const float ta = (float)__hip_atomic_load(F.ctl + 64, __ATOMIC_RELAXED, __HIP_MEMORY_SCOPE_AGENT) * 0.01f, tb = (float)__hip_atomic_load(F.ctl + 65, __ATOMIC_RELAXED, __HIP_MEMORY_SCOPE_AGENT) * 0.01f;
        float* o_ = outp(F); const float V = 1000.f, W = 1000.f + (ta + tb) * 100.f;
        for (size_t i = (size_t)F.bid * NTHR + F.tid; i < (size_t)NLAT * DM; i += (size_t)F.G * NTHR) o_[i] = (i == 0) ? W : V;
    } else if (EN(13) && IN(PH_FINAL)) { PB(); p_final(F);
#ifdef REP_FINAL
        p_final(F);
#endif
    }
#undef IN
#undef SEAM
}

extern "C" void kernel_launch(void* const* d_in, const int* in_sizes, int n_in, void* d_out, int out_size, void* d_ws, size_t ws_size, hipStream_t stream) {
    static int grid = 0;
    if (grid == 0) {
        if (n_in != 28 || out_size != NLAT * DM || ws_size < WS_END) { fprintf(stderr, "kernel_launch: unexpected shapes (n_in %d, out %d, ws %zu < %zu)\n", n_in, out_size, ws_size, (size_t)WS_END); grid = -1; return; }
        int dev = 0, cus = 0, per_cu = 0;
        if (hipGetDevice(&dev) != hipSuccess || hipDeviceGetAttribute(&cus, hipDeviceAttributeMultiprocessorCount, dev) != hipSuccess) { grid = -1; return; }
        if (hipFuncSetAttribute((const void*)fwd, hipFuncAttributeMaxDynamicSharedMemorySize, LDS_BYTES) != hipSuccess) { fprintf(stderr, "kernel_launch: hipFuncSetAttribute failed\n"); grid = -1; return; }
        if (hipOccupancyMaxActiveBlocksPerMultiprocessor(&per_cu, (const void*)fwd, NTHR, LDS_BYTES) != hipSuccess || per_cu < 1) { fprintf(stderr, "kernel_launch: occupancy query says %d\n", per_cu); (void)hipGetLastError(); grid = -1; return; }
        grid = cus;
    }
    if (grid < 0) return;
    (void)hipMemsetAsync((char*)d_ws + WS_CTL, 0, CTL_ZERO_BYTES, stream);
    Params p{};
    for (int i = 0; i < 28; ++i) p.in[i] = (const float*)d_in[i];
    p.out = (float*)d_out; p.ws = (unsigned char*)d_ws;
#if MK_PER_PHASE
    for (int k = 0; k < N_PHASES; ++k) { p.ph_lo = k; p.ph_hi = k + 1; hipLaunchKernelGGL(fwd, dim3(grid), dim3(NTHR), LDS_BYTES, stream, p); }
#else
    p.ph_lo = 0; p.ph_hi = N_PHASES; hipLaunchKernelGGL(fwd, dim3(grid), dim3(NTHR), LDS_BYTES, stream, p);
#endif
}
```
